# Optimizing an MI355X kernel written in HIP

```python
import jax, jax.numpy as jnp
from jax import lax
import numpy as np

D_MODEL = 2048
BATCH = 4
SEQ = 2048
DEPTH = 4

GRID_W = 64
CTX_LEN = 256
N_MIXERS = 2
N_HEADS = 16
HEAD_DIM = D_MODEL // N_HEADS
WIN_ROWS_MAX = 8
WIN_COLS = 16
LRU_BLOCK = 256
LRU_WIDTH = -(-4 * D_MODEL // (3 * LRU_BLOCK)) * LRU_BLOCK
N_LRU_BLOCKS = LRU_WIDTH // LRU_BLOCK
CONV_WIDTH = 4
LRU_C = 8.0
D_FF = 4 * D_MODEL
N_MOD = 6
EPS = 1e-6
N_LRU_LAYERS = (DEPTH + 1) // 2
N_NA_LAYERS = DEPTH // 2

kernel_name = 'hybrid_rglru_natten_dit_block'


def _rmsnorm(x, g):
    xf = x.astype(jnp.float32)
    xf = xf * lax.rsqrt(jnp.mean(xf * xf, axis=-1, keepdims=True) + EPS)
    return xf.astype(x.dtype) * g


def _modulate(h, shift, scale):
    return h * (1.0 + scale) + shift


def _sq_relu_mlp(h, w1, w2):
    return jnp.square(jax.nn.relu(h @ w1)) @ w2


def _centred_dwconv(u, w, b):
    left = CONV_WIDTH // 2
    right = CONV_WIDTH - 1 - left
    y = lax.conv_general_dilated(u, w[:, None, :].astype(u.dtype), window_strides=(1,),
                                 padding=[(left, right)], dimension_numbers=('NWC', 'WIO', 'NWC'),
                                 feature_group_count=u.shape[-1])
    return y + b


def _block_diag(u, w, b):
    bsz, length, _ = u.shape
    ub = u.reshape(bsz, length, N_LRU_BLOCKS, LRU_BLOCK)
    return (jnp.einsum('blnj,njk->blnk', ub, w) + b).reshape(bsz, length, LRU_WIDTH)


def _rglru_coeffs(u, lam, w_a, b_a, w_x, b_x):
    uf = u.astype(jnp.float32)
    r = jax.nn.sigmoid(_block_diag(uf, w_a.astype(jnp.float32), b_a.astype(jnp.float32)))
    i_g = jax.nn.sigmoid(_block_diag(uf, w_x.astype(jnp.float32), b_x.astype(jnp.float32)))
    log_a = -LRU_C * r * jax.nn.softplus(-lam.astype(jnp.float32))
    a = jnp.exp(log_a)
    b = jnp.sqrt(-jnp.expm1(2.0 * log_a)) * (i_g * uf)
    return a, b


def _linear_scan(a, b, h0):
    def combine(l, r):
        return (l[0] * r[0], r[0] * l[1] + r[1])
    a_cum, h = lax.associative_scan(combine, (a, b), axis=1)
    return h + a_cum * h0[:, None, :]


def _flip(t, direction):
    return t[:, ::-1] if direction == 1 else t


def _rglru_mixer(h, hc, w_in, conv_w, conv_b, lam, w_a, b_a, w_x, b_x, w_out, need_ctx):
    gate, u = jnp.split(h @ w_in, 2, axis=-1)
    if need_ctx:
        gate_c, u_c = jnp.split(hc @ w_in, 2, axis=-1)
    else:
        u_c = hc @ w_in[:, LRU_WIDTH:]
    u = _centred_dwconv(u, conv_w, conv_b)
    u_c = _centred_dwconv(u_c, conv_w, conv_b)
    ys, ys_c = [], []
    for d in range(2):
        a_c, b_c = _rglru_coeffs(_flip(u_c, d), lam[d], w_a[d], b_a[d], w_x[d], b_x[d])
        h_c = _linear_scan(a_c, b_c, jnp.zeros_like(a_c[:, 0]))
        a_l, b_l = _rglru_coeffs(_flip(u, d), lam[d], w_a[d], b_a[d], w_x[d], b_x[d])
        h_l = _linear_scan(a_l, b_l, h_c[:, -1])
        ys.append(_flip(h_l, d))
        if need_ctx:
            ys_c.append(_flip(h_c, d))
    y = (ys[0] + ys[1]).astype(h.dtype)
    out = (jax.nn.gelu(gate) * y) @ w_out
    out_c = None
    if need_ctx:
        y_c = (ys_c[0] + ys_c[1]).astype(hc.dtype)
        out_c = (jax.nn.gelu(gate_c) * y_c) @ w_out
    return out, out_c


def _na_mixer(h, hc, w_qkv, rpb, w_o, need_ctx):
    bsz, length, _ = h.shape
    rows = length // GRID_W
    kh = min(WIN_ROWS_MAX, rows)
    scale = HEAD_DIM ** -0.5
    q, k, v = jnp.split(h @ w_qkv, 3, axis=-1)
    q = q.reshape(bsz, rows, GRID_W, N_HEADS, HEAD_DIM)
    k = k.reshape(bsz, rows, GRID_W, N_HEADS, HEAD_DIM)
    v = v.reshape(bsz, rows, GRID_W, N_HEADS, HEAD_DIM)
    if need_ctx:
        qc, kc, vc = jnp.split(hc @ w_qkv, 3, axis=-1)
        qc = qc.reshape(bsz, CTX_LEN, N_HEADS, HEAD_DIM)
    else:
        kc, vc = jnp.split(hc @ w_qkv[:, D_MODEL:], 2, axis=-1)
    kc = kc.reshape(bsz, CTX_LEN, N_HEADS, HEAD_DIM)
    vc = vc.reshape(bsz, CTX_LEN, N_HEADS, HEAD_DIM)

    cols = jnp.arange(GRID_W)
    col_start = jnp.clip(cols - WIN_COLS // 2, 0, GRID_W - WIN_COLS)
    col_idx = col_start[:, None] + jnp.arange(WIN_COLS)[None, :]
    col_off = col_idx - cols[:, None] + (WIN_COLS - 1)
    bias_cols = rpb[:, :, col_off].astype(jnp.float32)

    def row_block(r):
        rs = jnp.clip(r - kh // 2, 0, rows - kh)
        q_r = lax.dynamic_index_in_dim(q, r, axis=1, keepdims=False)
        k_win = lax.dynamic_slice_in_dim(k, rs, kh, axis=1)[:, :, col_idx]
        v_win = lax.dynamic_slice_in_dim(v, rs, kh, axis=1)[:, :, col_idx]
        row_off = rs + jnp.arange(kh) - r + (WIN_ROWS_MAX - 1)
        bias = jnp.transpose(bias_cols[:, row_off], (0, 2, 1, 3))
        s_loc = jnp.einsum('bwhd,bawkhd->bhwak', q_r, k_win).astype(jnp.float32) * scale + bias[None]
        s_ctx = jnp.einsum('bwhd,bchd->bhwc', q_r, kc).astype(jnp.float32) * scale
        s = jnp.concatenate([s_loc.reshape(bsz, N_HEADS, GRID_W, kh * WIN_COLS), s_ctx], axis=-1)
        p = jax.nn.softmax(s, axis=-1).astype(v.dtype)
        p_loc = p[..., :kh * WIN_COLS].reshape(bsz, N_HEADS, GRID_W, kh, WIN_COLS)
        p_ctx = p[..., kh * WIN_COLS:]
        return (jnp.einsum('bhwak,bawkhd->bwhd', p_loc, v_win)
                + jnp.einsum('bhwc,bchd->bwhd', p_ctx, vc))

    o = lax.map(row_block, jnp.arange(rows))
    o = jnp.transpose(o, (1, 0, 2, 3, 4)).reshape(bsz, length, D_MODEL)
    out = o @ w_o
    out_c = None
    if need_ctx:
        s_c = jnp.einsum('bqhd,bkhd->bhqk', qc, kc).astype(jnp.float32) * scale
        p_c = jax.nn.softmax(s_c, axis=-1).astype(vc.dtype)
        o_c = jnp.einsum('bhqk,bkhd->bqhd', p_c, vc).reshape(bsz, CTX_LEN, D_MODEL)
        out_c = o_c @ w_o
    return out, out_c


def setup_inputs(seed: int = 0) -> dict:
    key = jax.random.key(seed)
    ks = jax.random.split(key, 24)
    f32 = jnp.float32
    nrm = lambda k, shape, s: jax.random.normal(k, shape, f32) * s
    u = jax.random.uniform(ks[12], (N_LRU_LAYERS, 2, LRU_WIDTH), f32, minval=0.9, maxval=0.999)
    s_lam = u ** (1.0 / LRU_C)
    lru_lambda = jnp.log(s_lam) - jnp.log1p(-s_lam)
    return {
        'x': nrm(ks[0], (BATCH, SEQ, D_MODEL), 1.0),
        'c': nrm(ks[1], (BATCH, D_MODEL), 1.0),
        'ctx': nrm(ks[2], (BATCH, CTX_LEN, D_MODEL), 1.0),
        'c_ctx': nrm(ks[3], (D_MODEL,), 1.0),
        'ada_w': nrm(ks[4], (DEPTH, D_MODEL, N_MOD * D_MODEL), 0.5 * D_MODEL ** -0.5),
        'ada_b': nrm(ks[5], (DEPTH, N_MOD * D_MODEL), 0.02),
        'norm1_g': 1.0 + nrm(ks[6], (DEPTH, D_MODEL), 0.02),
        'norm2_g': 1.0 + nrm(ks[7], (DEPTH, D_MODEL), 0.02),
        'mlp_w1': nrm(ks[8], (DEPTH, D_MODEL, D_FF), D_MODEL ** -0.5),
        'mlp_w2': nrm(ks[9], (DEPTH, D_FF, D_MODEL), D_FF ** -0.5),
        'lru_w_in': nrm(ks[10], (N_LRU_LAYERS, D_MODEL, 2 * LRU_WIDTH), D_MODEL ** -0.5),
        'lru_conv_w': nrm(ks[11], (N_LRU_LAYERS, CONV_WIDTH, LRU_WIDTH), CONV_WIDTH ** -0.5),
        'lru_conv_b': nrm(ks[13], (N_LRU_LAYERS, LRU_WIDTH), 0.02),
        'lru_lambda': lru_lambda,
        'lru_wa': nrm(ks[14], (N_LRU_LAYERS, 2, N_LRU_BLOCKS, LRU_BLOCK, LRU_BLOCK), LRU_BLOCK ** -0.5),
        'lru_ba': nrm(ks[15], (N_LRU_LAYERS, 2, N_LRU_BLOCKS, LRU_BLOCK), 0.02),
        'lru_wx': nrm(ks[16], (N_LRU_LAYERS, 2, N_LRU_BLOCKS, LRU_BLOCK, LRU_BLOCK), LRU_BLOCK ** -0.5),
        'lru_bx': nrm(ks[17], (N_LRU_LAYERS, 2, N_LRU_BLOCKS, LRU_BLOCK), 0.02),
        'lru_w_out': nrm(ks[18], (N_LRU_LAYERS, LRU_WIDTH, D_MODEL), LRU_WIDTH ** -0.5),
        'na_w_qkv': nrm(ks[19], (N_NA_LAYERS, D_MODEL, 3 * D_MODEL), D_MODEL ** -0.5),
        'na_rpb': nrm(ks[20], (N_NA_LAYERS, N_HEADS, 2 * WIN_ROWS_MAX - 1, 2 * WIN_COLS - 1), 0.1),
        'na_w_o': nrm(ks[21], (N_NA_LAYERS, D_MODEL, D_MODEL), D_MODEL ** -0.5),
        'final_g': 1.0 + nrm(ks[22], (D_MODEL,), 0.02),
    }


def reference(x, c, ctx, c_ctx, ada_w, ada_b, norm1_g, norm2_g, mlp_w1, mlp_w2,
              lru_w_in, lru_conv_w, lru_conv_b, lru_lambda, lru_wa, lru_ba, lru_wx, lru_bx, lru_w_out,
              na_w_qkv, na_rpb, na_w_o, final_g):
    xc = ctx
    silu_c = jax.nn.silu(c)
    silu_cc = jax.nn.silu(c_ctx)
    for i in range(DEPTH):
        need_ctx = i < DEPTH - 1
        mods = silu_c @ ada_w[i] + ada_b[i]
        sh1, sc1, gt1, sh2, sc2, gt2 = [m[:, None, :] for m in jnp.split(mods, N_MOD, axis=-1)]
        if need_ctx:
            csh1, csc1, cgt1, csh2, csc2, cgt2 = jnp.split(silu_cc @ ada_w[i] + ada_b[i], N_MOD, axis=-1)
        else:
            csh1, csc1 = jnp.split(silu_cc @ ada_w[i][:, :2 * D_MODEL] + ada_b[i][:2 * D_MODEL], 2, axis=-1)
        h = _modulate(_rmsnorm(x, norm1_g[i]), sh1, sc1)
        hc = _modulate(_rmsnorm(xc, norm1_g[i]), csh1, csc1)
        j = i // N_MIXERS
        if i % N_MIXERS == 0:
            out, out_c = _rglru_mixer(h, hc, lru_w_in[j], lru_conv_w[j], lru_conv_b[j], lru_lambda[j],
                                      lru_wa[j], lru_ba[j], lru_wx[j], lru_bx[j], lru_w_out[j], need_ctx)
        else:
            out, out_c = _na_mixer(h, hc, na_w_qkv[j], na_rpb[j], na_w_o[j], need_ctx)
        x = x + gt1 * out
        h2 = _modulate(_rmsnorm(x, norm2_g[i]), sh2, sc2)
        x = x + gt2 * _sq_relu_mlp(h2, mlp_w1[i], mlp_w2[i])
        if need_ctx:
            xc = xc + cgt1 * out_c
            hc2 = _modulate(_rmsnorm(xc, norm2_g[i]), csh2, csc2)
            xc = xc + cgt2 * _sq_relu_mlp(hc2, mlp_w1[i], mlp_w2[i])
    return _rmsnorm(x, final_g)
```

```cpp
#include <hip/hip_runtime.h>
#include <cstdint>
#include <cstdio>

#ifndef FAST_MLP
#define FAST_MLP 1
#endif
#ifndef FAST_NA
#define FAST_NA 1
#endif
#ifndef FAST_LRU
#define FAST_LRU 1
#endif
#ifndef REP_PRO
#define REP_PRO 1
#endif
#ifndef REP_NORM
#define REP_NORM 1
#endif
#ifndef REP_ATTN
#define REP_ATTN 1
#endif
#ifndef REP_SCAN
#define REP_SCAN 1
#endif
#ifndef REP_CONV
#define REP_CONV 1
#endif
#ifndef REP_S1
#define REP_S1 1
#endif
#ifndef REP_S2
#define REP_S2 1
#endif
#ifndef REP_S3
#define REP_S3 1
#endif
#ifndef REP_IN
#define REP_IN 1
#endif
#ifndef REP_GATES
#define REP_GATES 1
#endif
#ifndef REP_MLP1
#define REP_MLP1 1
#endif
#ifndef REP_OUT
#define REP_OUT 1
#endif
#ifndef REP_MLP2
#define REP_MLP2 1
#endif
#ifndef REP_GEMM
#define REP_GEMM 1
#endif
#ifndef ONE_LAUNCH
#define ONE_LAUNCH 1
#endif

namespace cfg {
constexpr int D = 2048, BATCH = 4, SEQ = 2048, DEPTH = 4, GRID_W = 64, CTX = 256, NH = 16, HD = 128;
constexpr int LW = 2816, NLB = 11, LB = 256, FF = 8192, NMOD = 6;
constexpr int ML = BATCH * SEQ, MC = BATCH * CTX, M = ML + MC;
constexpr int MODW = NMOD * D;
}
using namespace cfg;

#define LAS __attribute__((address_space(3)))
#define GAS __attribute__((address_space(1)))
typedef unsigned short bf16_t;
typedef short bf16x8 __attribute__((ext_vector_type(8)));
typedef float f32x4 __attribute__((ext_vector_type(4)));
typedef float f32x2 __attribute__((ext_vector_type(2)));
typedef unsigned u32x4 __attribute__((ext_vector_type(4)));
typedef unsigned u32x2 __attribute__((ext_vector_type(2)));

__device__ __forceinline__ float sigmoidf_(float x) { return 1.f / (1.f + expf(-x)); }
__device__ __forceinline__ float siluf_(float x) { return x * sigmoidf_(x); }
__device__ __forceinline__ float gelu_tanh(float x) { return 0.5f * x * (1.f + tanhf(0.7978845608028654f * (x + 0.044715f * x * x * x))); }
__device__ __forceinline__ int row_mod(int row) { return row < ML ? row / SEQ : 4; }
__device__ __forceinline__ unsigned f2bf(float f) { unsigned u = __builtin_bit_cast(unsigned, f); return (u + 0x7fffu + ((u >> 16) & 1u)) >> 16; }
__device__ __forceinline__ unsigned pk2(float lo, float hi) { return f2bf(lo) | (f2bf(hi) << 16); }
__device__ __forceinline__ float bf_lo(unsigned w) { return __builtin_bit_cast(float, w << 16); }
__device__ __forceinline__ float bf_hi(unsigned w) { return __builtin_bit_cast(float, w & 0xffff0000u); }
__device__ __forceinline__ unsigned cvt_pk_bf16(float lo, float hi) { unsigned r; asm volatile("v_cvt_pk_bf16_f32 %0, %1, %2" : "=v"(r) : "v"(lo), "v"(hi)); return r; }
__device__ __forceinline__ float fast_exp2(float x) { return __builtin_amdgcn_exp2f(x); }
__device__ __forceinline__ float fast_rcp(float x) { return __builtin_amdgcn_rcpf(x); }
__device__ __forceinline__ float fast_sigmoid(float x) { return fast_rcp(1.f + fast_exp2(-1.4426950408889634f * x)); }

namespace nv {
__global__ void k_norm_mod(const float* X, const float* g, const float* mods_l, int sh_idx, float* H, int ldh) {
    const int row = blockIdx.x, tid = threadIdx.x;
    const float* xr = X + (size_t)row * D;
    float v[8], ss = 0.f;
#pragma unroll
    for (int j = 0; j < 8; ++j) { v[j] = xr[tid + 256 * j]; ss += v[j] * v[j]; }
    __shared__ float red[256];
    red[tid] = ss; __syncthreads();
    for (int o = 128; o > 0; o >>= 1) { if (tid < o) red[tid] += red[tid + o]; __syncthreads(); }
    const float rstd = rsqrtf(red[0] / D + 1e-6f);
    const int m = row_mod(row);
#pragma unroll
    for (int j = 0; j < 8; ++j) {
        const int col = tid + 256 * j; float h = v[j] * rstd * g[col];
        if (sh_idx >= 0) { const float sh = mods_l[(size_t)m * MODW + sh_idx * D + col], sc = mods_l[(size_t)m * MODW + (sh_idx + 1) * D + col]; h = h * (1.f + sc) + sh; }
        H[(size_t)row * ldh + col] = h;
    }
}
__global__ __launch_bounds__(256) void k_sgemm(const float* A, int lda, size_t sA, const float* B, int ldb, size_t sB, float* C, int ldc, size_t sC, int K) {
    __shared__ float As[16][128 + 4], Bs[16][128 + 4];
    A += blockIdx.z * sA; B += blockIdx.z * sB; C += blockIdx.z * sC;
    const int tid = threadIdx.x, tx = tid & 15, ty = tid >> 4;
    const int m0 = blockIdx.y * 128, n0 = blockIdx.x * 128;
    float acc[8][8];
#pragma unroll
    for (int i = 0; i < 8; ++i)
#pragma unroll
        for (int j = 0; j < 8; ++j) acc[i][j] = 0.f;
    for (int k0 = 0; k0 < K; k0 += 16) {
#pragma unroll
        for (int i = 0; i < 2; ++i) {
            const int r = (tid >> 2) + 64 * i, kq = (tid & 3) * 4;
            const float4 a = *(const float4*)(A + (size_t)(m0 + r) * lda + k0 + kq);
            As[kq + 0][r] = a.x; As[kq + 1][r] = a.y; As[kq + 2][r] = a.z; As[kq + 3][r] = a.w;
            const int kk = (tid >> 5) + 8 * i, nq = (tid & 31) * 4;
            const float4 b = *(const float4*)(B + (size_t)(k0 + kk) * ldb + n0 + nq);
            *(float4*)&Bs[kk][nq] = b;
        }
        __syncthreads();
#pragma unroll
        for (int k = 0; k < 16; ++k) {
            float a[8], b[8];
            *(float4*)&a[0] = *(const float4*)&As[k][ty * 4]; *(float4*)&a[4] = *(const float4*)&As[k][64 + ty * 4];
            *(float4*)&b[0] = *(const float4*)&Bs[k][tx * 4]; *(float4*)&b[4] = *(const float4*)&Bs[k][64 + tx * 4];
#pragma unroll
            for (int i = 0; i < 8; ++i)
#pragma unroll
                for (int j = 0; j < 8; ++j) acc[i][j] += a[i] * b[j];
        }
        __syncthreads();
    }
#pragma unroll
    for (int i = 0; i < 8; ++i) {
        const int r = m0 + (i < 4 ? ty * 4 + i : 64 + ty * 4 + i - 4);
        *(float4*)(C + (size_t)r * ldc + n0 + tx * 4) = make_float4(acc[i][0], acc[i][1], acc[i][2], acc[i][3]);
        *(float4*)(C + (size_t)r * ldc + n0 + 64 + tx * 4) = make_float4(acc[i][4], acc[i][5], acc[i][6], acc[i][7]);
    }
}
__global__ void k_resid(float* X, const float* O, const float* mods_l, int g_idx, int rows) {
    const size_t i = (size_t)blockIdx.x * 256 + threadIdx.x; if (i >= (size_t)rows * D) return;
    const int row = i / D, col = i % D, m = row_mod(row);
    X[i] += mods_l[(size_t)m * MODW + g_idx * D + col] * O[i];
}
__global__ void k_sqrelu(float* A, size_t n) { const size_t i = (size_t)blockIdx.x * 256 + threadIdx.x; if (i < n) { const float v = fmaxf(A[i], 0.f); A[i] = v * v; } }
__global__ void k_conv(const float* GU, const float* cw, const float* cb, float* UC) {
    const size_t i = (size_t)blockIdx.x * 256 + threadIdx.x; if (i >= (size_t)M * LW) return;
    const int row = i / LW, c = i % LW;
    int seg0, seglen; if (row < ML) { seg0 = (row / SEQ) * SEQ; seglen = SEQ; } else { seg0 = ML + ((row - ML) / CTX) * CTX; seglen = CTX; }
    const int t = row - seg0; float s = cb[c];
    for (int j = 0; j < 4; ++j) { const int tt = t + j - 2; if (tt >= 0 && tt < seglen) s += cw[j * LW + c] * GU[(size_t)(seg0 + tt) * (2 * LW) + LW + c]; }
    UC[i] = s;
}
__global__ void k_lru_coef(float* RA, float* RX, const float* UC, const float* ba, const float* bx, const float* lam) {
    const size_t i = (size_t)blockIdx.x * 256 + threadIdx.x; if (i >= (size_t)M * LW) return;
    const int c = i % LW;
    const float r = sigmoidf_(RA[i] + ba[c]), ig = sigmoidf_(RX[i] + bx[c]);
    const float sp = log1pf(expf(-lam[c]));
    const float log_a = -8.f * r * sp;
    RA[i] = expf(log_a);
    RX[i] = sqrtf(-expm1f(2.f * log_a)) * (ig * UC[i]);
}
__global__ void k_scan_dir(const float* A, const float* Bc, float* Y, int dir) {
    const int idx = blockIdx.x * 256 + threadIdx.x; if (idx >= BATCH * LW) return;
    const int b = idx / LW, c = idx % LW;
    float h = 0.f;
    if (dir == 0) {
        for (int t = 0; t < CTX; ++t) { const size_t o = (size_t)(ML + b * CTX + t) * LW + c; h = A[o] * h + Bc[o]; Y[o] = h; }
        for (int t = 0; t < SEQ; ++t) { const size_t o = (size_t)(b * SEQ + t) * LW + c; h = A[o] * h + Bc[o]; Y[o] = h; }
    } else {
        for (int t = CTX - 1; t >= 0; --t) { const size_t o = (size_t)(ML + b * CTX + t) * LW + c; h = A[o] * h + Bc[o]; Y[o] += h; }
        for (int t = SEQ - 1; t >= 0; --t) { const size_t o = (size_t)(b * SEQ + t) * LW + c; h = A[o] * h + Bc[o]; Y[o] += h; }
    }
}
__global__ void k_gate_mul(const float* GU, const float* Y, float* Z) {
    const size_t i = (size_t)blockIdx.x * 256 + threadIdx.x; if (i >= (size_t)M * LW) return;
    const int row = i / LW, c = i % LW;
    Z[i] = gelu_tanh(GU[(size_t)row * (2 * LW) + c]) * Y[i];
}
__global__ __launch_bounds__(256) void k_attn(const float* QKV, const float* rpb_l, float* O) {
    __shared__ float qs[4][HD], ps[4][384];
    const int w = threadIdx.x >> 6, lane = threadIdx.x & 63;
    const int gw = blockIdx.x * 4 + w; const int row = gw / NH, h = gw % NH;
    const bool lat = row < ML;
    const int b = lat ? row / SEQ : (row - ML) / CTX;
    const int t = lat ? row % SEQ : 0, r = t / GRID_W, c = t % GRID_W;
    int rs = r - 4; rs = rs < 0 ? 0 : (rs > 24 ? 24 : rs);
    int cs = c - 8; cs = cs < 0 ? 0 : (cs > 48 ? 48 : cs);
    const float scale = 0.08838834764831845f;
    qs[w][lane] = QKV[(size_t)row * (3 * D) + h * HD + lane]; qs[w][lane + 64] = QKV[(size_t)row * (3 * D) + h * HD + lane + 64];
    __syncthreads();
    float s[6]; float mx = -1e30f;
#pragma unroll
    for (int i = 0; i < 6; ++i) {
        const int j = lane + 64 * i; int krow; float bias = 0.f; bool valid = true;
        if (j < 128) { const int a = j >> 4, kk = j & 15; krow = b * SEQ + (rs + a) * GRID_W + cs + kk; bias = rpb_l[(h * 15 + (rs + a - r + 7)) * 31 + (cs + kk - c + 15)]; valid = lat; }
        else krow = ML + b * CTX + (j - 128);
        float d = 0.f;
        if (valid) { const float* kp = QKV + (size_t)krow * (3 * D) + D + h * HD; for (int e = 0; e < HD; ++e) d += qs[w][e] * kp[e]; d = d * scale + bias; } else d = -1e30f;
        s[i] = d; mx = fmaxf(mx, d);
    }
    for (int o = 32; o > 0; o >>= 1) mx = fmaxf(mx, __shfl_xor(mx, o));
    float sum = 0.f;
#pragma unroll
    for (int i = 0; i < 6; ++i) { const float p = (s[i] <= -1e29f) ? 0.f : expf(s[i] - mx); s[i] = p; sum += p; }
    for (int o = 32; o > 0; o >>= 1) sum += __shfl_xor(sum, o);
    const float inv = 1.f / sum;
#pragma unroll
    for (int i = 0; i < 6; ++i) ps[w][lane + 64 * i] = s[i] * inv;
    __syncthreads();
    float o0 = 0.f, o1 = 0.f;
    for (int j = lat ? 0 : 128; j < 384; ++j) {
        int krow; if (j < 128) { const int a = j >> 4, kk = j & 15; krow = b * SEQ + (rs + a) * GRID_W + cs + kk; } else krow = ML + b * CTX + (j - 128);
        const float* vp = QKV + (size_t)krow * (3 * D) + 2 * D + h * HD; const float p = ps[w][j];
        o0 += p * vp[lane]; o1 += p * vp[lane + 64];
    }
    O[(size_t)row * D + h * HD + lane] = o0; O[(size_t)row * D + h * HD + lane + 64] = o1;
}
}

namespace pg8 {
constexpr int BM = 256, BK = 64, HALF = 128, HTB = HALF * BK * 2, STAGE_BYTES = 8 * HTB, NXCD = 8, WGM = 4;
__host__ __device__ __forceinline__ int lds_byte(int r, int c) { const int st = (r >> 4) * 2 + (c >> 5), rr = r & 15, cc = c & 31, ob = rr * 64 + cc * 2; return st * 1024 + (ob ^ (((ob >> 9) & 1) << 5)); }
__host__ __device__ __forceinline__ void stage_rc(int b, int& R, int& C) { const int st = b / 1024, sb = b % 1024, swz = sb ^ (((sb >> 9) & 1) << 5); R = (st >> 1) * 16 + swz / 64; C = (st & 1) * 32 + (swz % 64) / 2; }
__host__ __device__ __forceinline__ int perm32(int rho) { const int n = rho >> 4, i = rho & 15; return 8 * (i >> 2) + 4 * n + (i & 3); }
struct Unit { int pm, pn, sw, ks; };
struct Gemm { const bf16_t* A; const bf16_t* Bt; int lda, ldb, K, apn_shift; const bf16_t* A2; const bf16_t* Bt2; int ksplit; };
__device__ __forceinline__ int gemm_cc(int U, int G) { if (G & 7) return G; const int R = (U + G - 1) / G; int c = (U + R - 1) / R; c = (c + 7) & ~7; return c > G ? G : c; }
constexpr int CC_TAB_OFF = 131072 + 512;
struct StaticOrder {
    int nM, nN, nwg, G, c, nM2, nN2, nwg2, split;
    __device__ void init(int nM_, int nN_, int G_, int c_, int nM2_ = 0, int nN2_ = 0, int split_ = 0) { nM = nM_; nN = nN_; nwg = nM * nN; G = G_; c = c_; nM2 = nM2_; nN2 = nN2_; split = split_; nwg2 = split_ ? nM2 * nN2 * 8 : nM2 * nN2; }
    __device__ static void map(int wgid, int nM, int nN, int nwg, Unit& u) {
        { const int q = nwg / NXCD, r = nwg % NXCD, xcd = wgid % NXCD, off = wgid / NXCD; wgid = (xcd < r ? xcd * (q + 1) : r * (q + 1) + (xcd - r) * q) + off; }
        const int nig = WGM * nN, gid = wgid / nig, fm = gid * WGM, gsz = (nM - fm) < WGM ? (nM - fm) : WGM;
        u.pm = fm + ((wgid % nig) % gsz); u.pn = (wgid % nig) / gsz;
    }
    __device__ bool next(int i, Unit& u, const LAS unsigned char* lds, int cck) const {
        int Gs = G, cs = c; if (cck) { Gs = __builtin_amdgcn_readfirstlane(*(volatile const LAS int*)(lds + CC_TAB_OFF + 4 * cck)); cs = c < Gs ? c : (1 << 28); }
        const long L = (long)i * Gs + cs; if ((unsigned long)L >= (unsigned long)(nwg + nwg2)) return false;
        u.ks = 0;
        if (L < nwg) { map((int)L, nM, nN, nwg, u); u.sw = 0; }
        else if (!split) { map((int)L - nwg, nM2, nN2, nwg2, u); u.sw = 1; }
        else { const int L2 = (int)L - nwg; int tile, ks;
            if (nwg2 == 256) { const int x = L2 & 7, jj = L2 >> 3; tile = x * 4 + (jj >> 3); ks = jj & 7; } else { tile = L2 >> 3; ks = L2 & 7; }
            u.pm = nM + tile / nN2; u.pn = tile % nN2; u.sw = 1; u.ks = ks; }
        return true;
    }
};
template <class Epi, bool ALIGN_EPI, bool SP2, int CCK = 0>
__device__ __forceinline__ void gemm_phase(LAS unsigned char* lds, const Gemm g, const StaticOrder& S, const Epi& E) {
    int tid = threadIdx.x; asm volatile("" : "+v"(tid));
    const int wid = __builtin_amdgcn_readfirstlane(tid >> 6), lane = tid & 63, wr = wid >> 2, wc = wid & 3, fr = lane & 15, fq = lane >> 4;
    const int KT = g.K / BK, spl_e = (KT / 8) & ~1, spl_x = (KT - 8 * spl_e) / 2;
    unsigned voffA[2], voffB[2];
#pragma unroll
    for (int i = 0; i < 2; ++i) { int R, C; stage_rc(tid * 16 + i * 8192, R, C); const int Rb = Epi::PERM ? ((R & ~31) + perm32(R & 31)) : R;
        voffA[i] = (unsigned)(R * g.lda + C) * 2u; voffB[i] = (unsigned)(Rb * g.ldb + C) * 2u; }
    const size_t kstep = (size_t)(BK * 2);
    const size_t hstepA = (size_t)HALF * g.lda * 2, tstepA = 2 * hstepA, hstepB = (size_t)HALF * g.ldb * 2, tstepB = 2 * hstepB;
    const unsigned ldsw = (unsigned)wid * 1024u;
    const int aoff = lds_byte(wr * 64 + fr, fq * 8), boff = lds_byte(wc * 32 + fr, fq * 8);
#define PG8_SA(b, h) (((b) * 2 + (h)) * HTB)
#define PG8_SB(b, h) ((4 + (b) * 2 + (h)) * HTB)
#define PG8_STAGE(bufoff, gbase, voff) do { _Pragma("unroll") for (int _i = 0; _i < 2; ++_i) \
        __builtin_amdgcn_global_load_lds((const unsigned*)((const char*)(gbase) + (voff)[_i]), (LAS unsigned*)(lds + (bufoff) + ldsw + _i * 8192), 16, 0, 0); } while (0)
#define PG8_LDA(dst, b, h) do { _Pragma("unroll") for (int m = 0; m < 4; ++m) _Pragma("unroll") for (int k = 0; k < 2; ++k) dst[m][k] = *(const LAS bf16x8*)(lds + PG8_SA(b, h) + aoff + m * 2048 + k * 1024); } while (0)
#define PG8_LDB(dst, b, h) do { _Pragma("unroll") for (int n = 0; n < 2; ++n) _Pragma("unroll") for (int k = 0; k < 2; ++k) dst[n][k] = *(const LAS bf16x8*)(lds + PG8_SB(b, h) + boff + n * 2048 + k * 1024); } while (0)
#define PG8_MMA(ai, bj, At, Bt) do { __builtin_amdgcn_s_setprio(1); _Pragma("unroll") for (int m = 0; m < 4; ++m) _Pragma("unroll") for (int n = 0; n < 2; ++n) _Pragma("unroll") for (int k = 0; k < 2; ++k) \
        acc[ai][bj][m][n] = __builtin_amdgcn_mfma_f32_16x16x32_bf16(Bt[n][k], At[m][k], acc[ai][bj][m][n], 0, 0, 0); __builtin_amdgcn_s_setprio(0); } while (0)
#define PG8_WAIT_V(n) asm volatile("s_waitcnt vmcnt(" #n ")" ::: "memory")
#define PG8_WAIT_L(n) asm volatile("s_waitcnt lgkmcnt(" #n ")" ::: "memory")
#define PG8_BAR __builtin_amdgcn_s_barrier()
#define PG8_SCHED __builtin_amdgcn_sched_barrier(0)
#define PG8_KOFF(u) ((g.ksplit && (u).sw) ? (size_t)(spl_e * (u).ks + 2 * ((u).ks < spl_x ? (u).ks : spl_x)) * kstep : (size_t)0)
#define PG8_NT(u) ((g.ksplit && (u).sw) ? spl_e + ((u).ks < spl_x ? 2 : 0) : KT)
#define PG8_APTR(u) ((const char*)((u).sw ? g.A2 : g.A) + (size_t)(u).pm * tstepA + (g.apn_shift >= 0 ? (size_t)((u).pn >> g.apn_shift) * 512 : (size_t)0) + PG8_KOFF(u))
#define PG8_BPTR(u) ((const char*)((u).sw ? g.Bt2 : g.Bt) + (size_t)(u).pn * tstepB + PG8_KOFF(u))
    Unit cur, nxt; int ui = 0;
    if (!S.next(0, cur, lds, CCK)) return;
    f32x4 acc[2][2][4][2];
#pragma unroll
    for (int a = 0; a < 2; ++a)
#pragma unroll
        for (int b = 0; b < 2; ++b)
#pragma unroll
            for (int m = 0; m < 4; ++m)
#pragma unroll
                for (int n = 0; n < 2; ++n) acc[a][b][m][n] = (f32x4){0.f, 0.f, 0.f, 0.f};
    bf16x8 At[4][2], B0[2][2], B1[2][2];
    const char* cA = PG8_APTR(cur); const char* cB = PG8_BPTR(cur); int nt = PG8_NT(cur);
    if constexpr (SP2) {
        PG8_STAGE(PG8_SB(0, 0), cB, voffB); PG8_STAGE(PG8_SB(0, 1), cB + hstepB, voffB); PG8_STAGE(PG8_SA(0, 0), cA, voffA); PG8_STAGE(PG8_SA(0, 1), cA + hstepA, voffA);
        if (wr == 1) PG8_BAR;
        PG8_WAIT_V(2); PG8_BAR;
        PG8_STAGE(PG8_SB(1, 0), cB + kstep, voffB); PG8_STAGE(PG8_SA(1, 0), cA + kstep, voffA); PG8_STAGE(PG8_SB(1, 1), cB + hstepB + kstep, voffB);
        PG8_WAIT_V(6); PG8_BAR;
    } else {
        PG8_STAGE(PG8_SB(0, 0), cB, voffB); PG8_STAGE(PG8_SA(0, 0), cA, voffA); PG8_STAGE(PG8_SB(0, 1), cB + hstepB, voffB); PG8_STAGE(PG8_SA(0, 1), cA + hstepA, voffA);
        if (wr == 1) PG8_BAR;
        PG8_WAIT_V(4); PG8_BAR;
        PG8_STAGE(PG8_SB(1, 0), cB + kstep, voffB); PG8_STAGE(PG8_SA(1, 0), cA + kstep, voffA); PG8_STAGE(PG8_SB(1, 1), cB + hstepB + kstep, voffB);
        PG8_WAIT_V(6); PG8_BAR;
    }
    for (;;) {
        const bool has_next = S.next(ui + 1, nxt, lds, CCK);
        const char* nA = has_next ? PG8_APTR(nxt) : cA; const char* nB = has_next ? PG8_BPTR(nxt) : cB;
        for (int t = 0; t < nt; t += 2) {
            const bool last = (t == nt - 2);
            const char* a1 = cA + (size_t)(t + 1) * kstep;
            const char* a2 = last ? nA : cA + (size_t)(t + 2) * kstep; const char* b2 = last ? nB : cB + (size_t)(t + 2) * kstep;
            const char* a3 = a2 + kstep; const char* b3 = b2 + kstep;
            if constexpr (SP2) {
            PG8_LDB(B0, 0, 0); PG8_LDB(B1, 0, 1); PG8_SCHED; PG8_LDA(At, 0, 0); PG8_STAGE(PG8_SA(1, 1), a1 + hstepA, voffA);
            PG8_WAIT_V(8); PG8_WAIT_L(0); PG8_BAR; PG8_MMA(0, 0, At, B0); PG8_MMA(0, 1, At, B1); PG8_BAR; PG8_SCHED;
            PG8_LDA(At, 0, 1); PG8_STAGE(PG8_SB(0, 0), b2, voffB); PG8_STAGE(PG8_SB(0, 1), b2 + hstepB, voffB); PG8_STAGE(PG8_SA(0, 0), a2, voffA);
            PG8_WAIT_V(8); PG8_WAIT_L(0); PG8_BAR; PG8_MMA(1, 0, At, B0); PG8_MMA(1, 1, At, B1); PG8_BAR; PG8_SCHED;
            PG8_LDB(B0, 1, 0); PG8_LDB(B1, 1, 1); PG8_SCHED; PG8_LDA(At, 1, 0); PG8_STAGE(PG8_SA(0, 1), a2 + hstepA, voffA);
            PG8_WAIT_V(8); PG8_WAIT_L(0); PG8_BAR; PG8_MMA(0, 0, At, B0); PG8_MMA(0, 1, At, B1); PG8_BAR; PG8_SCHED;
            PG8_LDA(At, 1, 1); PG8_STAGE(PG8_SB(1, 0), b3, voffB); PG8_STAGE(PG8_SB(1, 1), b3 + hstepB, voffB); PG8_STAGE(PG8_SA(1, 0), a3, voffA);
            PG8_WAIT_V(8); PG8_WAIT_L(0); PG8_BAR; PG8_MMA(1, 0, At, B0); PG8_MMA(1, 1, At, B1); PG8_BAR; PG8_SCHED;
            } else {
            PG8_LDB(B0, 0, 0); PG8_SCHED; PG8_LDA(At, 0, 0); PG8_STAGE(PG8_SA(1, 1), a1 + hstepA, voffA);
            PG8_WAIT_L(8); PG8_BAR; PG8_WAIT_L(0); PG8_MMA(0, 0, At, B0); PG8_BAR; PG8_SCHED;
            PG8_LDB(B1, 0, 1); PG8_STAGE(PG8_SB(0, 0), b2, voffB);
            PG8_BAR; PG8_WAIT_L(0); PG8_MMA(0, 1, At, B1); PG8_BAR;
            PG8_LDA(At, 0, 1); PG8_STAGE(PG8_SA(0, 0), a2, voffA);
            PG8_BAR; PG8_WAIT_L(0); PG8_MMA(1, 0, At, B0); PG8_BAR; PG8_SCHED;
            PG8_STAGE(PG8_SB(0, 1), b2 + hstepB, voffB);
            PG8_WAIT_V(6); PG8_BAR; PG8_MMA(1, 1, At, B1); PG8_BAR;
            PG8_LDB(B0, 1, 0); PG8_SCHED; PG8_LDA(At, 1, 0); PG8_STAGE(PG8_SA(0, 1), a2 + hstepA, voffA);
            PG8_WAIT_L(8); PG8_BAR; PG8_WAIT_L(0); PG8_MMA(0, 0, At, B0); PG8_BAR; PG8_SCHED;
            PG8_LDB(B1, 1, 1); PG8_STAGE(PG8_SB(1, 0), b3, voffB);
            PG8_BAR; PG8_WAIT_L(0); PG8_MMA(0, 1, At, B1); PG8_BAR;
            PG8_LDA(At, 1, 1); PG8_STAGE(PG8_SA(1, 0), a3, voffA);
            PG8_BAR; PG8_WAIT_L(0); PG8_MMA(1, 0, At, B0); PG8_BAR; PG8_SCHED;
            PG8_STAGE(PG8_SB(1, 1), b3 + hstepB, voffB);
            PG8_WAIT_V(6); PG8_BAR; PG8_MMA(1, 1, At, B1); PG8_BAR;
            }
        }
        if constexpr (ALIGN_EPI) { if (wr == 0) PG8_BAR; }
        { int tz = threadIdx.x; asm volatile("" : "+v"(tz));
          const int wz = __builtin_amdgcn_readfirstlane(tz >> 6), lz = tz & 63; E(acc, cur, wz >> 2, wz & 3, lz & 15, lz >> 4); }
        if (!has_next) break;
#pragma unroll
        for (int a = 0; a < 2; ++a)
#pragma unroll
            for (int b = 0; b < 2; ++b)
#pragma unroll
                for (int m = 0; m < 4; ++m)
#pragma unroll
                    for (int n = 0; n < 2; ++n) acc[a][b][m][n] = (f32x4){0.f, 0.f, 0.f, 0.f};
        cur = nxt; cA = nA; cB = nB; ++ui; nt = PG8_NT(cur);
        if constexpr (ALIGN_EPI) { if (wr == 1) PG8_BAR; }
    }
    PG8_WAIT_V(0);
    if constexpr (!ALIGN_EPI) { if (wr == 0) PG8_BAR; }
    PG8_BAR;
#undef PG8_SA
#undef PG8_SB
#undef PG8_STAGE
#undef PG8_LDA
#undef PG8_LDB
#undef PG8_MMA
#undef PG8_WAIT_V
#undef PG8_WAIT_L
#undef PG8_BAR
#undef PG8_SCHED
#undef PG8_APTR
#undef PG8_BPTR
#undef PG8_KOFF
#undef PG8_NT
}

template <int ACT> struct EpiAct {
    static constexpr bool PERM = true;
    bf16_t* O; int ldc;
    __device__ __forceinline__ void operator()(const f32x4 (&acc)[2][2][4][2], const Unit& u, int wr, int wc, int fr, int fq) const {
        const int row0 = u.pm * BM + wr * 64 + fr, col0 = u.pn * BM + wc * 32 + 8 * fq;
#pragma unroll
        for (int ai = 0; ai < 2; ++ai)
#pragma unroll
            for (int m = 0; m < 4; ++m) { bf16_t* rowp = O + (size_t)(row0 + ai * HALF + m * 16) * ldc + col0;
#pragma unroll
                for (int bj = 0; bj < 2; ++bj) { f32x4 v0 = acc[ai][bj][m][0], v1 = acc[ai][bj][m][1];
                    if (ACT == 1) {
#pragma unroll
                        for (int j = 0; j < 4; ++j) { const float a = fmaxf(v0[j], 0.f), b = fmaxf(v1[j], 0.f); v0[j] = a * a; v1[j] = b * b; } }
                    u32x4 w; w.x = cvt_pk_bf16(v0[0], v0[1]); w.y = cvt_pk_bf16(v0[2], v0[3]); w.z = cvt_pk_bf16(v1[0], v1[1]); w.w = cvt_pk_bf16(v1[2], v1[3]);
                    *(u32x4*)(rowp + bj * HALF) = w; } }
    }
};
constexpr long long RN_DXN = (471ll - 399ll) << 20;
constexpr long long RN_DSLOT = (838ll - 399ll) << 20;
constexpr long long RN_DCNT = 131072ll - (399ll << 20);
constexpr int RN_LDS = 131072 + 4096;
template <bool XF32, int FUSE = 0  > struct EpiResidT {
    static constexpr bool PERM = true;
    bf16_t* X; const float* mods_l; int gidx; float* slab; const float* xin; const float* ng; int nsh_off; unsigned want; LAS unsigned char* lds;
    __device__ __forceinline__ void fuse_tail(f32x4 (&acc)[2][2][4][2], const float (&ssq)[2][4], const Unit& u, int wr, int wc, int fr, int fq, int mi, int row0, int col0) const {
        LAS float* P = (LAS float*)(lds + RN_LDS); LAS float* S = P + 1024; LAS unsigned* flag = (LAS unsigned*)(S + 256);
        const int wid = wr * 4 + wc, lane = fq * 16 + fr;
#pragma unroll
        for (int ai = 0; ai < 2; ++ai)
#pragma unroll
            for (int m = 0; m < 4; ++m) { float t = ssq[ai][m]; t += __shfl_xor(t, 16); t += __shfl_xor(t, 32);
                if (fq == 0) P[(ai * HALF + wr * 64 + m * 16 + fr) * 4 + wc] = t; }
        asm volatile("s_waitcnt lgkmcnt(0)" ::: "memory"); __builtin_amdgcn_s_barrier(); asm volatile("" ::: "memory");
        const int row = wid * 32 + (lane & 31);
        unsigned* slots = (unsigned*)((char*)X + RN_DSLOT) + ((size_t)(u.pm * BM + row) * 8);
        unsigned* pc = (unsigned*)((char*)X + RN_DCNT) + 64 * u.pm;
        if (lane < 32) { const f32x4 p = *(const LAS f32x4*)(P + row * 4); const float t = (p[0] + p[1]) + (p[2] + p[3]);
            __hip_atomic_store(slots + u.pn, __builtin_bit_cast(unsigned, t), __ATOMIC_RELAXED, __HIP_MEMORY_SCOPE_AGENT); }
        asm volatile("s_waitcnt vmcnt(0)" ::: "memory");
        if (lane == 0) __hip_atomic_fetch_add(pc, 1u, __ATOMIC_RELAXED, __HIP_MEMORY_SCOPE_AGENT);
        if (FUSE == 1 && !XF32) {
            int r0o = row0; asm volatile("" : "+v"(r0o)); bf16_t* xb = X + (size_t)r0o * D + col0;
#pragma unroll
            for (int ai = 0; ai < 2; ++ai)
#pragma unroll
                for (int m = 0; m < 4; ++m)
#pragma unroll
                    for (int bj = 0; bj < 2; ++bj) { const f32x4 v0 = acc[ai][bj][m][0], v1 = acc[ai][bj][m][1];
                        u32x4 w; w.x = cvt_pk_bf16(v0[0], v0[1]); w.y = cvt_pk_bf16(v0[2], v0[3]); w.z = cvt_pk_bf16(v1[0], v1[1]); w.w = cvt_pk_bf16(v1[2], v1[3]);
                        *(u32x4*)(xb + (size_t)(ai * HALF + m * 16) * D + bj * HALF) = w; }
        }
        if (wid == 0) { unsigned sp = 0u;
            while ((unsigned)__builtin_amdgcn_readfirstlane((int)__hip_atomic_load(pc, __ATOMIC_RELAXED, __HIP_MEMORY_SCOPE_AGENT)) < want) { __builtin_amdgcn_s_sleep(1); if (++sp > (1u << 18)) break; }
            __builtin_amdgcn_fence(__ATOMIC_ACQUIRE, "agent"); }
        asm volatile("s_waitcnt lgkmcnt(0)" ::: "memory"); __builtin_amdgcn_s_barrier(); asm volatile("" ::: "memory");
        if (lane < 32) { float t = 0.f;
#pragma unroll
            for (int k = 0; k < 8; ++k) t += __builtin_bit_cast(float, __hip_atomic_load(slots + k, __ATOMIC_RELAXED, __HIP_MEMORY_SCOPE_AGENT));
            S[row] = rsqrtf(t * (1.f / D) + 1e-6f); }
        asm volatile("s_waitcnt lgkmcnt(0)" ::: "memory"); __builtin_amdgcn_s_barrier(); asm volatile("" ::: "memory");
        if (FUSE == 2) {
            float* ob = slab + (size_t)row0 * D + col0;
#pragma unroll
            for (int bj = 0; bj < 2; ++bj) { const f32x4 G0 = *(const f32x4*)(ng + col0 + bj * HALF), G1 = *(const f32x4*)(ng + col0 + bj * HALF + 4);
#pragma unroll
                for (int ai = 0; ai < 2; ++ai)
#pragma unroll
                    for (int m = 0; m < 4; ++m) { const float rstd = S[ai * HALF + wr * 64 + m * 16 + fr];
                        *(f32x4*)(ob + (size_t)(ai * HALF + m * 16) * D + bj * HALF) = acc[ai][bj][m][0] * rstd * G0; *(f32x4*)(ob + (size_t)(ai * HALF + m * 16) * D + bj * HALF + 4) = acc[ai][bj][m][1] * rstd * G1; } }
            return;
        }
        bf16_t* XN = (bf16_t*)((char*)X + RN_DXN);
        const float* sh = mods_l + nsh_off + (size_t)mi * MODW + col0;
#pragma unroll
        for (int bj = 0; bj < 2; ++bj) { f32x4 GG[2], SS[2];
#pragma unroll
            for (int n = 0; n < 2; ++n) { GG[n] = *(const f32x4*)(ng + col0 + bj * HALF + 4 * n) * (*(const f32x4*)(sh + D + bj * HALF + 4 * n) + 1.f); SS[n] = *(const f32x4*)(sh + bj * HALF + 4 * n); }
#pragma unroll
            for (int ai = 0; ai < 2; ++ai)
#pragma unroll
                for (int m = 0; m < 4; ++m) { const float rstd = S[ai * HALF + wr * 64 + m * 16 + fr];
                    const f32x4 h0 = acc[ai][bj][m][0] * rstd * GG[0] + SS[0], h1 = acc[ai][bj][m][1] * rstd * GG[1] + SS[1];
                    u32x4 w; w.x = cvt_pk_bf16(h0[0], h0[1]); w.y = cvt_pk_bf16(h0[2], h0[3]); w.z = cvt_pk_bf16(h1[0], h1[1]); w.w = cvt_pk_bf16(h1[2], h1[3]);
                    *(u32x4*)(XN + (size_t)(row0 + ai * HALF + m * 16) * D + col0 + bj * HALF) = w; } }
    }
    __device__ __forceinline__ void operator()(f32x4 (&acc)[2][2][4][2], const Unit& u, int wr, int wc, int fr, int fq) const {
        if (u.sw) {
            bf16_t* base = (bf16_t*)slab + (size_t)(((u.pm - 32) * 8 + u.pn) * 8 + u.ks) * 65536 + (size_t)(wr * 64 + fr) * 256 + wc * 32 + 8 * fq;
#pragma unroll
            for (int ai = 0; ai < 2; ++ai)
#pragma unroll
                for (int m = 0; m < 4; ++m)
#pragma unroll
                    for (int bj = 0; bj < 2; ++bj) { const f32x4 v0 = acc[ai][bj][m][0], v1 = acc[ai][bj][m][1];
                        u32x4 w; w.x = cvt_pk_bf16(v0[0], v0[1]); w.y = cvt_pk_bf16(v0[2], v0[3]); w.z = cvt_pk_bf16(v1[0], v1[1]); w.w = cvt_pk_bf16(v1[2], v1[3]);
                        *(u32x4*)(base + (size_t)(ai * HALF + m * 16) * 256 + bj * HALF) = w; }
            return;
        }
        const int row0 = u.pm * BM + wr * 64 + fr, col0 = u.pn * BM + wc * 32 + 8 * fq;
        const int mi = u.pm < 32 ? (u.pm >> 3) : 4;
        const float* gt = mods_l + (size_t)mi * MODW + gidx * D + col0;
        f32x4 gv[2][2];
#pragma unroll
        for (int bj = 0; bj < 2; ++bj)
#pragma unroll
            for (int n = 0; n < 2; ++n) gv[bj][n] = *(const f32x4*)(gt + bj * HALF + 4 * n);
        float ssq[2][4];
#pragma unroll
        for (int ai = 0; ai < 2; ++ai)
#pragma unroll
            for (int m = 0; m < 4; ++m) ssq[ai][m] = 0.f;
        if (XF32) {
#pragma unroll
            for (int am = 0; am < 4; ++am) { const int ai = am >> 1, m0 = (am & 1) * 2;
                f32x4 xf[2][2][2];
#pragma unroll
                for (int mm = 0; mm < 2; ++mm)
#pragma unroll
                    for (int bj = 0; bj < 2; ++bj)
#pragma unroll
                        for (int n = 0; n < 2; ++n) xf[mm][bj][n] = *(const f32x4*)(xin + (size_t)(row0 + ai * HALF + (m0 + mm) * 16) * D + col0 + bj * HALF + 4 * n);
                __builtin_amdgcn_sched_barrier(0);
#pragma unroll
                for (int mm = 0; mm < 2; ++mm)
#pragma unroll
                    for (int bj = 0; bj < 2; ++bj) { const f32x4 v0 = xf[mm][bj][0] + gv[bj][0] * acc[ai][bj][m0 + mm][0], v1 = xf[mm][bj][1] + gv[bj][1] * acc[ai][bj][m0 + mm][1];
                        if (FUSE) { acc[ai][bj][m0 + mm][0] = v0; acc[ai][bj][m0 + mm][1] = v1; ssq[ai][m0 + mm] += ((v0[0] * v0[0] + v0[1] * v0[1]) + (v0[2] * v0[2] + v0[3] * v0[3])) + ((v1[0] * v1[0] + v1[1] * v1[1]) + (v1[2] * v1[2] + v1[3] * v1[3])); }
                        u32x4 w; w.x = cvt_pk_bf16(v0[0], v0[1]); w.y = cvt_pk_bf16(v0[2], v0[3]); w.z = cvt_pk_bf16(v1[0], v1[1]); w.w = cvt_pk_bf16(v1[2], v1[3]);
                        *(u32x4*)(X + (size_t)(row0 + ai * HALF + (m0 + mm) * 16) * D + col0 + bj * HALF) = w; }
                __builtin_amdgcn_sched_barrier(0);
            }
            if (FUSE) fuse_tail(acc, ssq, u, wr, wc, fr, fq, mi, row0, col0);
            return;
        }
#pragma unroll
        for (int ai = 0; ai < 2; ++ai) {
            u32x4 xo[4][2];
#pragma unroll
            for (int m = 0; m < 4; ++m)
#pragma unroll
                for (int bj = 0; bj < 2; ++bj) xo[m][bj] = *(const u32x4*)(X + (size_t)(row0 + ai * HALF + m * 16) * D + col0 + bj * HALF);
            __builtin_amdgcn_sched_barrier(0);
#pragma unroll
            for (int m = 0; m < 4; ++m)
#pragma unroll
                for (int bj = 0; bj < 2; ++bj) { const u32x4 x = xo[m][bj];
                    const f32x4 x0 = {bf_lo(x.x), bf_hi(x.x), bf_lo(x.y), bf_hi(x.y)}, x1 = {bf_lo(x.z), bf_hi(x.z), bf_lo(x.w), bf_hi(x.w)};
                    const f32x4 v0 = x0 + gv[bj][0] * acc[ai][bj][m][0], v1 = x1 + gv[bj][1] * acc[ai][bj][m][1];
                    if (FUSE) { acc[ai][bj][m][0] = v0; acc[ai][bj][m][1] = v1; ssq[ai][m] += ((v0[0] * v0[0] + v0[1] * v0[1]) + (v0[2] * v0[2] + v0[3] * v0[3])) + ((v1[0] * v1[0] + v1[1] * v1[1]) + (v1[2] * v1[2] + v1[3] * v1[3])); }
                    if (FUSE == 0) { u32x4 w; w.x = cvt_pk_bf16(v0[0], v0[1]); w.y = cvt_pk_bf16(v0[2], v0[3]); w.z = cvt_pk_bf16(v1[0], v1[1]); w.w = cvt_pk_bf16(v1[2], v1[3]);
                    *(u32x4*)(X + (size_t)(row0 + ai * HALF + m * 16) * D + col0 + bj * HALF) = w; } }
            __builtin_amdgcn_sched_barrier(0); asm volatile("" ::: "memory");
        }
        if (FUSE) fuse_tail(acc, ssq, u, wr, wc, fr, fq, mi, row0, col0);
    }
};
struct EpiQKV {
    static constexpr bool PERM = true;
    bf16_t* Q; bf16_t* KT; bf16_t* VT; float qscale;
    __device__ __forceinline__ void operator()(const f32x4 (&acc)[2][2][4][2], const Unit& u, int wr, int wc, int fr, int fq) const {
#pragma unroll
        for (int ai = 0; ai < 2; ++ai)
#pragma unroll
            for (int m = 0; m < 4; ++m)
#pragma unroll
                for (int bj = 0; bj < 2; ++bj) {
                    const int r = u.pm * BM + ai * HALF + wr * 64 + m * 16 + fr;
                    const int c = u.pn * BM + bj * HALF + wc * 32 + 8 * fq;
                    bf16_t* dst; float sc = 1.f;
                    if (!u.sw) {
                        if (u.pn < 8) { dst = Q + (size_t)r * D + c; sc = qscale; }
                        else { const int cc = c - D, h = cc >> 7, ch = (cc & 127) >> 3;
                            dst = KT + ((size_t)((r >> 3) * NH + h)) * 1024 + (ch >> 2) * 256 + ((r >> 2) & 1) * 128 + (r & 3) * 32 + (ch & 3) * 8; }
                    } else { const int h = r >> 7, d = r & 127;
                        dst = VT + ((size_t)(((c >> 3) * NH + h) * 8 + (d >> 4))) * 128 + (d & 15) * 8; }
                    const f32x4 v0 = acc[ai][bj][m][0] * sc, v1 = acc[ai][bj][m][1] * sc;
                    u32x4 w; w.x = cvt_pk_bf16(v0[0], v0[1]); w.y = cvt_pk_bf16(v0[2], v0[3]); w.z = cvt_pk_bf16(v1[0], v1[1]); w.w = cvt_pk_bf16(v1[2], v1[3]);
                    *(u32x4*)dst = w; }
    }
};
struct EpiGates {
    static constexpr bool PERM = true;
    const bf16_t* UC; unsigned* LB; const float* ba; const float* bx; const float* cA;
    __device__ __forceinline__ void operator()(const f32x4 (&acc)[2][2][4][2], const Unit& u, int wr, int wc, int fr, int fq) const {
        const int blk = u.pn >> 2, dir = (u.pn >> 1) & 1, half = u.pn & 1;
        const int row0 = u.pm * BM + wr * 64 + fr;
        unsigned* lb_d = LB + ((size_t)(dir * 36 + u.pm) * 22 + (blk * 2 + half)) * 32768 + (size_t)(wr * 64 + fr) * 128 + wc * 32 + 8 * fq;
        const int ch0 = blk * 256 + half * 128 + wc * 32 + 8 * fq;
        unsigned pba[4], pbx[4], pca[4];
#pragma unroll
        for (int n = 0; n < 2; ++n) { const f32x4 t0 = *(const f32x4*)(ba + dir * LW + ch0 + 4 * n), t1 = *(const f32x4*)(bx + dir * LW + ch0 + 4 * n), t2 = *(const f32x4*)(cA + dir * LW + ch0 + 4 * n);
            pca[2 * n] = pk2(t2[0], t2[1]); pca[2 * n + 1] = pk2(t2[2], t2[3]);
            constexpr float NL = -1.4426950408889634f;
            pba[2 * n] = pk2(NL * t0[0], NL * t0[1]); pba[2 * n + 1] = pk2(NL * t0[2], NL * t0[3]); pbx[2 * n] = pk2(NL * t1[0], NL * t1[1]); pbx[2 * n + 1] = pk2(NL * t1[2], NL * t1[3]); }
        u32x4 ucw[2][2];
#define GATES_UCLOAD(buf, am_) do { _Pragma("unroll") for (int mm = 0; mm < 2; ++mm) ucw[buf][mm] = *(const u32x4*)(UC + (size_t)(row0 + ((am_) >> 1) * HALF + (((am_) & 1) * 2 + mm) * 16) * LW + ch0); } while (0)
        GATES_UCLOAD(0, 0);
#pragma unroll
        for (int am = 0; am < 4; ++am) { const int ai = am >> 1, m0 = (am & 1) * 2;
            if (am + 1 < 4) GATES_UCLOAD((am + 1) & 1, am + 1);
            __builtin_amdgcn_sched_barrier(0);
#pragma unroll
            for (int mm = 0; mm < 2; ++mm) { const int m = m0 + mm; const size_t ro = (size_t)(ai * HALF + m * 16) * 128;
                const unsigned uw[4] = {ucw[am & 1][mm].x, ucw[am & 1][mm].y, ucw[am & 1][mm].z, ucw[am & 1][mm].w};
                unsigned wv[8];
#pragma unroll
                for (int n = 0; n < 2; ++n) {
#pragma unroll
                    for (int j = 0; j < 4; ++j) { const int pi = 2 * n + (j >> 1);
                        const float ucv = (j & 1) ? bf_hi(uw[pi]) : bf_lo(uw[pi]), vb_a = (j & 1) ? bf_hi(pba[pi]) : bf_lo(pba[pi]), vb_x = (j & 1) ? bf_hi(pbx[pi]) : bf_lo(pbx[pi]);
                        const float rr = fast_rcp(1.f + fast_exp2(fmaf(acc[ai][0][m][n][j], -1.4426950408889634f, vb_a))), ig = fast_rcp(1.f + fast_exp2(fmaf(acc[ai][1][m][n][j], -1.4426950408889634f, vb_x)));
                        wv[4 * n + j] = cvt_pk_bf16(rr * ((j & 1) ? bf_hi(pca[pi]) : bf_lo(pca[pi])), ig * ucv); } }
                *(u32x4*)(lb_d + ro) = (u32x4){wv[0], wv[1], wv[2], wv[3]}; *(u32x4*)(lb_d + ro + 4) = (u32x4){wv[4], wv[5], wv[6], wv[7]}; }
            __builtin_amdgcn_sched_barrier(0);
        }
#undef GATES_UCLOAD
    }
};
}

#define XB_TMO      128
#define XB_XCNT(j)  (256  + 64 * (j))
#define XB_XSUB(j)  (1280 + 64 * (j))
#define XB_XGEN(j)  (2304 + 64 * (j))
#define XB_TOP      3328
#define XB_TOPGEN   3392
#define XCD_BAR_WORDS 3456
#define XB_SPIN_CAP (1u << 18)
__device__ __forceinline__ unsigned xb_ld(unsigned* p)              { return __hip_atomic_load(p, __ATOMIC_RELAXED, __HIP_MEMORY_SCOPE_AGENT); }
__device__ __forceinline__ unsigned xb_add(unsigned* p, unsigned v) { return __hip_atomic_fetch_add(p, v, __ATOMIC_RELAXED, __HIP_MEMORY_SCOPE_AGENT); }
__device__ __forceinline__ unsigned xb_xcc_id() { return (unsigned)__builtin_amdgcn_s_getreg((3 << 11) | 20) & 0xFu; }
#define XB_SPIN(cond, bar) do { unsigned _sp = 0; while (cond) { __builtin_amdgcn_s_sleep(1); \
    if ((++_sp & 255u) == 0u) { if (xb_ld(&(bar)[XB_TMO])) break; if (_sp > XB_SPIN_CAP) { atomicAdd(&(bar)[XB_TMO], 1u); break; } } } } while (0)
struct XcdBarrier { unsigned* bar; unsigned x; volatile LAS unsigned* st; };
__device__ __forceinline__ XcdBarrier xcd_barrier_post(unsigned* bar, volatile LAS unsigned* st) {
    XcdBarrier b; b.bar = bar; b.x = xb_xcc_id(); b.st = st;
    if (threadIdx.x == 0) (void)xb_add(&bar[XB_XCNT(b.x)], 1u);
    return b;
}
__device__ __forceinline__ void xcd_barrier_complete(unsigned* bar, unsigned x, unsigned& nloc, unsigned& nx) {
    const unsigned G = gridDim.x * gridDim.y * gridDim.z;
    unsigned sum, cnt, mine, sp = 0u;
    for (;;) {
        sum = 0u; cnt = 0u; mine = 0u;
#pragma unroll
        for (unsigned j = 0; j < 16; ++j) { const unsigned c = xb_ld(&bar[XB_XCNT(j)]); sum += c; cnt += (c > 0u) ? 1u : 0u; mine = (j == x) ? c : mine; }
        if (sum == G) break;
        __builtin_amdgcn_s_sleep(1);
        if ((++sp & 255u) == 0u) { if (xb_ld(&bar[XB_TMO])) break; if (sp > XB_SPIN_CAP) { atomicAdd(&bar[XB_TMO], 1u); break; } }
    }
    nloc = mine > 0u ? mine : 1u; nx = cnt > 0u ? cnt : 1u;
}
__device__ __forceinline__ void xcd_barrier(const XcdBarrier& b) {
    asm volatile("s_waitcnt vmcnt(0)" ::: "memory");
    __syncthreads();
    if (threadIdx.x == 0) {
        unsigned* bar = b.bar;
        __builtin_amdgcn_s_waitcnt(0);
        unsigned nloc = b.st[0], nx = b.st[1];
        if (nloc == 0u) { xcd_barrier_complete(bar, b.x, nloc, nx); b.st[0] = nloc; b.st[1] = nx; }
        const unsigned old = xb_add(&bar[XB_XSUB(b.x)], 1u);
        const unsigned gen = old / nloc;
        if (old + 1u == (gen + 1u) * nloc) {
            __builtin_amdgcn_fence(__ATOMIC_RELEASE, "agent");
            asm volatile("s_waitcnt vmcnt(0)" ::: "memory");
            const unsigned og = xb_add(&bar[XB_TOP], 1u);
            const unsigned tg = og / nx;
            if (og + 1u == (tg + 1u) * nx) xb_add(&bar[XB_TOPGEN], 1u);
            else XB_SPIN(xb_ld(&bar[XB_TOPGEN]) == tg, bar);
            __builtin_amdgcn_fence(__ATOMIC_ACQUIRE, "agent");
            xb_add(&bar[XB_XGEN(b.x)], 1u);
            asm volatile("s_waitcnt vmcnt(0)" ::: "memory");
        } else {
            XB_SPIN(xb_ld(&bar[XB_XGEN(b.x)]) == gen, bar);
            __builtin_amdgcn_fence(__ATOMIC_ACQUIRE, "agent");
            asm volatile("s_waitcnt vmcnt(0)" ::: "memory");
        }
    }
    __syncthreads();
}

constexpr size_t MiB = 1u << 20;
constexpr size_t WS_CTL = 0, CTL_ZERO_BYTES = 1 * MiB;
constexpr size_t WS_MODS = 1 * MiB;
constexpr size_t WS_WIN = 2 * MiB;
constexpr size_t WS_WG = 46 * MiB;
constexpr size_t WS_WOUT = 57 * MiB;
constexpr size_t WS_WQKV = 79 * MiB;
constexpr size_t WS_WO = 127 * MiB;
constexpr size_t WS_W1 = 143 * MiB;
constexpr size_t WS_W2 = 271 * MiB;
constexpr size_t WS_X = 399 * MiB;
constexpr size_t WS_XN = 471 * MiB;
constexpr size_t WS_BIG = 507 * MiB;
constexpr size_t WS_O = 651 * MiB;
constexpr size_t WS_CA = 687 * MiB;
constexpr size_t WS_UC = 688 * MiB;
constexpr size_t WS_LA = 738 * MiB;
constexpr size_t WS_BB = 838 * MiB;
constexpr size_t WS_Z = 938 * MiB;
constexpr size_t WS_AGGA = 988 * MiB, WS_AGGH = 995 * MiB, WS_CARRY = 1002 * MiB;
constexpr size_t WS_SLAB = 1009 * MiB;
constexpr size_t WS_FAST_END = 1073 * MiB;
constexpr size_t WS_NV = 688 * MiB;
static_assert((long long)WS_XN - (long long)WS_X == pg8::RN_DXN && (long long)WS_BB - (long long)WS_X == pg8::RN_DSLOT && (long long)WS_CTL + 131072 - (long long)WS_X == pg8::RN_DCNT && CTL_ZERO_BYTES >= 131072 + 32 * 256, "fused-norm exchange: slots (256 KiB at WS_BB, otherwise unused), panel counters in CTL");
constexpr int CW_BAR = 4096;
constexpr int CW_SPLIT = 16384;

constexpr int NWAVES = 8, NTHREADS = 512;
constexpr int LDS_BYTES = 147456;
constexpr int LDS_MISC = 131072;
constexpr int PH_PROLOGUE = 0, PH_NORM0 = 1, PH_LAYER0 = 2, PH_PER_LAYER = 12, PH_END = PH_LAYER0 + PH_PER_LAYER * DEPTH;

struct Args {
    const float* in[23]; float* out; unsigned char* ws; int ph_lo, ph_hi;
};

__device__ __forceinline__ float wave_sum(float v) {
#pragma unroll
    for (int o = 1; o < 64; o <<= 1) v += __shfl_xor(v, o);
    return v;
}
__device__ __forceinline__ void transpose_item(const float* W, int K, int N, bf16_t* WT, int k0, int n0, int dst_row0, int lane) {
    const int kb = lane & 7, nl = lane >> 3;
    const float* src = W + (size_t)(k0 + 8 * kb) * N + n0 + 4 * nl;
    f32x4 v[8];
#pragma unroll
    for (int i = 0; i < 8; ++i) v[i] = __builtin_nontemporal_load((const f32x4*)(src + (size_t)i * N));
    bf16_t* dst = WT + (size_t)(dst_row0 + 4 * nl) * K + k0 + 8 * kb;
#pragma unroll
    for (int j = 0; j < 4; ++j) { u32x4 o; o.x = pk2(v[0][j], v[1][j]); o.y = pk2(v[2][j], v[3][j]); o.z = pk2(v[4][j], v[5][j]); o.w = pk2(v[6][j], v[7][j]);
        *(u32x4*)(dst + (size_t)j * K) = o; }
}
__device__ __forceinline__ void transpose_group(int r, const float* src, int K, int N, bf16_t* dst, int lane) {
    const int nblk = N / 32, per = (K / 64) * nblk; const int mat = r / per, q = r % per, kb = q / nblk, nb = q % nblk;
    transpose_item(src + (size_t)mat * K * N, K, N, dst + (size_t)mat * N * K, 64 * kb, 32 * nb, 32 * nb, lane);
}


__device__ __forceinline__ unsigned char* tabp(volatile LAS unsigned* ptab, int i) {
    unsigned base = (unsigned)(size_t)ptab; asm volatile("" : "+v"(base));
    const u32x2 w = *(volatile LAS u32x2*)(base + 8u * (unsigned)i);
    return (unsigned char*)(GAS unsigned char*)(((unsigned long long)(unsigned)__builtin_amdgcn_readfirstlane((int)w.y) << 32) | (unsigned)__builtin_amdgcn_readfirstlane((int)w.x));
}
constexpr int C_W = (D / 64) * (FF / 32), C_IN = (D / 64) * (2 * LW / 32), C_OUT = (LW / 64) * (D / 32), C_QKV = (D / 64) * (3 * D / 32), C_O = (D / 64) * (D / 32), C_G = 2 * NLB * 2 * 32;
struct ConvAddr { const float* src; bf16_t* dst; int N, K; };
__device__ __forceinline__ ConvAddr conv_addr(volatile LAS unsigned* ptab, int kind, int l, int r, int lane) {
    unsigned char* ws = tabp(ptab, 24); const int kbl = lane & 7, nl = lane >> 3; ConvAddr a;
    if (kind == 6) { const int matl = r >> 5, q = r & 31, kb = q >> 3, nb = q & 7;
        const int gsel = matl & 1, db = matl >> 1, blk = db % NLB, d = db / NLB;
        const float* s0 = (const float*)tabp(ptab, gsel ? 16 : 14) + (size_t)((l * 2 + d) * NLB + blk) * LB * LB;
        const int n0 = 32 * nb, half = n0 >> 7, chn = n0 & 127, drow = blk * 1024 + ((d * 2 + half) * 2 + gsel) * 128 + chn;
        a.N = LB; a.K = LB; a.src = s0 + (size_t)(64 * kb + 8 * kbl) * LB + n0 + 4 * nl;
        a.dst = (bf16_t*)(ws + WS_WG) + (size_t)l * (NLB * 1024) * LB + (size_t)(drow + 4 * nl) * LB + 64 * kb + 8 * kbl;
        return a; }
    int K, N, inp; size_t wso;
    switch (kind) { case 0: K = D; N = FF; inp = 8; wso = WS_W1; break; case 1: K = FF; N = D; inp = 9; wso = WS_W2; break; case 2: K = D; N = 2 * LW; inp = 10; wso = WS_WIN; break;
                    case 3: K = LW; N = D; inp = 18; wso = WS_WOUT; break; case 4: K = D; N = 3 * D; inp = 19; wso = WS_WQKV; break; default: K = D; N = D; inp = 21; wso = WS_WO; break; }
    const int nblk = N / 32, kb = r / nblk, nb = r % nblk;
    a.N = N; a.K = K; a.src = (const float*)tabp(ptab, inp) + (size_t)l * K * N + (size_t)(64 * kb + 8 * kbl) * N + 32 * nb + 4 * nl;
    a.dst = (bf16_t*)(ws + wso) + (size_t)l * N * K + (size_t)(32 * nb + 4 * nl) * K + 64 * kb + 8 * kbl;
    return a;
}
__device__ __forceinline__ void conv_load(const ConvAddr& a, f32x4 (&v)[8]) {
#pragma unroll
    for (int i = 0; i < 8; ++i) v[i] = __builtin_nontemporal_load((const f32x4*)(a.src + (size_t)i * a.N));
}
__device__ __forceinline__ void conv_store(const ConvAddr& a, const f32x4 (&v)[8]) {
#pragma unroll
    for (int j = 0; j < 4; ++j) { u32x4 o; o.x = pk2(v[0][j], v[1][j]); o.y = pk2(v[2][j], v[3][j]); o.z = pk2(v[4][j], v[5][j]); o.w = pk2(v[6][j], v[7][j]);
        *(u32x4*)(a.dst + (size_t)j * a.K) = o; }
}
#define CSEG(kind, l, cnt) if (!fnd_ && r < (cnt)) { ck_ = (kind); cl_ = (l); fnd_ = true; } else if (!fnd_) r -= (cnt)
#define CONV_RUN(it0, st, nit, SEGS) do { for (int it_ = (it0); it_ < (nit); it_ += 2 * (st)) { ConvAddr ca_, cb_; f32x4 va_[8], vb_[8]; const bool two_ = it_ + (st) < (nit); \
        { int r = it_, ck_ = 0, cl_ = 0; bool fnd_ = false; SEGS; ca_ = conv_addr(ptab, ck_, cl_, r, lane); } conv_load(ca_, va_); \
        { int r = two_ ? it_ + (st) : it_, ck_ = 0, cl_ = 0; bool fnd_ = false; SEGS; cb_ = conv_addr(ptab, ck_, cl_, r, lane); } conv_load(cb_, vb_); \
        __builtin_amdgcn_sched_barrier(0); conv_store(ca_, va_); if (two_) conv_store(cb_, vb_); } } while (0)
__device__ __forceinline__ void ada_fill_ssil(volatile LAS unsigned* ptab, LAS unsigned char* lds, int tid) {
    const float* c = (const float*)tabp(ptab, 1); const float* c_ctx = (const float*)tabp(ptab, 3); LAS float* ssil = (LAS float*)lds;
    for (int i = tid; i < 5 * D; i += NTHREADS) { const int m = i / D, k = i % D; const float v = m < 4 ? c[m * D + k] : c_ctx[k]; ssil[i] = v / (1.f + expf(-v)); }
    __syncthreads();
}
constexpr int ADA_IT = 96;
__device__ __forceinline__ void ada_wg_item(volatile LAS unsigned* ptab, LAS unsigned char* lds, int it, int tid) {
    int lane = tid & 63; asm volatile("" : "+v"(lane)); const int wave = __builtin_amdgcn_readfirstlane(tid >> 6);
    const float* ada_w = (const float*)tabp(ptab, 4); const float* ada_b = (const float*)tabp(ptab, 5); float* mods = (float*)(tabp(ptab, 24) + WS_MODS);
    LAS float* ssil = (LAS float*)lds; LAS float* red = (LAS float*)(lds + 40960);
    const int layer = it / ADA_IT, col0 = (it % ADA_IT) * 128;
    const int kr = lane >> 5, c4 = lane & 31;
    const float* W = ada_w + ((size_t)layer * D + wave * 256 + 16 * kr) * MODW + col0 + 4 * c4;
    f32x4 a0 = {0.f, 0.f, 0.f, 0.f}, a1 = a0, a2 = a0, a3 = a0, a4 = a0;
    const LAS float* sp = ssil + wave * 256 + 16 * kr;
    for (int k = 0; k < 256; k += 32) {
        f32x4 wv[16];
#pragma unroll
        for (int kk = 0; kk < 16; ++kk) wv[kk] = __builtin_nontemporal_load((const f32x4*)(W + (size_t)(k + kk) * MODW));
#pragma unroll
        for (int hh = 0; hh < 4; ++hh) { const int k4 = k + 4 * hh;
            const f32x4 s0 = *(const LAS f32x4*)(sp + k4), s1 = *(const LAS f32x4*)(sp + D + k4), s2 = *(const LAS f32x4*)(sp + 2 * D + k4), s3 = *(const LAS f32x4*)(sp + 3 * D + k4), s4 = *(const LAS f32x4*)(sp + 4 * D + k4);
#pragma unroll
            for (int kk = 0; kk < 4; ++kk) { const f32x4 w4 = wv[4 * hh + kk]; a0 += w4 * s0[kk]; a1 += w4 * s1[kk]; a2 += w4 * s2[kk]; a3 += w4 * s3[kk]; a4 += w4 * s4[kk]; } }
    }
    { LAS f32x4* rw = (LAS f32x4*)(red + (wave * 2 + kr) * 5 * 128) + c4;
      rw[0] = a0; rw[32] = a1; rw[64] = a2; rw[96] = a3; rw[128] = a4; }
    __syncthreads();
    for (int i = tid; i < 5 * 128; i += NTHREADS) { const int m = i >> 7, l = i & 127; float s = 0.f;
#pragma unroll
        for (int w2 = 0; w2 < 16; ++w2) s += red[w2 * 5 * 128 + m * 128 + l];
        mods[((size_t)layer * 5 + m) * MODW + col0 + l] = s + ada_b[(size_t)layer * MODW + col0 + l]; }
    __syncthreads();
}

#define FILLER(U, ADA_FIRST, NIT, SEGS) do { int Gl = G; asm volatile("" : "+s"(Gl)); const int nfull = (U) % Gl; \
    if (nfull == 0 || bxp >= nfull) { const int rank = nfull ? bxp - nfull : bxp, nidle = nfull ? Gl - nfull : Gl, nada = ((ADA_FIRST) >= 0 && nidle > ADA_IT) ? ADA_IT : 0; \
        int tid = threadIdx.x; asm volatile("" : "+v"(tid)); const int lane = tid & 63, wave = __builtin_amdgcn_readfirstlane(tid >> 6); \
        if ((ADA_FIRST) >= 0 && nada == 0) { ada_fill_ssil(ptab, lds, tid); for (int it_ = rank; it_ < ADA_IT; it_ += nidle) ada_wg_item(ptab, lds, (ADA_FIRST) + it_, tid); }     \
        if (rank < nada) { ada_fill_ssil(ptab, lds, tid); ada_wg_item(ptab, lds, (ADA_FIRST) + rank, tid); } \
        else CONV_RUN((rank - nada) * NWAVES + wave, (nidle - nada) * NWAVES, NIT, SEGS); } } while (0)

#define FILLER2(K, ADA_FIRST, NIT, SEGS) do { int Gl = G; asm volatile("" : "+s"(Gl)); const int cc_ = __builtin_amdgcn_readfirstlane(*(volatile const LAS int*)(lds + pg8::CC_TAB_OFF + 4 * (K))); \
    if (cc_ >= Gl || bxp >= cc_) { const int rank = cc_ >= Gl ? bxp : bxp - cc_, nidle = cc_ >= Gl ? Gl : Gl - cc_; \
        int tid = threadIdx.x; asm volatile("" : "+v"(tid)); const int lane = tid & 63, wave = __builtin_amdgcn_readfirstlane(tid >> 6); \
        if ((ADA_FIRST) >= 0) { ada_fill_ssil(ptab, lds, tid); for (int it_ = rank; it_ < ADA_IT; it_ += nidle) ada_wg_item(ptab, lds, (ADA_FIRST) + it_, tid); } \
        CONV_RUN(rank * NWAVES + wave, nidle * NWAVES, NIT, SEGS); } } while (0)

__device__ __forceinline__ void norm_load(const float* xrow, f32x4 (&v)[8], int lane) {
    const f32x4* xr = (const f32x4*)xrow + lane;
#pragma unroll
    for (int j = 0; j < 8; ++j) v[j] = xr[64 * j];
}
__device__ __forceinline__ void norm_load(const bf16_t* xrow, f32x4 (&v)[8], int lane) {
    const u32x2* xr = (const u32x2*)xrow + lane; u32x2 r[8];
#pragma unroll
    for (int j = 0; j < 8; ++j) r[j] = xr[64 * j];
#pragma unroll
    for (int j = 0; j < 8; ++j) v[j] = (f32x4){bf_lo(r[j].x), bf_hi(r[j].x), bf_lo(r[j].y), bf_hi(r[j].y)};
}
template <int MODE>
__device__ __forceinline__ void norm_vecs(const float* g, const float* sh, const float* sc, f32x4 (&GG)[8], f32x4 (&SS)[8], int lane) {
#pragma unroll
    for (int j = 0; j < 8; ++j) { GG[j] = ((const f32x4*)g)[lane + 64 * j];
        if (MODE == 0) { GG[j] = GG[j] * (((const f32x4*)sc)[lane + 64 * j] + 1.f); SS[j] = ((const f32x4*)sh)[lane + 64 * j]; } }
}
template <int MODE>
__device__ __forceinline__ void norm_apply(f32x4 (&v)[8], bf16_t* xcopy, const f32x4 (&GG)[8], const f32x4 (&SS)[8], bf16_t* obf, float* of32, int lane, const float* slabrow = nullptr, const float* gate = nullptr) {
    float ss = 0.f;
    if (slabrow) {
#pragma unroll
        for (int jh = 0; jh < 2; ++jh) { u32x2 p[4][8];
#pragma unroll
            for (int jj = 0; jj < 4; ++jj) { const int j = jh * 4 + jj; const u32x2* sp = (const u32x2*)((const bf16_t*)slabrow + (size_t)j * 8 * 65536) + lane;
#pragma unroll
                for (int s = 0; s < 8; ++s) p[jj][s] = sp[(size_t)s * 16384]; }
            __builtin_amdgcn_sched_barrier(0);
#pragma unroll
            for (int jj = 0; jj < 4; ++jj) { const int j = jh * 4 + jj; const f32x4 gt = ((const f32x4*)gate)[lane + 64 * j];
                f32x4 a = {bf_lo(p[jj][0].x), bf_hi(p[jj][0].x), bf_lo(p[jj][0].y), bf_hi(p[jj][0].y)};
#pragma unroll
                for (int s = 1; s < 8; ++s) a += (f32x4){bf_lo(p[jj][s].x), bf_hi(p[jj][s].x), bf_lo(p[jj][s].y), bf_hi(p[jj][s].y)};
                v[j] += gt * a; }
            __builtin_amdgcn_sched_barrier(0); } }
#pragma unroll
    for (int j = 0; j < 8; ++j) ss += (v[j].x * v[j].x + v[j].y * v[j].y) + (v[j].z * v[j].z + v[j].w * v[j].w);
    const float rstd = rsqrtf(wave_sum(ss) * (1.f / D) + 1e-6f);
    if (xcopy) {
#pragma unroll
        for (int j = 0; j < 8; ++j) { u32x2 w; w.x = pk2(v[j].x, v[j].y); w.y = pk2(v[j].z, v[j].w); ((u32x2*)xcopy)[lane + 64 * j] = w; } }
#pragma unroll
    for (int j = 0; j < 8; ++j) { const int c4 = lane + 64 * j;
        f32x4 h = v[j] * rstd * GG[j];
        if (MODE == 0) { h = h + SS[j]; u32x2 w; w.x = pk2(h.x, h.y); w.y = pk2(h.z, h.w); ((u32x2*)obf)[c4] = w; }
        else ((f32x4*)of32)[c4] = h; }
}
#define NORM_LATENT(VECS, ROWSRC, APPLY) do { const int rpw_ = (ML + NGW - 1) / NGW; const int r0_ = gw * rpw_, r1_ = (r0_ + rpw_ < ML) ? r0_ + rpw_ : ML; \
    if (r0_ < r1_) { f32x4 GG[8], SS[8], vA[8], vB[8]; int mc_ = r0_ / SEQ; VECS(mc_); norm_load(ROWSRC(r0_), vA, lane); \
        for (int r_ = r0_; r_ < r1_; r_ += 2) { \
            { const int rn_ = (r_ + 1 < r1_) ? r_ + 1 : r_; norm_load(ROWSRC(rn_), vB, lane); } \
            if (r_ / SEQ != mc_) { mc_ = r_ / SEQ; VECS(mc_); } \
            APPLY(vA, r_); \
            if (r_ + 1 < r1_) { { const int rn_ = (r_ + 2 < r1_) ? r_ + 2 : r_ + 1; norm_load(ROWSRC(rn_), vA, lane); } \
                if ((r_ + 1) / SEQ != mc_) { mc_ = (r_ + 1) / SEQ; VECS(mc_); } \
                APPLY(vB, r_ + 1); } } } } while (0)

template <bool LOCAL>
__device__ __forceinline__ void attn_unit(const bf16_t* Q, const bf16_t* KT, const bf16_t* VT, bf16_t* O, LAS unsigned char* lds, int b, int h, int r, int w, int tq, int lane) {
    const int g = lane >> 4, q = lane & 15;
    const int qrow = LOCAL ? (b * SEQ + r * GRID_W + 16 * w + q) : (ML + b * CTX + 16 * tq + q);
    bf16x8 bq[4];
    { const bf16_t* qp = Q + (size_t)qrow * D + h * HD + 8 * g;
#pragma unroll
      for (int ks = 0; ks < 4; ++ks) bq[ks] = *(const bf16x8*)(qp + 32 * ks); }
    constexpr int NP = LOCAL ? 16 : 8, CP = LOCAL ? 8 : 0;
    f32x4 s[2 * NP];
    int rs = 0, ws = 0;
    if (LOCAL) { rs = r - 4; rs = rs < 0 ? 0 : (rs > 24 ? 24 : rs); ws = 16 * w - 8; ws = ws < 0 ? 0 : (ws > 32 ? 32 : ws); }
    const int rgl = b * SEQ + rs * GRID_W + ws;
    if (LOCAL) {
        const bf16_t* kloc = KT + ((size_t)(((rgl >> 3) + (q >> 2)) * NH + h)) * 1024 + (q & 3) * 32 + g * 8;
        bf16x8 ka[2][8];
#define ATT_KLOAD(buf, p) do { const bf16_t* kp_ = kloc + (size_t)((p) * 8 * NH) * 1024; \
        _Pragma("unroll") for (int f = 0; f < 2; ++f) _Pragma("unroll") for (int ks = 0; ks < 4; ++ks) ka[buf][f * 4 + ks] = *(const bf16x8*)(kp_ + f * 128 + ks * 256); } while (0)
        ATT_KLOAD(0, 0);
#pragma unroll
        for (int p = 0; p < 8; ++p) {
            __builtin_amdgcn_s_barrier();
            if (p + 1 < 8) ATT_KLOAD((p + 1) & 1, p + 1);
            __builtin_amdgcn_sched_barrier(0);
#pragma unroll
            for (int f = 0; f < 2; ++f) { f32x4 a = {0.f, 0.f, 0.f, 0.f};
#pragma unroll
                for (int ks = 0; ks < 4; ++ks) a = __builtin_amdgcn_mfma_f32_16x16x32_bf16(ka[p & 1][f * 4 + ks], bq[ks], a, 0, 0, 0);
                s[2 * p + f] = a; }
            __builtin_amdgcn_sched_barrier(0);
        }
#undef ATT_KLOAD
    }
    {
        const LAS unsigned char* kl = lds + (q >> 2) * 2048 + (((q & 3) * 4 + g) ^ ((q >> 2) & 2)) * 16;
#pragma unroll
        for (int p = 0; p < 8; ++p)
#pragma unroll
            for (int f = 0; f < 2; ++f) { f32x4 a = {0.f, 0.f, 0.f, 0.f};
#pragma unroll
                for (int ks = 0; ks < 4; ++ks) a = __builtin_amdgcn_mfma_f32_16x16x32_bf16(*(const LAS bf16x8*)(kl + p * 8192 + ks * 512 + f * 256), bq[ks], a, 0, 0, 0);
                s[2 * (CP + p) + f] = a; }
    }
    if (LOCAL) {
        const int c = 16 * w + q; int cs = c - 8; cs = cs < 0 ? 0 : (cs > 48 ? 48 : cs);
        const LAS float* rp = (const LAS float*)(lds + LDS_MISC + 1024);
#pragma unroll
        for (int p = 0; p < 8; ++p) { const int ro = (rs + p - r + 7) * 31;
#pragma unroll
            for (int f = 0; f < 2; ++f)
#pragma unroll
                for (int j = 0; j < 4; ++j) { const int kc = ws + 8 * g + 4 * f + j; const bool valid = (kc >= cs) && (kc < cs + 16);
                    int rel = kc - c + 15; rel = rel < 0 ? 0 : (rel > 30 ? 30 : rel);
                    const float bias = rp[ro + rel];
                    s[p * 2 + f][j] = valid ? s[p * 2 + f][j] + bias : -INFINITY; } }
    }
    float mx = -INFINITY;
#pragma unroll
    for (int i = 0; i < 2 * NP; ++i) mx = fmaxf(mx, fmaxf(fmaxf(s[i][0], s[i][1]), fmaxf(s[i][2], s[i][3])));
    mx = fmaxf(mx, __shfl_xor(mx, 16)); mx = fmaxf(mx, __shfl_xor(mx, 32));
    float sum = 0.f; const float mxl = mx * 1.4426950408889634f;
    bf16x8 pb[NP];
#pragma unroll
    for (int p = 0; p < NP; ++p) { float e[8];
#pragma unroll
        for (int f = 0; f < 2; ++f)
#pragma unroll
            for (int j = 0; j < 4; ++j) { e[4 * f + j] = fast_exp2(fmaf(s[2 * p + f][j], 1.4426950408889634f, -mxl)); sum += e[4 * f + j]; }
        u32x4 pw; pw.x = cvt_pk_bf16(e[0], e[1]); pw.y = cvt_pk_bf16(e[2], e[3]); pw.z = cvt_pk_bf16(e[4], e[5]); pw.w = cvt_pk_bf16(e[6], e[7]);
        pb[p] = __builtin_bit_cast(bf16x8, pw); }
    sum += __shfl_xor(sum, 16); sum += __shfl_xor(sum, 32);
    f32x4 o[8];
#pragma unroll
    for (int df = 0; df < 8; ++df) o[df] = (f32x4){0.f, 0.f, 0.f, 0.f};
    if (LOCAL) {
        const bf16_t* vloc = VT + ((size_t)(((rgl >> 3) + g) * NH + h)) * 1024 + q * 8;
        bf16x8 va[2][8];
#define ATT_VLOAD(buf, p) do { const bf16_t* vp_ = vloc + (size_t)((p) * 8 * NH) * 1024; \
        _Pragma("unroll") for (int df = 0; df < 8; ++df) va[buf][df] = *(const bf16x8*)(vp_ + df * 128); } while (0)
        ATT_VLOAD(0, 0);
#pragma unroll
        for (int p = 0; p < 8; ++p) {
            __builtin_amdgcn_s_barrier();
            if (p + 1 < 8) ATT_VLOAD((p + 1) & 1, p + 1);
            __builtin_amdgcn_sched_barrier(0);
#pragma unroll
            for (int df = 0; df < 8; ++df) o[df] = __builtin_amdgcn_mfma_f32_16x16x32_bf16(va[p & 1][df], pb[p], o[df], 0, 0, 0);
            __builtin_amdgcn_sched_barrier(0);
        }
#undef ATT_VLOAD
    }
    {
        const LAS unsigned char* vl = lds + 65536 + g * 2048 + q * 16;
#pragma unroll
        for (int p = 0; p < 8; ++p)
#pragma unroll
            for (int df = 0; df < 8; ++df) o[df] = __builtin_amdgcn_mfma_f32_16x16x32_bf16(*(const LAS bf16x8*)(vl + p * 8192 + df * 256), pb[CP + p], o[df], 0, 0, 0);
    }
    const float inv = 1.f / sum;
    bf16_t* op = O + (size_t)qrow * D + h * HD + 4 * g;
#pragma unroll
    for (int df = 0; df < 8; ++df) { u32x2 wv; wv.x = cvt_pk_bf16(o[df][0] * inv, o[df][1] * inv); wv.y = cvt_pk_bf16(o[df][2] * inv, o[df][3] * inv); *(u32x2*)(op + 16 * df) = wv; }
}

#define LRU_STEP(h, l, x) do { const float a_ = fast_exp2(l); h = fmaf(a_, h, __builtin_amdgcn_sqrtf(fmaxf(fmaf(-a_, a_, 1.f), 0.f)) * (x)); } while (0)
__global__ void __launch_bounds__(NTHREADS, 2) mega(Args args) {
    extern __shared__ __attribute__((aligned(16))) unsigned char lds_raw[];
    LAS unsigned char* lds = (LAS unsigned char*)lds_raw;
    const int G = gridDim.x; const int bx = blockIdx.x; const int vcu = ((G & 7) == 0) ? (bx & 7) * (G >> 3) + (bx >> 3) : bx;
    const int NGW = G * NWAVES;
    const int lo = args.ph_lo, hi = args.ph_hi;
    volatile LAS unsigned* ptab = (volatile LAS unsigned*)(lds + LDS_MISC + 64);
    { const int tid = threadIdx.x;
    for (int u = tid; u < (LDS_BYTES - LDS_MISC) / 4; u += NTHREADS) ((LAS unsigned*)(lds + LDS_MISC))[u] = 0u;
    __syncthreads();
    if (tid < 25) { const unsigned long long pv = tid < 23 ? (unsigned long long)args.in[tid] : (tid == 23 ? (unsigned long long)args.out : (unsigned long long)args.ws);
        ptab[2 * tid] = (unsigned)pv; ptab[2 * tid + 1] = (unsigned)(pv >> 32); }
    if (tid == 32) { volatile LAS int* cct = (volatile LAS int*)(lds + pg8::CC_TAB_OFF); static_assert(pg8::CC_TAB_OFF == LDS_MISC + 512, "cc table");
        cct[1] = pg8::gemm_cc(36 * (2 * LW / 256), G); cct[2] = pg8::gemm_cc(36 * (2 * D / 256) + (D / 256) * 36, G); cct[3] = pg8::gemm_cc(36 * NLB * 4, G); cct[4] = pg8::gemm_cc(36 * (FF / 256), G); }
    __syncthreads(); }
    unsigned char* const ws0 = args.ws;
    XcdBarrier bar; bar.bar = (unsigned*)(ws0 + WS_CTL) + CW_BAR; bar.x = 0; bar.st = nullptr;
    const bool multi = (hi - lo) > 1;
    if (multi) bar = xcd_barrier_post((unsigned*)(ws0 + WS_CTL) + CW_BAR, (volatile LAS unsigned*)(lds + LDS_MISC + 32));
    bool need_bar = false;
#define IN(k) (lo <= (k) && (k) < hi)
#define TABP(i) tabp(ptab, (i))
#define INP(i) ((const float*)TABP(i))
#define WSF(off) ((float*)(wsl + (off)))
#define WSB(off) ((bf16_t*)(wsl + (off)))
#define PHASE_BEGIN() if (need_bar) xcd_barrier(bar); need_bar = true; int tid = threadIdx.x; asm volatile("" : "+v"(tid)); const int lane = tid & 63, wave = __builtin_amdgcn_readfirstlane(tid >> 6), gw = vcu * NWAVES + wave; (void)lane; (void)gw; unsigned char* const wsl = TABP(24); (void)wsl; int bxp = bx; asm volatile("" : "+s"(bxp)); (void)bxp

    if (IN(PH_PROLOGUE)) {
        PHASE_BEGIN();
        for (int rep = 0; rep < REP_PRO; ++rep) {
        __syncthreads();
        ada_fill_ssil(ptab, lds, tid);
        constexpr int ADA0 = ADA_IT;
        { const float* lam = INP(13); float* CAw = WSF(WS_CA);
          for (int i = gw * 64 + lane; i < 2 * 2 * LW; i += NGW * 64) CAw[i] = -8.f * log1pf(expf(-lam[i])) * 1.4426950408889634f; }
        constexpr int NITEMS = 4 * C_W + C_IN + C_OUT + C_G;
#define SEGS_P CSEG(2, 0, C_IN); CSEG(6, 0, C_G); CSEG(3, 0, C_OUT); CSEG(0, 0, C_W); CSEG(1, 0, C_W); CSEG(0, 1, C_W); CSEG(1, 1, C_W)
        if (G > 2 * ADA0) { if (vcu < ADA0) ada_wg_item(ptab, lds, vcu, tid); else CONV_RUN((vcu - ADA0) * NWAVES + wave, (G - ADA0) * NWAVES, NITEMS, SEGS_P); }
        else { for (int it_ = vcu; it_ < ADA0; it_ += G) ada_wg_item(ptab, lds, it_, tid); CONV_RUN(vcu * NWAVES + wave, G * NWAVES, NITEMS, SEGS_P); }
#undef SEGS_P
        }
    }
    if (IN(PH_NORM0)) {
        PHASE_BEGIN();
        const float* x = INP(0); const float* ctx = INP(2); const float* norm1_g = INP(6); const float* mods = WSF(WS_MODS); bf16_t* X = WSB(WS_X); bf16_t* XN = WSB(WS_XN);
#define VECS0(m) norm_vecs<0>(norm1_g, mods + (size_t)(m) * MODW, mods + (size_t)(m) * MODW + D, GG, SS, lane)
#define SRC0(r) (x + (size_t)(r) * D)
#define APP0(v, r) norm_apply<0>(v, nullptr, GG, SS, XN + (size_t)(r) * D, nullptr, lane)
        for (int rep = 0; rep < REP_NORM; ++rep) {
            NORM_LATENT(VECS0, SRC0, APP0);
            { f32x4 GG[8], SS[8]; VECS0(4);
              for (int row = ML + gw; row < M; row += NGW) { f32x4 v[8]; norm_load(ctx + (size_t)(row - ML) * D, v, lane); norm_apply<0>(v, X + (size_t)row * D, GG, SS, XN + (size_t)row * D, nullptr, lane); } } }
#undef VECS0
#undef SRC0
#undef APP0
    }
    for (int L = 0; L < DEPTH; ++L) {
        const int base = PH_LAYER0 + PH_PER_LAYER * L; const bool lru = !(L & 1); const int j = L >> 1; const bool lastL = (L == DEPTH - 1);
        const int nMrows = lastL ? 32 : 36;
        if (IN(base + 0)) {
            PHASE_BEGIN();
            if (lru) {
                pg8::Gemm g{WSB(WS_XN), WSB(WS_WIN) + (size_t)j * (2 * LW) * D, D, D, D, -1, nullptr, nullptr, 0}; pg8::StaticOrder S; S.init(36, 2 * LW / 256, G, bxp);
                pg8::EpiAct<0> E{WSB(WS_BIG), 2 * LW};
                pg8::gemm_phase<pg8::EpiAct<0>, true, true, 1>(lds, g, S, E);
#define SEGS_A CSEG(4, 0, C_QKV); CSEG(5, 0, C_O)
#define SEGS_E CSEG(1, 2, C_W); CSEG(4, 1, C_QKV); CSEG(5, 1, C_O)
                if (L == 0) FILLER2(1, ADA_IT, C_QKV + C_O, SEGS_A);
                if (L == 2) FILLER2(1, -1, C_W + C_QKV + C_O, SEGS_E);
#undef SEGS_A
#undef SEGS_E
            } else {
                const bf16_t* wq = WSB(WS_WQKV) + (size_t)j * (3 * D) * D; const bf16_t* XN = WSB(WS_XN);
                pg8::Gemm g{XN, wq, D, D, D, -1, wq + (size_t)(2 * D) * D, XN, 0}; pg8::StaticOrder S; S.init(36, 2 * D / 256, G, bxp, D / 256, 36);
                pg8::EpiQKV E{WSB(WS_BIG), WSB(WS_BIG + 36 * MiB), WSB(WS_BIG + 72 * MiB), 0.08838834764831845f};
                pg8::gemm_phase<pg8::EpiQKV, true, true, 2>(lds, g, S, E);
#define SEGS_C CSEG(3, 1, C_OUT); CSEG(6, 1, C_G)
#define SEGS_F CSEG(1, 3, C_W)
                if (L == 1) FILLER2(2, 3 * ADA_IT, C_OUT + C_G, SEGS_C);
                if (L == 3) FILLER2(2, -1, C_W, SEGS_F);
#undef SEGS_C
#undef SEGS_F
            }
        }
        if (IN(base + 1)) {
            PHASE_BEGIN();
            if (lru) {
                const float* cw = INP(11) + (size_t)j * 4 * LW; const float* cb = INP(12) + (size_t)j * LW; const bf16_t* GU = WSB(WS_BIG); bf16_t* UC = WSB(WS_UC);
                for (int rep = 0; rep < REP_CONV; ++rep)
                for (int it = gw; it < 288 * NLB; it += NGW) {
                    const int strip = it / NLB, cg = it % NLB, ch = cg * 256 + 4 * lane;
                    int seg0, seglen, t0; if (strip < 256) { seg0 = (strip >> 6) * SEQ; seglen = SEQ; t0 = (strip & 63) * 32; } else { const int s2 = strip - 256; seg0 = ML + (s2 >> 3) * CTX; seglen = CTX; t0 = (s2 & 7) * 32; }
                    const f32x4 w0 = *(const f32x4*)(cw + ch), w1 = *(const f32x4*)(cw + LW + ch), w2 = *(const f32x4*)(cw + 2 * LW + ch), w3 = *(const f32x4*)(cw + 3 * LW + ch), bv = *(const f32x4*)(cb + ch);
                    u32x2 uw[35];
#pragma unroll
                    for (int i = 0; i < 35; ++i) { const int t = t0 - 2 + i; const int tc = t < 0 ? 0 : (t >= seglen ? seglen - 1 : t); uw[i] = *(const u32x2*)(GU + (size_t)(seg0 + tc) * (2 * LW) + LW + ch); }
                    __builtin_amdgcn_sched_barrier(0);
                    auto cvu = [&](int i) -> f32x4 { const int t = t0 - 2 + i; const float z = (t < 0 || t >= seglen) ? 0.f : 1.f; return (f32x4){bf_lo(uw[i].x) * z, bf_hi(uw[i].x) * z, bf_lo(uw[i].y) * z, bf_hi(uw[i].y) * z}; };
                    f32x4 um2 = cvu(0), um1 = cvu(1), u0 = cvu(2);
#pragma unroll
                    for (int t = 0; t < 32; ++t) { const f32x4 up1 = cvu(t + 3);
                        const f32x4 y = w0 * um2 + w1 * um1 + w2 * u0 + w3 * up1 + bv;
                        u32x2 wv; wv.x = pk2(y.x, y.y); wv.y = pk2(y.z, y.w); *(u32x2*)(UC + (size_t)(seg0 + t0 + t) * LW + ch) = wv;
                        um2 = um1; um1 = u0; u0 = up1; }
                }
            } else {
                const bf16_t* Qb = WSB(WS_BIG); const bf16_t* KTp = WSB(WS_BIG + 36 * MiB); const bf16_t* VTp = WSB(WS_BIG + 72 * MiB); bf16_t* Ob = WSB(WS_O);
                const float* rpg = INP(20) + (size_t)j * NH * 465;
                for (int rep = 0; rep < REP_ATTN; ++rep)
                for (int it = vcu; it < BATCH * NH * 4; it += G) { const int qr = it & 3, h = (it >> 2) & 15, b = it >> 6;
                    __syncthreads();
                    { const int oc0 = (ML + b * CTX) >> 3;
                      for (int ci = tid; ci < 4096; ci += NTHREADS) { const int o = ci >> 7, wq = ci & 127;
                          const u32x4 kv = *(const u32x4*)(KTp + ((size_t)((oc0 + o) * NH + h)) * 1024 + wq * 8);
                          *(LAS u32x4*)(lds + o * 2048 + (wq & ~15) * 16 + ((wq & 15) ^ (o & 2)) * 16) = kv;
                          const u32x4 vv = *(const u32x4*)(VTp + ((size_t)((oc0 + o) * NH + h)) * 1024 + wq * 8);
                          *(LAS u32x4*)(lds + 65536 + o * 2048 + wq * 16) = vv; }
                      LAS float* rp = (LAS float*)(lds + LDS_MISC + 1024);
                      for (int i = tid; i < 465; i += NTHREADS) rp[i] = rpg[h * 465 + i]; }
                    __syncthreads();
#pragma unroll 1
                    for (int rd = 0; rd < 4; ++rd) attn_unit<true>(Qb, KTp, VTp, Ob, lds, b, h, 8 * qr + 2 * rd + (wave >> 2), wave & 3, 0, lane);
                    if (!lastL && wave < 4) attn_unit<false>(Qb, KTp, VTp, Ob, lds, b, h, 0, 0, 4 * qr + wave, lane);
                }
                __syncthreads();
            }
        }
        if (lru) {
            if (IN(base + 2)) {
                PHASE_BEGIN();
                const bf16_t* UC = WSB(WS_UC);
                pg8::Gemm g{UC, WSB(WS_WG) + (size_t)j * (NLB * 1024) * LB, LW, LB, LB, 2, nullptr, nullptr, 0}; pg8::StaticOrder S; S.init(36, NLB * 4, G, bxp);
                pg8::EpiGates E{UC, (unsigned*)(wsl + WS_LA), INP(15) + (size_t)j * 2 * LW, INP(17) + (size_t)j * 2 * LW, WSF(WS_CA) + (size_t)j * 2 * LW};
                for (int rep = 0; rep < REP_GATES; ++rep) pg8::gemm_phase<pg8::EpiGates, false, true>(lds, g, S, E);
#define SEGS_H0 CSEG(5, 0, C_O)
#define SEGS_H1 CSEG(5, 1, C_O)
#undef SEGS_H0
#undef SEGS_H1
            }
            if (IN(base + 3)) {
                PHASE_BEGIN();
                const unsigned* LB = (const unsigned*)(wsl + WS_LA); float* AGGA = WSF(WS_AGGA); float* AGGH = WSF(WS_AGGH);
                for (int rep = 0; rep < REP_S1; ++rep)
                for (int it = gw; it < 2 * BATCH * 72 * 22; it += NGW) {
                    const int cg = it % 22, r1 = it / 22, q = r1 % 72, r2 = r1 / 72, b = r2 & 3, dir = r2 >> 2;
                    const int ch = cg * 128 + 2 * lane;
                    const int rbase = q < 8 ? ML + b * CTX + 32 * q : b * SEQ + 32 * (q - 8);
                    const unsigned* lp = LB + ((size_t)(dir * 36 + (rbase >> 8)) * 22 + cg) * 32768 + (size_t)(rbase & 255) * 128 + 2 * lane;
                    float sl0 = 0.f, sl1 = 0.f, h0 = 0.f, h1 = 0.f;
                    u32x2 lb[32];
#pragma unroll
                    for (int t = 0; t < 32; ++t) lb[t] = *(const u32x2*)(lp + (size_t)t * 128);
                    __builtin_amdgcn_sched_barrier(0);
                    if (dir == 0) {
#pragma unroll
                        for (int t = 0; t < 32; ++t) { const float l0 = bf_lo(lb[t].x), l1 = bf_lo(lb[t].y); LRU_STEP(h0, l0, bf_hi(lb[t].x)); LRU_STEP(h1, l1, bf_hi(lb[t].y)); sl0 += l0; sl1 += l1; }
                    } else {
#pragma unroll
                        for (int t = 31; t >= 0; --t) { const float l0 = bf_lo(lb[t].x), l1 = bf_lo(lb[t].y); LRU_STEP(h0, l0, bf_hi(lb[t].x)); LRU_STEP(h1, l1, bf_hi(lb[t].y)); sl0 += l0; sl1 += l1; }
                    }
                    const size_t o = ((size_t)(dir * BATCH + b) * 72 + q) * LW + ch;
                    *(f32x2*)(AGGA + o) = (f32x2){fast_exp2(sl0), fast_exp2(sl1)}; *(f32x2*)(AGGH + o) = (f32x2){h0, h1};
                }
            }
            if (IN(base + 4)) {
                PHASE_BEGIN();
                const float* AGGA = WSF(WS_AGGA); const float* AGGH = WSF(WS_AGGH); float* CARRY = WSF(WS_CARRY);
                for (int rep = 0; rep < REP_S2; ++rep)
                for (int i = (wave * G + vcu) * 64 + lane; i < 2 * BATCH * LW; i += NGW * 64) {
                    const int ch = i % LW, db = i / LW, dir = db >> 2;
                    const size_t o = (size_t)db * 72 * LW + ch; float h = 0.f;
                    for (int bt = 0; bt < 2; ++bt) { float av[36], hv[36];
#pragma unroll
                        for (int k = 0; k < 36; ++k) { const int st = bt * 36 + k, q = dir ? (st < 8 ? 7 - st : 79 - st) : st; av[k] = AGGA[o + (size_t)q * LW]; hv[k] = AGGH[o + (size_t)q * LW]; }
#pragma unroll
                        for (int k = 0; k < 36; ++k) { const int st = bt * 36 + k, q = dir ? (st < 8 ? 7 - st : 79 - st) : st; CARRY[o + (size_t)q * LW] = h; h = av[k] * h + hv[k]; } }
                }
            }
            if (IN(base + 5)) {
                PHASE_BEGIN();
                const unsigned* LB = (const unsigned*)(wsl + WS_LA); const float* CARRY = WSF(WS_CARRY); const bf16_t* GU = WSB(WS_BIG); bf16_t* Zb = WSB(WS_Z);
                for (int rep = 0; rep < REP_S3; ++rep)
                for (int it = gw; it < BATCH * 72 * 22; it += NGW) {
                    const int cg = it % 22, r1 = it / 22, q = r1 % 72, b = r1 / 72;
                    const int ch = cg * 128 + 2 * lane;
                    const int rbase = q < 8 ? ML + b * CTX + 32 * q : b * SEQ + 32 * (q - 8);
                    const size_t ro = (size_t)rbase * LW + ch;
                    const size_t c0 = ((size_t)(0 * BATCH + b) * 72 + q) * LW + ch, c1 = ((size_t)(1 * BATCH + b) * 72 + q) * LW + ch;
                    float hf0[32], hf1[32];
                    const unsigned* l0p = LB + ((size_t)(rbase >> 8) * 22 + cg) * 32768 + (size_t)(rbase & 255) * 128 + 2 * lane;
                    { u32x2 lb[32]; const f32x2 hc = *(const f32x2*)(CARRY + c0);
#pragma unroll
                      for (int t = 0; t < 32; ++t) lb[t] = *(const u32x2*)(l0p + (size_t)t * 128);
                      __builtin_amdgcn_sched_barrier(0);
                      float h0 = hc.x, h1 = hc.y;
#pragma unroll
                      for (int t = 0; t < 32; ++t) { LRU_STEP(h0, bf_lo(lb[t].x), bf_hi(lb[t].x)); LRU_STEP(h1, bf_lo(lb[t].y), bf_hi(lb[t].y)); hf0[t] = h0; hf1[t] = h1; } }
                    { u32x2 lb[32]; unsigned gwv[32]; const f32x2 hc = *(const f32x2*)(CARRY + c1);
                      const unsigned* l1p = l0p + (size_t)36 * 22 * 32768;
#pragma unroll
                      for (int t = 0; t < 32; ++t) { lb[t] = *(const u32x2*)(l1p + (size_t)t * 128); gwv[t] = *(const unsigned*)(GU + (size_t)(rbase + t) * (2 * LW) + ch); }
                      __builtin_amdgcn_sched_barrier(0);
                      float h0 = hc.x, h1 = hc.y;
#pragma unroll
                      for (int t = 31; t >= 0; --t) { LRU_STEP(h0, bf_lo(lb[t].x), bf_hi(lb[t].x)); LRU_STEP(h1, bf_lo(lb[t].y), bf_hi(lb[t].y));
                          const float g0 = bf_lo(gwv[t]), g1 = bf_hi(gwv[t]);
                          const float z0 = g0 * fast_sigmoid(1.5957691216057308f * (g0 + 0.044715f * g0 * g0 * g0)) * (hf0[t] + h0);
                          const float z1 = g1 * fast_sigmoid(1.5957691216057308f * (g1 + 0.044715f * g1 * g1 * g1)) * (hf1[t] + h1);
                          *(unsigned*)(Zb + ro + (size_t)t * LW) = pk2(z0, z1); } }
                }
            }
        }
        if (IN(base + 6)) {
            PHASE_BEGIN();
            const bf16_t* Ao = lru ? WSB(WS_Z) : WSB(WS_O); const bf16_t* Bo = lru ? WSB(WS_WOUT) + (size_t)j * D * LW : WSB(WS_WO) + (size_t)j * D * D; const int Ko = lru ? LW : D;
            pg8::Gemm g{Ao, Bo, Ko, Ko, Ko, -1, Ao, Bo, 1};
            pg8::StaticOrder S; if (lastL) S.init(32, D / 256, G, bxp); else if (G == 256) S.init(32, D / 256, -G, bxp + 256, 4, D / 256, 1);
            else S.init(32, D / 256, G, bxp, 4, D / 256, 1);
            if (L == 0) { pg8::EpiResidT<true, 1> E{WSB(WS_X), WSF(WS_MODS) + (size_t)L * 5 * MODW, 2, WSF(WS_SLAB), INP(0), INP(7) + (size_t)L * D, 3 * D, 64u * (2 * L + 1), lds};
                pg8::gemm_phase<pg8::EpiResidT<true, 1>, true, true>(lds, g, S, E); }
            else { pg8::EpiResidT<false, 1> E{WSB(WS_X), WSF(WS_MODS) + (size_t)L * 5 * MODW, 2, WSF(WS_SLAB), nullptr, INP(7) + (size_t)L * D, 3 * D, 64u * (2 * L + 1), lds};
                pg8::gemm_phase<pg8::EpiResidT<false, 1>, true, true>(lds, g, S, E); }
        }
        if (IN(base + 7) && !lastL) {
            PHASE_BEGIN();
            const float* ml = WSF(WS_MODS) + (size_t)L * 5 * MODW; bf16_t* X = WSB(WS_X); bf16_t* XN = WSB(WS_XN); const float* g2 = INP(7) + (size_t)L * D;
            const float* slab = WSF(WS_SLAB);
#define VECS7(m) norm_vecs<0>(g2, ml + (size_t)(m) * MODW + 3 * D, ml + (size_t)(m) * MODW + 4 * D, GG, SS, lane)
#define SRC7(r) (X + (size_t)(r) * D)
#define APP7(v, r) norm_apply<0>(v, nullptr, GG, SS, XN + (size_t)(r) * D, nullptr, lane)
            if (!lastL) { f32x4 GG[8], SS[8]; VECS7(4); const float* mm = ml + (size_t)4 * MODW;
                for (int row = ML + gw; row < M; row += NGW) { f32x4 v[8]; norm_load(X + (size_t)row * D, v, lane);
                    norm_apply<0>(v, X + (size_t)row * D, GG, SS, XN + (size_t)row * D, nullptr, lane,
                                  (const float*)((const bf16_t*)slab + (size_t)((row - ML) >> 8) * 64 * 65536 + (size_t)(row & 255) * 256), mm + 2 * D); } }
#undef VECS7
#undef SRC7
#undef APP7
        }
        if (IN(base + 8)) {
            if (threadIdx.x == 0) ((volatile LAS int*)(lds + pg8::CC_TAB_OFF))[4] = lastL ? G : pg8::gemm_cc(36 * (FF / 256), G);
            PHASE_BEGIN();
            pg8::Gemm g{WSB(WS_XN), WSB(WS_W1) + (size_t)L * FF * D, D, D, D, -1, nullptr, nullptr, 0}; pg8::StaticOrder S; S.init(nMrows, FF / 256, G, bxp);
            pg8::EpiAct<1> E{WSB(WS_BIG), FF};
            pg8::gemm_phase<pg8::EpiAct<1>, true, true, 4>(lds, g, S, E);
#define SEGS_B CSEG(2, 1, C_IN)
#define SEGS_D CSEG(0, 2, C_W)
#define SEGS_G CSEG(0, 3, C_W)
            if (L == 0) FILLER2(4, 2 * ADA_IT, C_IN, SEGS_B);
            if (L == 1) FILLER2(4, -1, C_W, SEGS_D);
            if (L == 2) FILLER2(4, -1, C_W, SEGS_G);
#undef SEGS_B
#undef SEGS_D
#undef SEGS_G
        }
        if (IN(base + 9)) {
            PHASE_BEGIN();
            const bf16_t* Ao = WSB(WS_BIG); const bf16_t* Bo = WSB(WS_W2) + (size_t)L * D * FF;
            pg8::Gemm g{Ao, Bo, FF, FF, FF, -1, Ao, Bo, 1};
            pg8::StaticOrder S; if (lastL) S.init(32, D / 256, G, bxp); else if (G == 256) S.init(32, D / 256, -G, bxp + 256, 4, D / 256, 1);
            else S.init(32, D / 256, G, bxp, 4, D / 256, 1);
            if (lastL) { pg8::EpiResidT<false, 2> E{WSB(WS_X), WSF(WS_MODS) + (size_t)L * 5 * MODW, 5, (float*)TABP(23), nullptr, INP(22), 0, 64u * (2 * L + 2), lds};
                pg8::gemm_phase<pg8::EpiResidT<false, 2>, true, true>(lds, g, S, E); }
            else { pg8::EpiResidT<false, 1> E{WSB(WS_X), WSF(WS_MODS) + (size_t)L * 5 * MODW, 5, WSF(WS_SLAB), nullptr, INP(6) + (size_t)(L + 1) * D, 5 * MODW, 64u * (2 * L + 2), lds};
                pg8::gemm_phase<pg8::EpiResidT<false, 1>, true, true>(lds, g, S, E); }
        }
        if (IN(base + 10) && !lastL) {
            PHASE_BEGIN();
            bf16_t* X = WSB(WS_X);
#define SRC10(r) (X + (size_t)(r) * D)
            { const float* mn = WSF(WS_MODS) + (size_t)(L + 1) * 5 * MODW; bf16_t* XN = WSB(WS_XN); const float* g1n = INP(6) + (size_t)(L + 1) * D;
                const float* slab = WSF(WS_SLAB); const float* gate5 = WSF(WS_MODS) + ((size_t)L * 5 + 4) * MODW + 5 * D;
#define VECS10B(m) norm_vecs<0>(g1n, mn + (size_t)(m) * MODW, mn + (size_t)(m) * MODW + D, GG, SS, lane)
#define APP10B(v, r) norm_apply<0>(v, nullptr, GG, SS, XN + (size_t)(r) * D, nullptr, lane)
                { f32x4 GG[8], SS[8]; VECS10B(4);
                  for (int row = ML + gw; row < M; row += NGW) { f32x4 v[8]; norm_load(X + (size_t)row * D, v, lane);
                      norm_apply<0>(v, X + (size_t)row * D, GG, SS, XN + (size_t)row * D, nullptr, lane,
                                    (const float*)((const bf16_t*)slab + (size_t)((row - ML) >> 8) * 64 * 65536 + (size_t)(row & 255) * 256), gate5); } }
#undef VECS10B
#undef APP10B
            }
#undef SRC10
        }
    }
#undef IN
#undef PHASE_BEGIN
}

static inline dim3 g1(size_t n) { return dim3((unsigned)((n + 255) / 256)); }

extern "C" void kernel_launch(void* const* d_in, const int* in_sizes, int n_in, void* d_out, int out_size, void* d_ws, size_t ws_size, hipStream_t stream) {
    static int grid = 0;
    if (grid == 0) {
        int dev = 0, cus = 0;
        if (hipGetDevice(&dev) != hipSuccess || hipDeviceGetAttribute(&cus, hipDeviceAttributeMultiprocessorCount, dev) != hipSuccess) { grid = -1; return; }
        if (hipFuncSetAttribute((const void*)mega, hipFuncAttributeMaxDynamicSharedMemorySize, LDS_BYTES) != hipSuccess) { fprintf(stderr, "hipFuncSetAttribute failed\n"); grid = -1; return; }
        int per_cu = 0; (void)hipOccupancyMaxActiveBlocksPerMultiprocessor(&per_cu, (const void*)mega, NTHREADS, LDS_BYTES); (void)hipGetLastError();
        grid = cus;
    }
    if (grid < 0) return;
    const float* norm1_g = (const float*)d_in[6]; const float* norm2_g = (const float*)d_in[7];
    const float* lru_w_in = (const float*)d_in[10]; const float* lru_conv_w = (const float*)d_in[11];
    const float* lru_conv_b = (const float*)d_in[12]; const float* lru_lambda = (const float*)d_in[13]; const float* lru_wa = (const float*)d_in[14]; const float* lru_ba = (const float*)d_in[15];
    const float* lru_wx = (const float*)d_in[16]; const float* lru_bx = (const float*)d_in[17]; const float* lru_w_out = (const float*)d_in[18]; const float* na_w_qkv = (const float*)d_in[19];
    const float* na_rpb = (const float*)d_in[20]; const float* na_w_o = (const float*)d_in[21];
    (void)norm2_g;
    char* ws = (char*)d_ws;
    (void)hipMemsetAsync(ws + WS_CTL, 0, CTL_ZERO_BYTES, stream);
    Args a{};
    for (int i = 0; i < 23; ++i) a.in[i] = (const float*)d_in[i];
    a.out = (float*)d_out; a.ws = (unsigned char*)d_ws;
    auto run = [&](int lo, int hi) { a.ph_lo = lo; a.ph_hi = hi; hipLaunchKernelGGL(mega, dim3(grid), dim3(NTHREADS), LDS_BYTES, stream, a); };
#if ONE_LAUNCH
    if (WS_FAST_END > ws_size) { fprintf(stderr, "ws too small\n"); return; }
    run(0, PH_END);
#else
    size_t off = (FAST_LRU ? WS_FAST_END : WS_NV);
    auto alloc = [&](size_t bytes) { float* p = (float*)(ws + off); off += (bytes + 255) & ~(size_t)255; return p; };
    float* H = alloc((size_t)M * D * 4); float* T1 = alloc((size_t)M * D * 4);
    float* BIGF = alloc((size_t)M * 3 * D * 4);
    float* UCf = alloc((size_t)M * LW * 4); float* RA = alloc((size_t)M * LW * 4); float* RX = alloc((size_t)M * LW * 4); float* Y = alloc((size_t)M * LW * 4);
    if (!(FAST_LRU && FAST_NA)) { if (off > ws_size) { fprintf(stderr, "ws too small: need %zu have %zu\n", off, ws_size); return; } }
    else if (WS_FAST_END > ws_size) return;
    float* mods = (float*)(ws + WS_MODS); float* X = (float*)(ws + WS_X);
    run(PH_PROLOGUE, PH_PROLOGUE + 1);
    run(PH_NORM0, PH_NORM0 + 1);
    for (int L = 0; L < DEPTH; ++L) {
        const int base = PH_LAYER0 + PH_PER_LAYER * L; const bool lru = !(L & 1); const int j = L / 2;
        const float* ml = mods + (size_t)L * 5 * MODW;
        if (lru) {
            if (FAST_LRU) { for (int p = 0; p <= 6; ++p) run(base + p, base + p + 1); }
            else {
                nv::k_norm_mod<<<M, 256, 0, stream>>>(X, norm1_g + (size_t)L * D, ml, 0, H, D);
                float* GUf = BIGF;
                nv::k_sgemm<<<dim3(2 * LW / 128, M / 128, 1), 256, 0, stream>>>(H, D, 0, lru_w_in + (size_t)j * D * 2 * LW, 2 * LW, 0, GUf, 2 * LW, 0, D);
                nv::k_conv<<<g1((size_t)M * LW), 256, 0, stream>>>(GUf, lru_conv_w + (size_t)j * 4 * LW, lru_conv_b + (size_t)j * LW, UCf);
                for (int d = 0; d < 2; ++d) {
                    const size_t wo = ((size_t)j * 2 + d) * NLB * LB * LB, bo = ((size_t)j * 2 + d) * LW;
                    nv::k_sgemm<<<dim3(LB / 128, M / 128, NLB), 256, 0, stream>>>(UCf, LW, LB, lru_wa + wo, LB, (size_t)LB * LB, RA, LW, LB, LB);
                    nv::k_sgemm<<<dim3(LB / 128, M / 128, NLB), 256, 0, stream>>>(UCf, LW, LB, lru_wx + wo, LB, (size_t)LB * LB, RX, LW, LB, LB);
                    nv::k_lru_coef<<<g1((size_t)M * LW), 256, 0, stream>>>(RA, RX, UCf, lru_ba + bo, lru_bx + bo, lru_lambda + bo);
                    nv::k_scan_dir<<<g1(BATCH * LW), 256, 0, stream>>>(RA, RX, Y, d);
                }
                nv::k_gate_mul<<<g1((size_t)M * LW), 256, 0, stream>>>(GUf, Y, UCf);
                nv::k_sgemm<<<dim3(D / 128, M / 128, 1), 256, 0, stream>>>(UCf, LW, 0, lru_w_out + (size_t)j * LW * D, D, 0, T1, D, 0, LW);
                nv::k_resid<<<g1((size_t)M * D), 256, 0, stream>>>(X, T1, ml, 2, M);
            }
        } else {
            if (FAST_NA) { run(base + 0, base + 1); run(base + 1, base + 2); run(base + 6, base + 7); }
            else {
                nv::k_norm_mod<<<M, 256, 0, stream>>>(X, norm1_g + (size_t)L * D, ml, 0, H, D);
                float* QKV = BIGF;
                nv::k_sgemm<<<dim3(3 * D / 128, M / 128, 1), 256, 0, stream>>>(H, D, 0, na_w_qkv + (size_t)j * D * 3 * D, 3 * D, 0, QKV, 3 * D, 0, D);
                nv::k_attn<<<M * NH / 4, 256, 0, stream>>>(QKV, na_rpb + (size_t)j * NH * 15 * 31, H);
                nv::k_sgemm<<<dim3(D / 128, M / 128, 1), 256, 0, stream>>>(H, D, 0, na_w_o + (size_t)j * D * D, D, 0, T1, D, 0, D);
                nv::k_resid<<<g1((size_t)M * D), 256, 0, stream>>>(X, T1, ml, 2, M);
            }
        }
        run(base + 7, base + 8); run(base + 8, base + 9); run(base + 9, base + 10); run(base + 10, base + 11);
    }
#endif
}
```

```cpp
#include <hip/hip_runtime.h>
#include <cstdint>
#include <cstdio>

#ifndef FAST_MLP
#define FAST_MLP 1
#endif
#ifndef FAST_NA
#define FAST_NA 1
#endif
#ifndef FAST_LRU
#define FAST_LRU 1
#endif
#ifndef REP_PRO
#define REP_PRO 1
#endif
#ifndef REP_NORM
#define REP_NORM 1
#endif
#ifndef REP_ATTN
#define REP_ATTN 1
#endif
#ifndef REP_SCAN
#define REP_SCAN 1
#endif
#ifndef REP_CONV
#define REP_CONV 1
#endif
#ifndef REP_S1
#define REP_S1 1
#endif
#ifndef REP_S2
#define REP_S2 1
#endif
#ifndef REP_S3
#define REP_S3 1
#endif
#ifndef REP_IN
#define REP_IN 1
#endif
#ifndef REP_GATES
#define REP_GATES 1
#endif
#ifndef REP_MLP1
#define REP_MLP1 1
#endif
#ifndef REP_OUT
#define REP_OUT 1
#endif
#ifndef REP_MLP2
#define REP_MLP2 1
#endif
#ifndef REP_GEMM
#define REP_GEMM 1
#endif
#ifndef ONE_LAUNCH
#define ONE_LAUNCH 1
#endif

namespace cfg {
constexpr int D = 2048, BATCH = 4, SEQ = 2048, DEPTH = 4, GRID_W = 64, CTX = 256, NH = 16, HD = 128;
constexpr int LW = 2816, NLB = 11, LB = 256, FF = 8192, NMOD = 6;
constexpr int ML = BATCH * SEQ, MC = BATCH * CTX, M = ML + MC;
constexpr int MODW = NMOD * D;
}
using namespace cfg;

#define LAS __attribute__((address_space(3)))
#define GAS __attribute__((address_space(1)))
typedef unsigned short bf16_t;
typedef short bf16x8 __attribute__((ext_vector_type(8)));
typedef float f32x4 __attribute__((ext_vector_type(4)));
typedef float f32x2 __attribute__((ext_vector_type(2)));
typedef unsigned u32x4 __attribute__((ext_vector_type(4)));
typedef unsigned u32x2 __attribute__((ext_vector_type(2)));

__device__ __forceinline__ float sigmoidf_(float x) { return 1.f / (1.f + expf(-x)); }
__device__ __forceinline__ float siluf_(float x) { return x * sigmoidf_(x); }
__device__ __forceinline__ float gelu_tanh(float x) { return 0.5f * x * (1.f + tanhf(0.7978845608028654f * (x + 0.044715f * x * x * x))); }
__device__ __forceinline__ int row_mod(int row) { return row < ML ? row / SEQ : 4; }
__device__ __forceinline__ unsigned f2bf(float f) { unsigned u = __builtin_bit_cast(unsigned, f); return (u + 0x7fffu + ((u >> 16) & 1u)) >> 16; }
__device__ __forceinline__ unsigned pk2(float lo, float hi) { return f2bf(lo) | (f2bf(hi) << 16); }
__device__ __forceinline__ float bf_lo(unsigned w) { return __builtin_bit_cast(float, w << 16); }
__device__ __forceinline__ float bf_hi(unsigned w) { return __builtin_bit_cast(float, w & 0xffff0000u); }
__device__ __forceinline__ unsigned cvt_pk_bf16(float lo, float hi) { unsigned r; asm volatile("v_cvt_pk_bf16_f32 %0, %1, %2" : "=v"(r) : "v"(lo), "v"(hi)); return r; }
__device__ __forceinline__ float fast_exp2(float x) { return __builtin_amdgcn_exp2f(x); }
__device__ __forceinline__ float fast_rcp(float x) { return __builtin_amdgcn_rcpf(x); }
__device__ __forceinline__ float fast_sigmoid(float x) { return fast_rcp(1.f + fast_exp2(-1.4426950408889634f * x)); }

namespace nv {
__global__ void k_norm_mod(const float* X, const float* g, const float* mods_l, int sh_idx, float* H, int ldh) {
    const int row = blockIdx.x, tid = threadIdx.x;
    const float* xr = X + (size_t)row * D;
    float v[8], ss = 0.f;
#pragma unroll
    for (int j = 0; j < 8; ++j) { v[j] = xr[tid + 256 * j]; ss += v[j] * v[j]; }
    __shared__ float red[256];
    red[tid] = ss; __syncthreads();
    for (int o = 128; o > 0; o >>= 1) { if (tid < o) red[tid] += red[tid + o]; __syncthreads(); }
    const float rstd = rsqrtf(red[0] / D + 1e-6f);
    const int m = row_mod(row);
#pragma unroll
    for (int j = 0; j < 8; ++j) {
        const int col = tid + 256 * j; float h = v[j] * rstd * g[col];
        if (sh_idx >= 0) { const float sh = mods_l[(size_t)m * MODW + sh_idx * D + col], sc = mods_l[(size_t)m * MODW + (sh_idx + 1) * D + col]; h = h * (1.f + sc) + sh; }
        H[(size_t)row * ldh + col] = h;
    }
}
__global__ __launch_bounds__(256) void k_sgemm(const float* A, int lda, size_t sA, const float* B, int ldb, size_t sB, float* C, int ldc, size_t sC, int K) {
    __shared__ float As[16][128 + 4], Bs[16][128 + 4];
    A += blockIdx.z * sA; B += blockIdx.z * sB; C += blockIdx.z * sC;
    const int tid = threadIdx.x, tx = tid & 15, ty = tid >> 4;
    const int m0 = blockIdx.y * 128, n0 = blockIdx.x * 128;
    float acc[8][8];
#pragma unroll
    for (int i = 0; i < 8; ++i)
#pragma unroll
        for (int j = 0; j < 8; ++j) acc[i][j] = 0.f;
    for (int k0 = 0; k0 < K; k0 += 16) {
#pragma unroll
        for (int i = 0; i < 2; ++i) {
            const int r = (tid >> 2) + 64 * i, kq = (tid & 3) * 4;
            const float4 a = *(const float4*)(A + (size_t)(m0 + r) * lda + k0 + kq);
            As[kq + 0][r] = a.x; As[kq + 1][r] = a.y; As[kq + 2][r] = a.z; As[kq + 3][r] = a.w;
            const int kk = (tid >> 5) + 8 * i, nq = (tid & 31) * 4;
            const float4 b = *(const float4*)(B + (size_t)(k0 + kk) * ldb + n0 + nq);
            *(float4*)&Bs[kk][nq] = b;
        }
        __syncthreads();
#pragma unroll
        for (int k = 0; k < 16; ++k) {
            float a[8], b[8];
            *(float4*)&a[0] = *(const float4*)&As[k][ty * 4]; *(float4*)&a[4] = *(const float4*)&As[k][64 + ty * 4];
            *(float4*)&b[0] = *(const float4*)&Bs[k][tx * 4]; *(float4*)&b[4] = *(const float4*)&Bs[k][64 + tx * 4];
#pragma unroll
            for (int i = 0; i < 8; ++i)
#pragma unroll
                for (int j = 0; j < 8; ++j) acc[i][j] += a[i] * b[j];
        }
        __syncthreads();
    }
#pragma unroll
    for (int i = 0; i < 8; ++i) {
        const int r = m0 + (i < 4 ? ty * 4 + i : 64 + ty * 4 + i - 4);
        *(float4*)(C + (size_t)r * ldc + n0 + tx * 4) = make_float4(acc[i][0], acc[i][1], acc[i][2], acc[i][3]);
        *(float4*)(C + (size_t)r * ldc + n0 + 64 + tx * 4) = make_float4(acc[i][4], acc[i][5], acc[i][6], acc[i][7]);
    }
}
__global__ void k_resid(float* X, const float* O, const float* mods_l, int g_idx, int rows) {
    const size_t i = (size_t)blockIdx.x * 256 + threadIdx.x; if (i >= (size_t)rows * D) return;
    const int row = i / D, col = i % D, m = row_mod(row);
    X[i] += mods_l[(size_t)m * MODW + g_idx * D + col] * O[i];
}
__global__ void k_sqrelu(float* A, size_t n) { const size_t i = (size_t)blockIdx.x * 256 + threadIdx.x; if (i < n) { const float v = fmaxf(A[i], 0.f); A[i] = v * v; } }
__global__ void k_conv(const float* GU, const float* cw, const float* cb, float* UC) {
    const size_t i = (size_t)blockIdx.x * 256 + threadIdx.x; if (i >= (size_t)M * LW) return;
    const int row = i / LW, c = i % LW;
    int seg0, seglen; if (row < ML) { seg0 = (row / SEQ) * SEQ; seglen = SEQ; } else { seg0 = ML + ((row - ML) / CTX) * CTX; seglen = CTX; }
    const int t = row - seg0; float s = cb[c];
    for (int j = 0; j < 4; ++j) { const int tt = t + j - 2; if (tt >= 0 && tt < seglen) s += cw[j * LW + c] * GU[(size_t)(seg0 + tt) * (2 * LW) + LW + c]; }
    UC[i] = s;
}
__global__ void k_lru_coef(float* RA, float* RX, const float* UC, const float* ba, const float* bx, const float* lam) {
    const size_t i = (size_t)blockIdx.x * 256 + threadIdx.x; if (i >= (size_t)M * LW) return;
    const int c = i % LW;
    const float r = sigmoidf_(RA[i] + ba[c]), ig = sigmoidf_(RX[i] + bx[c]);
    const float sp = log1pf(expf(-lam[c]));
    const float log_a = -8.f * r * sp;
    RA[i] = expf(log_a);
    RX[i] = sqrtf(-expm1f(2.f * log_a)) * (ig * UC[i]);
}
__global__ void k_scan_dir(const float* A, const float* Bc, float* Y, int dir) {
    const int idx = blockIdx.x * 256 + threadIdx.x; if (idx >= BATCH * LW) return;
    const int b = idx / LW, c = idx % LW;
    float h = 0.f;
    if (dir == 0) {
        for (int t = 0; t < CTX; ++t) { const size_t o = (size_t)(ML + b * CTX + t) * LW + c; h = A[o] * h + Bc[o]; Y[o] = h; }
        for (int t = 0; t < SEQ; ++t) { const size_t o = (size_t)(b * SEQ + t) * LW + c; h = A[o] * h + Bc[o]; Y[o] = h; }
    } else {
        for (int t = CTX - 1; t >= 0; --t) { const size_t o = (size_t)(ML + b * CTX + t) * LW + c; h = A[o] * h + Bc[o]; Y[o] += h; }
        for (int t = SEQ - 1; t >= 0; --t) { const size_t o = (size_t)(b * SEQ + t) * LW + c; h = A[o] * h + Bc[o]; Y[o] += h; }
    }
}
__global__ void k_gate_mul(const float* GU, const float* Y, float* Z) {
    const size_t i = (size_t)blockIdx.x * 256 + threadIdx.x; if (i >= (size_t)M * LW) return;
    const int row = i / LW, c = i % LW;
    Z[i] = gelu_tanh(GU[(size_t)row * (2 * LW) + c]) * Y[i];
}
__global__ __launch_bounds__(256) void k_attn(const float* QKV, const float* rpb_l, float* O) {
    __shared__ float qs[4][HD], ps[4][384];
    const int w = threadIdx.x >> 6, lane = threadIdx.x & 63;
    const int gw = blockIdx.x * 4 + w; const int row = gw / NH, h = gw % NH;
    const bool lat = row < ML;
    const int b = lat ? row / SEQ : (row - ML) / CTX;
    const int t = lat ? row % SEQ : 0, r = t / GRID_W, c = t % GRID_W;
    int rs = r - 4; rs = rs < 0 ? 0 : (rs > 24 ? 24 : rs);
    int cs = c - 8; cs = cs < 0 ? 0 : (cs > 48 ? 48 : cs);
    const float scale = 0.08838834764831845f;
    qs[w][lane] = QKV[(size_t)row * (3 * D) + h * HD + lane]; qs[w][lane + 64] = QKV[(size_t)row * (3 * D) + h * HD + lane + 64];
    __syncthreads();
    float s[6]; float mx = -1e30f;
#pragma unroll
    for (int i = 0; i < 6; ++i) {
        const int j = lane + 64 * i; int krow; float bias = 0.f; bool valid = true;
        if (j < 128) { const int a = j >> 4, kk = j & 15; krow = b * SEQ + (rs + a) * GRID_W + cs + kk; bias = rpb_l[(h * 15 + (rs + a - r + 7)) * 31 + (cs + kk - c + 15)]; valid = lat; }
        else krow = ML + b * CTX + (j - 128);
        float d = 0.f;
        if (valid) { const float* kp = QKV + (size_t)krow * (3 * D) + D + h * HD; for (int e = 0; e < HD; ++e) d += qs[w][e] * kp[e]; d = d * scale + bias; } else d = -1e30f;
        s[i] = d; mx = fmaxf(mx, d);
    }
    for (int o = 32; o > 0; o >>= 1) mx = fmaxf(mx, __shfl_xor(mx, o));
    float sum = 0.f;
#pragma unroll
    for (int i = 0; i < 6; ++i) { const float p = (s[i] <= -1e29f) ? 0.f : expf(s[i] - mx); s[i] = p; sum += p; }
    for (int o = 32; o > 0; o >>= 1) sum += __shfl_xor(sum, o);
    const float inv = 1.f / sum;
#pragma unroll
    for (int i = 0; i < 6; ++i) ps[w][lane + 64 * i] = s[i] * inv;
    __syncthreads();
    float o0 = 0.f, o1 = 0.f;
    for (int j = lat ? 0 : 128; j < 384; ++j) {
        int krow; if (j < 128) { const int a = j >> 4, kk = j & 15; krow = b * SEQ + (rs + a) * GRID_W + cs + kk; } else krow = ML + b * CTX + (j - 128);
        const float* vp = QKV + (size_t)krow * (3 * D) + 2 * D + h * HD; const float p = ps[w][j];
        o0 += p * vp[lane]; o1 += p * vp[lane + 64];
    }
    O[(size_t)row * D + h * HD + lane] = o0; O[(size_t)row * D + h * HD + lane + 64] = o1;
}
}

namespace pg8 {
constexpr int BM = 256, BK = 64, HALF = 128, HTB = HALF * BK * 2, STAGE_BYTES = 8 * HTB, NXCD = 8, WGM = 4;
__host__ __device__ __forceinline__ int lds_byte(int r, int c) { const int st = (r >> 4) * 2 + (c >> 5), rr = r & 15, cc = c & 31, ob = rr * 64 + cc * 2; return st * 1024 + (ob ^ (((ob >> 9) & 1) << 5)); }
__host__ __device__ __forceinline__ void stage_rc(int b, int& R, int& C) { const int st = b / 1024, sb = b % 1024, swz = sb ^ (((sb >> 9) & 1) << 5); R = (st >> 1) * 16 + swz / 64; C = (st & 1) * 32 + (swz % 64) / 2; }
__host__ __device__ __forceinline__ int perm32(int rho) { const int n = rho >> 4, i = rho & 15; return 8 * (i >> 2) + 4 * n + (i & 3); }
struct Unit { int pm, pn, sw, ks; };
struct Gemm { const bf16_t* A; const bf16_t* Bt; int lda, ldb, K, apn_shift; const bf16_t* A2; const bf16_t* Bt2; int ksplit; };
__device__ __forceinline__ int gemm_cc(int U, int G) { if (G & 7) return G; const int R = (U + G - 1) / G; int c = (U + R - 1) / R; c = (c + 7) & ~7; return c > G ? G : c; }
constexpr int CC_TAB_OFF = 131072 + 512;
struct StaticOrder {
    int nM, nN, nwg, G, c, nM2, nN2, nwg2, split;
    __device__ void init(int nM_, int nN_, int G_, int c_, int nM2_ = 0, int nN2_ = 0, int split_ = 0) { nM = nM_; nN = nN_; nwg = nM * nN; G = G_; c = c_; nM2 = nM2_; nN2 = nN2_; split = split_; nwg2 = split_ ? nM2 * nN2 * 8 : nM2 * nN2; }
    __device__ static void map(int wgid, int nM, int nN, int nwg, Unit& u) {
        { const int q = nwg / NXCD, r = nwg % NXCD, xcd = wgid % NXCD, off = wgid / NXCD; wgid = (xcd < r ? xcd * (q + 1) : r * (q + 1) + (xcd - r) * q) + off; }
        const int nig = WGM * nN, gid = wgid / nig, fm = gid * WGM, gsz = (nM - fm) < WGM ? (nM - fm) : WGM;
        u.pm = fm + ((wgid % nig) % gsz); u.pn = (wgid % nig) / gsz;
    }
    __device__ bool next(int i, Unit& u, const LAS unsigned char* lds, int cck) const {
        int Gs = G, cs = c; if (cck) { Gs = __builtin_amdgcn_readfirstlane(*(volatile const LAS int*)(lds + CC_TAB_OFF + 4 * cck)); cs = c < Gs ? c : (1 << 28); }
        const long L = (long)i * Gs + cs; if ((unsigned long)L >= (unsigned long)(nwg + nwg2)) return false;
        u.ks = 0;
        if (L < nwg) { map((int)L, nM, nN, nwg, u); u.sw = 0; }
        else if (!split) { map((int)L - nwg, nM2, nN2, nwg2, u); u.sw = 1; }
        else { const int L2 = (int)L - nwg; int tile, ks;
            if (nwg2 == 256) { const int x = L2 & 7, jj = L2 >> 3; tile = x * 4 + (jj >> 3); ks = jj & 7; } else { tile = L2 >> 3; ks = L2 & 7; }
            u.pm = nM + tile / nN2; u.pn = tile % nN2; u.sw = 1; u.ks = ks; }
        return true;
    }
};
template <class Epi, bool ALIGN_EPI, bool SP2, int CCK = 0>
__device__ __forceinline__ void gemm_phase(LAS unsigned char* lds, const Gemm g, const StaticOrder& S, const Epi& E) {
    int tid = threadIdx.x; asm volatile("" : "+v"(tid));
    const int wid = __builtin_amdgcn_readfirstlane(tid >> 6), lane = tid & 63, wr = wid >> 2, wc = wid & 3, fr = lane & 15, fq = lane >> 4;
    const int KT = g.K / BK, spl_e = (KT / 8) & ~1, spl_x = (KT - 8 * spl_e) / 2;
    unsigned voffA[2], voffB[2];
#pragma unroll
    for (int i = 0; i < 2; ++i) { int R, C; stage_rc(tid * 16 + i * 8192, R, C); const int Rb = Epi::PERM ? ((R & ~31) + perm32(R & 31)) : R;
        voffA[i] = (unsigned)(R * g.lda + C) * 2u; voffB[i] = (unsigned)(Rb * g.ldb + C) * 2u; }
    const size_t kstep = (size_t)(BK * 2);
    const size_t hstepA = (size_t)HALF * g.lda * 2, tstepA = 2 * hstepA, hstepB = (size_t)HALF * g.ldb * 2, tstepB = 2 * hstepB;
    const unsigned ldsw = (unsigned)wid * 1024u;
    const int aoff = lds_byte(wr * 64 + fr, fq * 8), boff = lds_byte(wc * 32 + fr, fq * 8);
#define PG8_SA(b, h) (((b) * 2 + (h)) * HTB)
#define PG8_SB(b, h) ((4 + (b) * 2 + (h)) * HTB)
#define PG8_STAGE(bufoff, gbase, voff) do { _Pragma("unroll") for (int _i = 0; _i < 2; ++_i) \
        __builtin_amdgcn_global_load_lds((const unsigned*)((const char*)(gbase) + (voff)[_i]), (LAS unsigned*)(lds + (bufoff) + ldsw + _i * 8192), 16, 0, 0); } while (0)
#define PG8_LDA(dst, b, h) do { _Pragma("unroll") for (int m = 0; m < 4; ++m) _Pragma("unroll") for (int k = 0; k < 2; ++k) dst[m][k] = *(const LAS bf16x8*)(lds + PG8_SA(b, h) + aoff + m * 2048 + k * 1024); } while (0)
#define PG8_LDB(dst, b, h) do { _Pragma("unroll") for (int n = 0; n < 2; ++n) _Pragma("unroll") for (int k = 0; k < 2; ++k) dst[n][k] = *(const LAS bf16x8*)(lds + PG8_SB(b, h) + boff + n * 2048 + k * 1024); } while (0)
#define PG8_MMA(ai, bj, At, Bt) do { __builtin_amdgcn_s_setprio(1); _Pragma("unroll") for (int m = 0; m < 4; ++m) _Pragma("unroll") for (int n = 0; n < 2; ++n) _Pragma("unroll") for (int k = 0; k < 2; ++k) \
        acc[ai][bj][m][n] = __builtin_amdgcn_mfma_f32_16x16x32_bf16(Bt[n][k], At[m][k], acc[ai][bj][m][n], 0, 0, 0); __builtin_amdgcn_s_setprio(0); } while (0)
#define PG8_WAIT_V(n) asm volatile("s_waitcnt vmcnt(" #n ")" ::: "memory")
#define PG8_WAIT_L(n) asm volatile("s_waitcnt lgkmcnt(" #n ")" ::: "memory")
#define PG8_BAR __builtin_amdgcn_s_barrier()
#define PG8_SCHED __builtin_amdgcn_sched_barrier(0)
#define PG8_KOFF(u) ((g.ksplit && (u).sw) ? (size_t)(spl_e * (u).ks + 2 * ((u).ks < spl_x ? (u).ks : spl_x)) * kstep : (size_t)0)
#define PG8_NT(u) ((g.ksplit && (u).sw) ? spl_e + ((u).ks < spl_x ? 2 : 0) : KT)
#define PG8_APTR(u) ((const char*)((u).sw ? g.A2 : g.A) + (size_t)(u).pm * tstepA + (g.apn_shift >= 0 ? (size_t)((u).pn >> g.apn_shift) * 512 : (size_t)0) + PG8_KOFF(u))
#define PG8_BPTR(u) ((const char*)((u).sw ? g.Bt2 : g.Bt) + (size_t)(u).pn * tstepB + PG8_KOFF(u))
    Unit cur, nxt; int ui = 0;
    if (!S.next(0, cur, lds, CCK)) return;
    f32x4 acc[2][2][4][2];
#pragma unroll
    for (int a = 0; a < 2; ++a)
#pragma unroll
        for (int b = 0; b < 2; ++b)
#pragma unroll
            for (int m = 0; m < 4; ++m)
#pragma unroll
                for (int n = 0; n < 2; ++n) acc[a][b][m][n] = (f32x4){0.f, 0.f, 0.f, 0.f};
    bf16x8 At[4][2], B0[2][2], B1[2][2];
    const char* cA = PG8_APTR(cur); const char* cB = PG8_BPTR(cur); int nt = PG8_NT(cur);
    if constexpr (SP2) {
        PG8_STAGE(PG8_SB(0, 0), cB, voffB); PG8_STAGE(PG8_SB(0, 1), cB + hstepB, voffB); PG8_STAGE(PG8_SA(0, 0), cA, voffA); PG8_STAGE(PG8_SA(0, 1), cA + hstepA, voffA);
        if (wr == 1) PG8_BAR;
        PG8_WAIT_V(2); PG8_BAR;
        PG8_STAGE(PG8_SB(1, 0), cB + kstep, voffB); PG8_STAGE(PG8_SA(1, 0), cA + kstep, voffA); PG8_STAGE(PG8_SB(1, 1), cB + hstepB + kstep, voffB);
        PG8_WAIT_V(6); PG8_BAR;
    } else {
        PG8_STAGE(PG8_SB(0, 0), cB, voffB); PG8_STAGE(PG8_SA(0, 0), cA, voffA); PG8_STAGE(PG8_SB(0, 1), cB + hstepB, voffB); PG8_STAGE(PG8_SA(0, 1), cA + hstepA, voffA);
        if (wr == 1) PG8_BAR;
        PG8_WAIT_V(4); PG8_BAR;
        PG8_STAGE(PG8_SB(1, 0), cB + kstep, voffB); PG8_STAGE(PG8_SA(1, 0), cA + kstep, voffA); PG8_STAGE(PG8_SB(1, 1), cB + hstepB + kstep, voffB);
        PG8_WAIT_V(6); PG8_BAR;
    }
    for (;;) {
        const bool has_next = S.next(ui + 1, nxt, lds, CCK);
        const char* nA = has_next ? PG8_APTR(nxt) : cA; const char* nB = has_next ? PG8_BPTR(nxt) : cB;
        for (int t = 0; t < nt; t += 2) {
            const bool last = (t == nt - 2);
            const char* a1 = cA + (size_t)(t + 1) * kstep;
            const char* a2 = last ? nA : cA + (size_t)(t + 2) * kstep; const char* b2 = last ? nB : cB + (size_t)(t + 2) * kstep;
            const char* a3 = a2 + kstep; const char* b3 = b2 + kstep;
            if constexpr (SP2) {
            PG8_LDB(B0, 0, 0); PG8_LDB(B1, 0, 1); PG8_SCHED; PG8_LDA(At, 0, 0); PG8_STAGE(PG8_SA(1, 1), a1 + hstepA, voffA);
            PG8_WAIT_V(8); PG8_WAIT_L(0); PG8_BAR; PG8_MMA(0, 0, At, B0); PG8_MMA(0, 1, At, B1); PG8_BAR; PG8_SCHED;
            PG8_LDA(At, 0, 1); PG8_STAGE(PG8_SB(0, 0), b2, voffB); PG8_STAGE(PG8_SB(0, 1), b2 + hstepB, voffB); PG8_STAGE(PG8_SA(0, 0), a2, voffA);
            PG8_WAIT_V(8); PG8_WAIT_L(0); PG8_BAR; PG8_MMA(1, 0, At, B0); PG8_MMA(1, 1, At, B1); PG8_BAR; PG8_SCHED;
            PG8_LDB(B0, 1, 0); PG8_LDB(B1, 1, 1); PG8_SCHED; PG8_LDA(At, 1, 0); PG8_STAGE(PG8_SA(0, 1), a2 + hstepA, voffA);
            PG8_WAIT_V(8); PG8_WAIT_L(0); PG8_BAR; PG8_MMA(0, 0, At, B0); PG8_MMA(0, 1, At, B1); PG8_BAR; PG8_SCHED;
            PG8_LDA(At, 1, 1); PG8_STAGE(PG8_SB(1, 0), b3, voffB); PG8_STAGE(PG8_SB(1, 1), b3 + hstepB, voffB); PG8_STAGE(PG8_SA(1, 0), a3, voffA);
            PG8_WAIT_V(8); PG8_WAIT_L(0); PG8_BAR; PG8_MMA(1, 0, At, B0); PG8_MMA(1, 1, At, B1); PG8_BAR; PG8_SCHED;
            } else {
            PG8_LDB(B0, 0, 0); PG8_SCHED; PG8_LDA(At, 0, 0); PG8_STAGE(PG8_SA(1, 1), a1 + hstepA, voffA);
            PG8_WAIT_L(8); PG8_BAR; PG8_WAIT_L(0); PG8_MMA(0, 0, At, B0); PG8_BAR; PG8_SCHED;
            PG8_LDB(B1, 0, 1); PG8_STAGE(PG8_SB(0, 0), b2, voffB);
            PG8_BAR; PG8_WAIT_L(0); PG8_MMA(0, 1, At, B1); PG8_BAR;
            PG8_LDA(At, 0, 1); PG8_STAGE(PG8_SA(0, 0), a2, voffA);
            PG8_BAR; PG8_WAIT_L(0); PG8_MMA(1, 0, At, B0); PG8_BAR; PG8_SCHED;
            PG8_STAGE(PG8_SB(0, 1), b2 + hstepB, voffB);
            PG8_WAIT_V(6); PG8_BAR; PG8_MMA(1, 1, At, B1); PG8_BAR;
            PG8_LDB(B0, 1, 0); PG8_SCHED; PG8_LDA(At, 1, 0); PG8_STAGE(PG8_SA(0, 1), a2 + hstepA, voffA);
            PG8_WAIT_L(8); PG8_BAR; PG8_WAIT_L(0); PG8_MMA(0, 0, At, B0); PG8_BAR; PG8_SCHED;
            PG8_LDB(B1, 1, 1); PG8_STAGE(PG8_SB(1, 0), b3, voffB);
            PG8_BAR; PG8_WAIT_L(0); PG8_MMA(0, 1, At, B1); PG8_BAR;
            PG8_LDA(At, 1, 1); PG8_STAGE(PG8_SA(1, 0), a3, voffA);
            PG8_BAR; PG8_WAIT_L(0); PG8_MMA(1, 0, At, B0); PG8_BAR; PG8_SCHED;
            PG8_STAGE(PG8_SB(1, 1), b3 + hstepB, voffB);
            PG8_WAIT_V(6); PG8_BAR; PG8_MMA(1, 1, At, B1); PG8_BAR;
            }
        }
        if constexpr (ALIGN_EPI) { if (wr == 0) PG8_BAR; }
        { int tz = threadIdx.x; asm volatile("" : "+v"(tz));
          const int wz = __builtin_amdgcn_readfirstlane(tz >> 6), lz = tz & 63; E(acc, cur, wz >> 2, wz & 3, lz & 15, lz >> 4); }
        if (!has_next) break;
#pragma unroll
        for (int a = 0; a < 2; ++a)
#pragma unroll
            for (int b = 0; b < 2; ++b)
#pragma unroll
                for (int m = 0; m < 4; ++m)
#pragma unroll
                    for (int n = 0; n < 2; ++n) acc[a][b][m][n] = (f32x4){0.f, 0.f, 0.f, 0.f};
        cur = nxt; cA = nA; cB = nB; ++ui; nt = PG8_NT(cur);
        if constexpr (ALIGN_EPI) { if (wr == 1) PG8_BAR; }
    }
    PG8_WAIT_V(0);
    if constexpr (!ALIGN_EPI) { if (wr == 0) PG8_BAR; }
    PG8_BAR;
#undef PG8_SA
#undef PG8_SB
#undef PG8_STAGE
#undef PG8_LDA
#undef PG8_LDB
#undef PG8_MMA
#undef PG8_WAIT_V
#undef PG8_WAIT_L
#undef PG8_BAR
#undef PG8_SCHED
#undef PG8_APTR
#undef PG8_BPTR
#undef PG8_KOFF
#undef PG8_NT
}

template <int ACT> struct EpiAct {
    static constexpr bool PERM = true;
    bf16_t* O; int ldc;
    __device__ __forceinline__ void operator()(const f32x4 (&acc)[2][2][4][2], const Unit& u, int wr, int wc, int fr, int fq) const {
        const int row0 = u.pm * BM + wr * 64 + fr, col0 = u.pn * BM + wc * 32 + 8 * fq;
#pragma unroll
        for (int ai = 0; ai < 2; ++ai)
#pragma unroll
            for (int m = 0; m < 4; ++m) { bf16_t* rowp = O + (size_t)(row0 + ai * HALF + m * 16) * ldc + col0;
#pragma unroll
                for (int bj = 0; bj < 2; ++bj) { f32x4 v0 = acc[ai][bj][m][0], v1 = acc[ai][bj][m][1];
                    if (ACT == 1) {
#pragma unroll
                        for (int j = 0; j < 4; ++j) { const float a = fmaxf(v0[j], 0.f), b = fmaxf(v1[j], 0.f); v0[j] = a * a; v1[j] = b * b; } }
                    u32x4 w; w.x = cvt_pk_bf16(v0[0], v0[1]); w.y = cvt_pk_bf16(v0[2], v0[3]); w.z = cvt_pk_bf16(v1[0], v1[1]); w.w = cvt_pk_bf16(v1[2], v1[3]);
                    *(u32x4*)(rowp + bj * HALF) = w; } }
    }
};
constexpr long long RN_DXN = (471ll - 399ll) << 20;
constexpr long long RN_DSLOT = (838ll - 399ll) << 20;
constexpr long long RN_DCNT = 131072ll - (399ll << 20);
constexpr int RN_LDS = 131072 + 4096;
template <bool XF32, int FUSE = 0  > struct EpiResidT {
    static constexpr bool PERM = true;
    bf16_t* X; const float* mods_l; int gidx; float* slab; const float* xin; const float* ng; int nsh_off; unsigned want; LAS unsigned char* lds;
    __device__ __forceinline__ void fuse_tail(f32x4 (&acc)[2][2][4][2], const float (&ssq)[2][4], const Unit& u, int wr, int wc, int fr, int fq, int mi, int row0, int col0) const {
        LAS float* P = (LAS float*)(lds + RN_LDS); LAS float* S = P + 1024; LAS unsigned* flag = (LAS unsigned*)(S + 256);
        const int wid = wr * 4 + wc, lane = fq * 16 + fr;
#pragma unroll
        for (int ai = 0; ai < 2; ++ai)
#pragma unroll
            for (int m = 0; m < 4; ++m) { float t = ssq[ai][m]; t += __shfl_xor(t, 16); t += __shfl_xor(t, 32);
                if (fq == 0) P[(ai * HALF + wr * 64 + m * 16 + fr) * 4 + wc] = t; }
        asm volatile("s_waitcnt lgkmcnt(0)" ::: "memory"); __builtin_amdgcn_s_barrier(); asm volatile("" ::: "memory");
        const int row = wid * 32 + (lane & 31);
        unsigned* slots = (unsigned*)((char*)X + RN_DSLOT) + ((size_t)(u.pm * BM + row) * 8);
        unsigned* pc = (unsigned*)((char*)X + RN_DCNT) + 64 * u.pm;
        if (lane < 32) { const f32x4 p = *(const LAS f32x4*)(P + row * 4); const float t = (p[0] + p[1]) + (p[2] + p[3]);
            __hip_atomic_store(slots + u.pn, __builtin_bit_cast(unsigned, t), __ATOMIC_RELAXED, __HIP_MEMORY_SCOPE_AGENT); }
        asm volatile("s_waitcnt vmcnt(0)" ::: "memory");
        if (lane == 0) __hip_atomic_fetch_add(pc, 1u, __ATOMIC_RELAXED, __HIP_MEMORY_SCOPE_AGENT);
        if (FUSE == 1 && !XF32) {
            int r0o = row0; asm volatile("" : "+v"(r0o)); bf16_t* xb = X + (size_t)r0o * D + col0;
#pragma unroll
            for (int ai = 0; ai < 2; ++ai)
#pragma unroll
                for (int m = 0; m < 4; ++m)
#pragma unroll
                    for (int bj = 0; bj < 2; ++bj) { const f32x4 v0 = acc[ai][bj][m][0], v1 = acc[ai][bj][m][1];
                        u32x4 w; w.x = cvt_pk_bf16(v0[0], v0[1]); w.y = cvt_pk_bf16(v0[2], v0[3]); w.z = cvt_pk_bf16(v1[0], v1[1]); w.w = cvt_pk_bf16(v1[2], v1[3]);
                        *(u32x4*)(xb + (size_t)(ai * HALF + m * 16) * D + bj * HALF) = w; }
        }
        if (wid == 0) { unsigned sp = 0u;
            while ((unsigned)__builtin_amdgcn_readfirstlane((int)__hip_atomic_load(pc, __ATOMIC_RELAXED, __HIP_MEMORY_SCOPE_AGENT)) < want) { __builtin_amdgcn_s_sleep(1); if (++sp > (1u << 18)) break; }
            __builtin_amdgcn_fence(__ATOMIC_ACQUIRE, "agent"); }
        asm volatile("s_waitcnt lgkmcnt(0)" ::: "memory"); __builtin_amdgcn_s_barrier(); asm volatile("" ::: "memory");
        if (lane < 32) { float t = 0.f;
#pragma unroll
            for (int k = 0; k < 8; ++k) t += __builtin_bit_cast(float, __hip_atomic_load(slots + k, __ATOMIC_RELAXED, __HIP_MEMORY_SCOPE_AGENT));
            S[row] = rsqrtf(t * (1.f / D) + 1e-6f); }
        asm volatile("s_waitcnt lgkmcnt(0)" ::: "memory"); __builtin_amdgcn_s_barrier(); asm volatile("" ::: "memory");
        if (FUSE == 2) {
            float* ob = slab + (size_t)row0 * D + col0;
#pragma unroll
            for (int bj = 0; bj < 2; ++bj) { const f32x4 G0 = *(const f32x4*)(ng + col0 + bj * HALF), G1 = *(const f32x4*)(ng + col0 + bj * HALF + 4);
#pragma unroll
                for (int ai = 0; ai < 2; ++ai)
#pragma unroll
                    for (int m = 0; m < 4; ++m) { const float rstd = S[ai * HALF + wr * 64 + m * 16 + fr];
                        *(f32x4*)(ob + (size_t)(ai * HALF + m * 16) * D + bj * HALF) = acc[ai][bj][m][0] * rstd * G0; *(f32x4*)(ob + (size_t)(ai * HALF + m * 16) * D + bj * HALF + 4) = acc[ai][bj][m][1] * rstd * G1; } }
            return;
        }
        bf16_t* XN = (bf16_t*)((char*)X + RN_DXN);
        const float* sh = mods_l + nsh_off + (size_t)mi * MODW + col0;
#pragma unroll
        for (int bj = 0; bj < 2; ++bj) { f32x4 GG[2], SS[2];
#pragma unroll
            for (int n = 0; n < 2; ++n) { GG[n] = *(const f32x4*)(ng + col0 + bj * HALF + 4 * n) * (*(const f32x4*)(sh + D + bj * HALF + 4 * n) + 1.f); SS[n] = *(const f32x4*)(sh + bj * HALF + 4 * n); }
#pragma unroll
            for (int ai = 0; ai < 2; ++ai)
#pragma unroll
                for (int m = 0; m < 4; ++m) { const float rstd = S[ai * HALF + wr * 64 + m * 16 + fr];
                    const f32x4 h0 = acc[ai][bj][m][0] * rstd * GG[0] + SS[0], h1 = acc[ai][bj][m][1] * rstd * GG[1] + SS[1];
                    u32x4 w; w.x = cvt_pk_bf16(h0[0], h0[1]); w.y = cvt_pk_bf16(h0[2], h0[3]); w.z = cvt_pk_bf16(h1[0], h1[1]); w.w = cvt_pk_bf16(h1[2], h1[3]);
                    *(u32x4*)(XN + (size_t)(row0 + ai * HALF + m * 16) * D + col0 + bj * HALF) = w; } }
    }
    __device__ __forceinline__ void operator()(f32x4 (&acc)[2][2][4][2], const Unit& u, int wr, int wc, int fr, int fq) const {
        if (u.sw) {
            bf16_t* base = (bf16_t*)slab + (size_t)(((u.pm - 32) * 8 + u.pn) * 8 + u.ks) * 65536 + (size_t)(wr * 64 + fr) * 256 + wc * 32 + 8 * fq;
#pragma unroll
            for (int ai = 0; ai < 2; ++ai)
#pragma unroll
                for (int m = 0; m < 4; ++m)
#pragma unroll
                    for (int bj = 0; bj < 2; ++bj) { const f32x4 v0 = acc[ai][bj][m][0], v1 = acc[ai][bj][m][1];
                        u32x4 w; w.x = cvt_pk_bf16(v0[0], v0[1]); w.y = cvt_pk_bf16(v0[2], v0[3]); w.z = cvt_pk_bf16(v1[0], v1[1]); w.w = cvt_pk_bf16(v1[2], v1[3]);
                        *(u32x4*)(base + (size_t)(ai * HALF + m * 16) * 256 + bj * HALF) = w; }
            return;
        }
        const int row0 = u.pm * BM + wr * 64 + fr, col0 = u.pn * BM + wc * 32 + 8 * fq;
        const int mi = u.pm < 32 ? (u.pm >> 3) : 4;
        const float* gt = mods_l + (size_t)mi * MODW + gidx * D + col0;
        f32x4 gv[2][2];
#pragma unroll
        for (int bj = 0; bj < 2; ++bj)
#pragma unroll
            for (int n = 0; n < 2; ++n) gv[bj][n] = *(const f32x4*)(gt + bj * HALF + 4 * n);
        float ssq[2][4];
#pragma unroll
        for (int ai = 0; ai < 2; ++ai)
#pragma unroll
            for (int m = 0; m < 4; ++m) ssq[ai][m] = 0.f;
        if (XF32) {
#pragma unroll
            for (int am = 0; am < 4; ++am) { const int ai = am >> 1, m0 = (am & 1) * 2;
                f32x4 xf[2][2][2];
#pragma unroll
                for (int mm = 0; mm < 2; ++mm)
#pragma unroll
                    for (int bj = 0; bj < 2; ++bj)
#pragma unroll
                        for (int n = 0; n < 2; ++n) xf[mm][bj][n] = *(const f32x4*)(xin + (size_t)(row0 + ai * HALF + (m0 + mm) * 16) * D + col0 + bj * HALF + 4 * n);
                __builtin_amdgcn_sched_barrier(0);
#pragma unroll
                for (int mm = 0; mm < 2; ++mm)
#pragma unroll
                    for (int bj = 0; bj < 2; ++bj) { const f32x4 v0 = xf[mm][bj][0] + gv[bj][0] * acc[ai][bj][m0 + mm][0], v1 = xf[mm][bj][1] + gv[bj][1] * acc[ai][bj][m0 + mm][1];
                        if (FUSE) { acc[ai][bj][m0 + mm][0] = v0; acc[ai][bj][m0 + mm][1] = v1; ssq[ai][m0 + mm] += ((v0[0] * v0[0] + v0[1] * v0[1]) + (v0[2] * v0[2] + v0[3] * v0[3])) + ((v1[0] * v1[0] + v1[1] * v1[1]) + (v1[2] * v1[2] + v1[3] * v1[3])); }
                        u32x4 w; w.x = cvt_pk_bf16(v0[0], v0[1]); w.y = cvt_pk_bf16(v0[2], v0[3]); w.z = cvt_pk_bf16(v1[0], v1[1]); w.w = cvt_pk_bf16(v1[2], v1[3]);
                        *(u32x4*)(X + (size_t)(row0 + ai * HALF + (m0 + mm) * 16) * D + col0 + bj * HALF) = w; }
                __builtin_amdgcn_sched_barrier(0);
            }
            if (FUSE) fuse_tail(acc, ssq, u, wr, wc, fr, fq, mi, row0, col0);
            return;
        }
#pragma unroll
        for (int ai = 0; ai < 2; ++ai) {
            u32x4 xo[4][2];
#pragma unroll
            for (int m = 0; m < 4; ++m)
#pragma unroll
                for (int bj = 0; bj < 2; ++bj) xo[m][bj] = *(const u32x4*)(X + (size_t)(row0 + ai * HALF + m * 16) * D + col0 + bj * HALF);
            __builtin_amdgcn_sched_barrier(0);
#pragma unroll
            for (int m = 0; m < 4; ++m)
#pragma unroll
                for (int bj = 0; bj < 2; ++bj) { const u32x4 x = xo[m][bj];
                    const f32x4 x0 = {bf_lo(x.x), bf_hi(x.x), bf_lo(x.y), bf_hi(x.y)}, x1 = {bf_lo(x.z), bf_hi(x.z), bf_lo(x.w), bf_hi(x.w)};
                    const f32x4 v0 = x0 + gv[bj][0] * acc[ai][bj][m][0], v1 = x1 + gv[bj][1] * acc[ai][bj][m][1];
                    if (FUSE) { acc[ai][bj][m][0] = v0; acc[ai][bj][m][1] = v1; ssq[ai][m] += ((v0[0] * v0[0] + v0[1] * v0[1]) + (v0[2] * v0[2] + v0[3] * v0[3])) + ((v1[0] * v1[0] + v1[1] * v1[1]) + (v1[2] * v1[2] + v1[3] * v1[3])); }
                    if (FUSE == 0) { u32x4 w; w.x = cvt_pk_bf16(v0[0], v0[1]); w.y = cvt_pk_bf16(v0[2], v0[3]); w.z = cvt_pk_bf16(v1[0], v1[1]); w.w = cvt_pk_bf16(v1[2], v1[3]);
                    *(u32x4*)(X + (size_t)(row0 + ai * HALF + m * 16) * D + col0 + bj * HALF) = w; } }
            __builtin_amdgcn_sched_barrier(0); asm volatile("" ::: "memory");
        }
        if (FUSE) fuse_tail(acc, ssq, u, wr, wc, fr, fq, mi, row0, col0);
    }
};
struct EpiQKV {
    static constexpr bool PERM = true;
    bf16_t* Q; bf16_t* KT; bf16_t* VT; float qscale;
    __device__ __forceinline__ void operator()(const f32x4 (&acc)[2][2][4][2], const Unit& u, int wr, int wc, int fr, int fq) const {
#pragma unroll
        for (int ai = 0; ai < 2; ++ai)
#pragma unroll
            for (int m = 0; m < 4; ++m)
#pragma unroll
                for (int bj = 0; bj < 2; ++bj) {
                    const int r = u.pm * BM + ai * HALF + wr * 64 + m * 16 + fr;
                    const int c = u.pn * BM + bj * HALF + wc * 32 + 8 * fq;
                    bf16_t* dst; float sc = 1.f;
                    if (!u.sw) {
                        if (u.pn < 8) { dst = Q + (size_t)r * D + c; sc = qscale; }
                        else { const int cc = c - D, h = cc >> 7, ch = (cc & 127) >> 3;
                            dst = KT + ((size_t)((r >> 3) * NH + h)) * 1024 + (ch >> 2) * 256 + ((r >> 2) & 1) * 128 + (r & 3) * 32 + (ch & 3) * 8; }
                    } else { const int h = r >> 7, d = r & 127;
                        dst = VT + ((size_t)(((c >> 3) * NH + h) * 8 + (d >> 4))) * 128 + (d & 15) * 8; }
                    const f32x4 v0 = acc[ai][bj][m][0] * sc, v1 = acc[ai][bj][m][1] * sc;
                    u32x4 w; w.x = cvt_pk_bf16(v0[0], v0[1]); w.y = cvt_pk_bf16(v0[2], v0[3]); w.z = cvt_pk_bf16(v1[0], v1[1]); w.w = cvt_pk_bf16(v1[2], v1[3]);
                    *(u32x4*)dst = w; }
    }
};
struct EpiGates {
    static constexpr bool PERM = true;
    const bf16_t* UC; unsigned* LB; const float* ba; const float* bx; const float* cA;
    __device__ __forceinline__ void operator()(const f32x4 (&acc)[2][2][4][2], const Unit& u, int wr, int wc, int fr, int fq) const {
        const int blk = u.pn >> 2, dir = (u.pn >> 1) & 1, half = u.pn & 1;
        const int row0 = u.pm * BM + wr * 64 + fr;
        unsigned* lb_d = LB + (size_t)dir * M * LW;
        const int ch0 = blk * 256 + half * 128 + wc * 32 + 8 * fq;
        unsigned pba[4], pbx[4], pca[4];
#pragma unroll
        for (int n = 0; n < 2; ++n) { const f32x4 t0 = *(const f32x4*)(ba + dir * LW + ch0 + 4 * n), t1 = *(const f32x4*)(bx + dir * LW + ch0 + 4 * n), t2 = *(const f32x4*)(cA + dir * LW + ch0 + 4 * n);
            pca[2 * n] = pk2(t2[0], t2[1]); pca[2 * n + 1] = pk2(t2[2], t2[3]);
            constexpr float NL = -1.4426950408889634f;
            pba[2 * n] = pk2(NL * t0[0], NL * t0[1]); pba[2 * n + 1] = pk2(NL * t0[2], NL * t0[3]); pbx[2 * n] = pk2(NL * t1[0], NL * t1[1]); pbx[2 * n + 1] = pk2(NL * t1[2], NL * t1[3]); }
        u32x4 ucw[2][2];
#define GATES_UCLOAD(buf, am_) do { _Pragma("unroll") for (int mm = 0; mm < 2; ++mm) ucw[buf][mm] = *(const u32x4*)(UC + (size_t)(row0 + ((am_) >> 1) * HALF + (((am_) & 1) * 2 + mm) * 16) * LW + ch0); } while (0)
        GATES_UCLOAD(0, 0);
#pragma unroll
        for (int am = 0; am < 4; ++am) { const int ai = am >> 1, m0 = (am & 1) * 2;
            if (am + 1 < 4) GATES_UCLOAD((am + 1) & 1, am + 1);
            __builtin_amdgcn_sched_barrier(0);
#pragma unroll
            for (int mm = 0; mm < 2; ++mm) { const int m = m0 + mm; const size_t ro = (size_t)(row0 + ai * HALF + m * 16) * LW + ch0;
                const unsigned uw[4] = {ucw[am & 1][mm].x, ucw[am & 1][mm].y, ucw[am & 1][mm].z, ucw[am & 1][mm].w};
                unsigned wv[8];
#pragma unroll
                for (int n = 0; n < 2; ++n) {
#pragma unroll
                    for (int j = 0; j < 4; ++j) { const int pi = 2 * n + (j >> 1);
                        const float ucv = (j & 1) ? bf_hi(uw[pi]) : bf_lo(uw[pi]), vb_a = (j & 1) ? bf_hi(pba[pi]) : bf_lo(pba[pi]), vb_x = (j & 1) ? bf_hi(pbx[pi]) : bf_lo(pbx[pi]);
                        const float rr = fast_rcp(1.f + fast_exp2(fmaf(acc[ai][0][m][n][j], -1.4426950408889634f, vb_a))), ig = fast_rcp(1.f + fast_exp2(fmaf(acc[ai][1][m][n][j], -1.4426950408889634f, vb_x)));
                        wv[4 * n + j] = cvt_pk_bf16(rr * ((j & 1) ? bf_hi(pca[pi]) : bf_lo(pca[pi])), ig * ucv); } }
                *(u32x4*)(lb_d + ro) = (u32x4){wv[0], wv[1], wv[2], wv[3]}; *(u32x4*)(lb_d + ro + 4) = (u32x4){wv[4], wv[5], wv[6], wv[7]}; }
            __builtin_amdgcn_sched_barrier(0);
        }
#undef GATES_UCLOAD
    }
};
}

#define XB_TMO      128
#define XB_XCNT(j)  (256  + 64 * (j))
#define XB_XSUB(j)  (1280 + 64 * (j))
#define XB_XGEN(j)  (2304 + 64 * (j))
#define XB_TOP      3328
#define XB_TOPGEN   3392
#define XCD_BAR_WORDS 3456
#define XB_SPIN_CAP (1u << 18)
__device__ __forceinline__ unsigned xb_ld(unsigned* p)              { return __hip_atomic_load(p, __ATOMIC_RELAXED, __HIP_MEMORY_SCOPE_AGENT); }
__device__ __forceinline__ unsigned xb_add(unsigned* p, unsigned v) { return __hip_atomic_fetch_add(p, v, __ATOMIC_RELAXED, __HIP_MEMORY_SCOPE_AGENT); }
__device__ __forceinline__ unsigned xb_xcc_id() { return (unsigned)__builtin_amdgcn_s_getreg((3 << 11) | 20) & 0xFu; }
#define XB_SPIN(cond, bar) do { unsigned _sp = 0; while (cond) { __builtin_amdgcn_s_sleep(1); \
    if ((++_sp & 255u) == 0u) { if (xb_ld(&(bar)[XB_TMO])) break; if (_sp > XB_SPIN_CAP) { atomicAdd(&(bar)[XB_TMO], 1u); break; } } } } while (0)
struct XcdBarrier { unsigned* bar; unsigned x; volatile LAS unsigned* st; };
__device__ __forceinline__ XcdBarrier xcd_barrier_post(unsigned* bar, volatile LAS unsigned* st) {
    XcdBarrier b; b.bar = bar; b.x = xb_xcc_id(); b.st = st;
    if (threadIdx.x == 0) (void)xb_add(&bar[XB_XCNT(b.x)], 1u);
    return b;
}
__device__ __forceinline__ void xcd_barrier_complete(unsigned* bar, unsigned x, unsigned& nloc, unsigned& nx) {
    const unsigned G = gridDim.x * gridDim.y * gridDim.z;
    unsigned sum, cnt, mine, sp = 0u;
    for (;;) {
        sum = 0u; cnt = 0u; mine = 0u;
#pragma unroll
        for (unsigned j = 0; j < 16; ++j) { const unsigned c = xb_ld(&bar[XB_XCNT(j)]); sum += c; cnt += (c > 0u) ? 1u : 0u; mine = (j == x) ? c : mine; }
        if (sum == G) break;
        __builtin_amdgcn_s_sleep(1);
        if ((++sp & 255u) == 0u) { if (xb_ld(&bar[XB_TMO])) break; if (sp > XB_SPIN_CAP) { atomicAdd(&bar[XB_TMO], 1u); break; } }
    }
    nloc = mine > 0u ? mine : 1u; nx = cnt > 0u ? cnt : 1u;
}
__device__ __forceinline__ void xcd_barrier(const XcdBarrier& b) {
    asm volatile("s_waitcnt vmcnt(0)" ::: "memory");
    __syncthreads();
    if (threadIdx.x == 0) {
        unsigned* bar = b.bar;
        __builtin_amdgcn_s_waitcnt(0);
        unsigned nloc = b.st[0], nx = b.st[1];
        if (nloc == 0u) { xcd_barrier_complete(bar, b.x, nloc, nx); b.st[0] = nloc; b.st[1] = nx; }
        const unsigned old = xb_add(&bar[XB_XSUB(b.x)], 1u);
        const unsigned gen = old / nloc;
        if (old + 1u == (gen + 1u) * nloc) {
            __builtin_amdgcn_fence(__ATOMIC_RELEASE, "agent");
            asm volatile("s_waitcnt vmcnt(0)" ::: "memory");
            const unsigned og = xb_add(&bar[XB_TOP], 1u);
            const unsigned tg = og / nx;
            if (og + 1u == (tg + 1u) * nx) xb_add(&bar[XB_TOPGEN], 1u);
            else XB_SPIN(xb_ld(&bar[XB_TOPGEN]) == tg, bar);
            __builtin_amdgcn_fence(__ATOMIC_ACQUIRE, "agent");
            xb_add(&bar[XB_XGEN(b.x)], 1u);
            asm volatile("s_waitcnt vmcnt(0)" ::: "memory");
        } else {
            XB_SPIN(xb_ld(&bar[XB_XGEN(b.x)]) == gen, bar);
            __builtin_amdgcn_fence(__ATOMIC_ACQUIRE, "agent");
            asm volatile("s_waitcnt vmcnt(0)" ::: "memory");
        }
    }
    __syncthreads();
}

constexpr size_t MiB = 1u << 20;
constexpr size_t WS_CTL = 0, CTL_ZERO_BYTES = 1 * MiB;
constexpr size_t WS_MODS = 1 * MiB;
constexpr size_t WS_WIN = 2 * MiB;
constexpr size_t WS_WG = 46 * MiB;
constexpr size_t WS_WOUT = 57 * MiB;
constexpr size_t WS_WQKV = 79 * MiB;
constexpr size_t WS_WO = 127 * MiB;
constexpr size_t WS_W1 = 143 * MiB;
constexpr size_t WS_W2 = 271 * MiB;
constexpr size_t WS_X = 399 * MiB;
constexpr size_t WS_XN = 471 * MiB;
constexpr size_t WS_BIG = 507 * MiB;
constexpr size_t WS_O = 651 * MiB;
constexpr size_t WS_CA = 687 * MiB;
constexpr size_t WS_UC = 688 * MiB;
constexpr size_t WS_LA = 738 * MiB;
constexpr size_t WS_BB = 838 * MiB;
constexpr size_t WS_Z = 938 * MiB;
constexpr size_t WS_AGGA = 988 * MiB, WS_AGGH = 995 * MiB, WS_CARRY = 1002 * MiB;
constexpr size_t WS_SLAB = 1009 * MiB;
constexpr size_t WS_FAST_END = 1073 * MiB;
constexpr size_t WS_NV = 688 * MiB;
static_assert((long long)WS_XN - (long long)WS_X == pg8::RN_DXN && (long long)WS_BB - (long long)WS_X == pg8::RN_DSLOT && (long long)WS_CTL + 131072 - (long long)WS_X == pg8::RN_DCNT && CTL_ZERO_BYTES >= 131072 + 32 * 256, "fused-norm exchange: slots (256 KiB at WS_BB, otherwise unused), panel counters in CTL");
constexpr int CW_BAR = 4096;
constexpr int CW_SPLIT = 16384;

constexpr int NWAVES = 8, NTHREADS = 512;
constexpr int LDS_BYTES = 147456;
constexpr int LDS_MISC = 131072;
constexpr int PH_PROLOGUE = 0, PH_NORM0 = 1, PH_LAYER0 = 2, PH_PER_LAYER = 12, PH_END = PH_LAYER0 + PH_PER_LAYER * DEPTH;

struct Args {
    const float* in[23]; float* out; unsigned char* ws; int ph_lo, ph_hi;
};

__device__ __forceinline__ float wave_sum(float v) {
#pragma unroll
    for (int o = 1; o < 64; o <<= 1) v += __shfl_xor(v, o);
    return v;
}
__device__ __forceinline__ void transpose_item(const float* W, int K, int N, bf16_t* WT, int k0, int n0, int dst_row0, int lane) {
    const int kb = lane & 7, nl = lane >> 3;
    const float* src = W + (size_t)(k0 + 8 * kb) * N + n0 + 4 * nl;
    f32x4 v[8];
#pragma unroll
    for (int i = 0; i < 8; ++i) v[i] = __builtin_nontemporal_load((const f32x4*)(src + (size_t)i * N));
    bf16_t* dst = WT + (size_t)(dst_row0 + 4 * nl) * K + k0 + 8 * kb;
#pragma unroll
    for (int j = 0; j < 4; ++j) { u32x4 o; o.x = pk2(v[0][j], v[1][j]); o.y = pk2(v[2][j], v[3][j]); o.z = pk2(v[4][j], v[5][j]); o.w = pk2(v[6][j], v[7][j]);
        *(u32x4*)(dst + (size_t)j * K) = o; }
}
__device__ __forceinline__ void transpose_group(int r, const float* src, int K, int N, bf16_t* dst, int lane) {
    const int nblk = N / 32, per = (K / 64) * nblk; const int mat = r / per, q = r % per, kb = q / nblk, nb = q % nblk;
    transpose_item(src + (size_t)mat * K * N, K, N, dst + (size_t)mat * N * K, 64 * kb, 32 * nb, 32 * nb, lane);
}


__device__ __forceinline__ unsigned char* tabp(volatile LAS unsigned* ptab, int i) {
    unsigned base = (unsigned)(size_t)ptab; asm volatile("" : "+v"(base));
    const u32x2 w = *(volatile LAS u32x2*)(base + 8u * (unsigned)i);
    return (unsigned char*)(GAS unsigned char*)(((unsigned long long)(unsigned)__builtin_amdgcn_readfirstlane((int)w.y) << 32) | (unsigned)__builtin_amdgcn_readfirstlane((int)w.x));
}
constexpr int C_W = (D / 64) * (FF / 32), C_IN = (D / 64) * (2 * LW / 32), C_OUT = (LW / 64) * (D / 32), C_QKV = (D / 64) * (3 * D / 32), C_O = (D / 64) * (D / 32), C_G = 2 * NLB * 2 * 32;
struct ConvAddr { const float* src; bf16_t* dst; int N, K; };
__device__ __forceinline__ ConvAddr conv_addr(volatile LAS unsigned* ptab, int kind, int l, int r, int lane) {
    unsigned char* ws = tabp(ptab, 24); const int kbl = lane & 7, nl = lane >> 3; ConvAddr a;
    if (kind == 6) { const int matl = r >> 5, q = r & 31, kb = q >> 3, nb = q & 7;
        const int gsel = matl & 1, db = matl >> 1, blk = db % NLB, d = db / NLB;
        const float* s0 = (const float*)tabp(ptab, gsel ? 16 : 14) + (size_t)((l * 2 + d) * NLB + blk) * LB * LB;
        const int n0 = 32 * nb, half = n0 >> 7, chn = n0 & 127, drow = blk * 1024 + ((d * 2 + half) * 2 + gsel) * 128 + chn;
        a.N = LB; a.K = LB; a.src = s0 + (size_t)(64 * kb + 8 * kbl) * LB + n0 + 4 * nl;
        a.dst = (bf16_t*)(ws + WS_WG) + (size_t)l * (NLB * 1024) * LB + (size_t)(drow + 4 * nl) * LB + 64 * kb + 8 * kbl;
        return a; }
    int K, N, inp; size_t wso;
    switch (kind) { case 0: K = D; N = FF; inp = 8; wso = WS_W1; break; case 1: K = FF; N = D; inp = 9; wso = WS_W2; break; case 2: K = D; N = 2 * LW; inp = 10; wso = WS_WIN; break;
                    case 3: K = LW; N = D; inp = 18; wso = WS_WOUT; break; case 4: K = D; N = 3 * D; inp = 19; wso = WS_WQKV; break; default: K = D; N = D; inp = 21; wso = WS_WO; break; }
    const int nblk = N / 32, kb = r / nblk, nb = r % nblk;
    a.N = N; a.K = K; a.src = (const float*)tabp(ptab, inp) + (size_t)l * K * N + (size_t)(64 * kb + 8 * kbl) * N + 32 * nb + 4 * nl;
    a.dst = (bf16_t*)(ws + wso) + (size_t)l * N * K + (size_t)(32 * nb + 4 * nl) * K + 64 * kb + 8 * kbl;
    return a;
}
__device__ __forceinline__ void conv_load(const ConvAddr& a, f32x4 (&v)[8]) {
#pragma unroll
    for (int i = 0; i < 8; ++i) v[i] = __builtin_nontemporal_load((const f32x4*)(a.src + (size_t)i * a.N));
}
__device__ __forceinline__ void conv_store(const ConvAddr& a, const f32x4 (&v)[8]) {
#pragma unroll
    for (int j = 0; j < 4; ++j) { u32x4 o; o.x = pk2(v[0][j], v[1][j]); o.y = pk2(v[2][j], v[3][j]); o.z = pk2(v[4][j], v[5][j]); o.w = pk2(v[6][j], v[7][j]);
        *(u32x4*)(a.dst + (size_t)j * a.K) = o; }
}
#define CSEG(kind, l, cnt) if (!fnd_ && r < (cnt)) { ck_ = (kind); cl_ = (l); fnd_ = true; } else if (!fnd_) r -= (cnt)
#define CONV_RUN(it0, st, nit, SEGS) do { for (int it_ = (it0); it_ < (nit); it_ += 2 * (st)) { ConvAddr ca_, cb_; f32x4 va_[8], vb_[8]; const bool two_ = it_ + (st) < (nit); \
        { int r = it_, ck_ = 0, cl_ = 0; bool fnd_ = false; SEGS; ca_ = conv_addr(ptab, ck_, cl_, r, lane); } conv_load(ca_, va_); \
        { int r = two_ ? it_ + (st) : it_, ck_ = 0, cl_ = 0; bool fnd_ = false; SEGS; cb_ = conv_addr(ptab, ck_, cl_, r, lane); } conv_load(cb_, vb_); \
        __builtin_amdgcn_sched_barrier(0); conv_store(ca_, va_); if (two_) conv_store(cb_, vb_); } } while (0)
__device__ __forceinline__ void ada_fill_ssil(volatile LAS unsigned* ptab, LAS unsigned char* lds, int tid) {
    const float* c = (const float*)tabp(ptab, 1); const float* c_ctx = (const float*)tabp(ptab, 3); LAS float* ssil = (LAS float*)lds;
    for (int i = tid; i < 5 * D; i += NTHREADS) { const int m = i / D, k = i % D; const float v = m < 4 ? c[m * D + k] : c_ctx[k]; ssil[i] = v / (1.f + expf(-v)); }
    __syncthreads();
}
constexpr int ADA_IT = 96;
__device__ __forceinline__ void ada_wg_item(volatile LAS unsigned* ptab, LAS unsigned char* lds, int it, int tid) {
    int lane = tid & 63; asm volatile("" : "+v"(lane)); const int wave = __builtin_amdgcn_readfirstlane(tid >> 6);
    const float* ada_w = (const float*)tabp(ptab, 4); const float* ada_b = (const float*)tabp(ptab, 5); float* mods = (float*)(tabp(ptab, 24) + WS_MODS);
    LAS float* ssil = (LAS float*)lds; LAS float* red = (LAS float*)(lds + 40960);
    const int layer = it / ADA_IT, col0 = (it % ADA_IT) * 128;
    const int kr = lane >> 5, c4 = lane & 31;
    const float* W = ada_w + ((size_t)layer * D + wave * 256 + 16 * kr) * MODW + col0 + 4 * c4;
    f32x4 a0 = {0.f, 0.f, 0.f, 0.f}, a1 = a0, a2 = a0, a3 = a0, a4 = a0;
    const LAS float* sp = ssil + wave * 256 + 16 * kr;
    for (int k = 0; k < 256; k += 32) {
        f32x4 wv[16];
#pragma unroll
        for (int kk = 0; kk < 16; ++kk) wv[kk] = __builtin_nontemporal_load((const f32x4*)(W + (size_t)(k + kk) * MODW));
#pragma unroll
        for (int hh = 0; hh < 4; ++hh) { const int k4 = k + 4 * hh;
            const f32x4 s0 = *(const LAS f32x4*)(sp + k4), s1 = *(const LAS f32x4*)(sp + D + k4), s2 = *(const LAS f32x4*)(sp + 2 * D + k4), s3 = *(const LAS f32x4*)(sp + 3 * D + k4), s4 = *(const LAS f32x4*)(sp + 4 * D + k4);
#pragma unroll
            for (int kk = 0; kk < 4; ++kk) { const f32x4 w4 = wv[4 * hh + kk]; a0 += w4 * s0[kk]; a1 += w4 * s1[kk]; a2 += w4 * s2[kk]; a3 += w4 * s3[kk]; a4 += w4 * s4[kk]; } }
    }
    { LAS f32x4* rw = (LAS f32x4*)(red + (wave * 2 + kr) * 5 * 128) + c4;
      rw[0] = a0; rw[32] = a1; rw[64] = a2; rw[96] = a3; rw[128] = a4; }
    __syncthreads();
    for (int i = tid; i < 5 * 128; i += NTHREADS) { const int m = i >> 7, l = i & 127; float s = 0.f;
#pragma unroll
        for (int w2 = 0; w2 < 16; ++w2) s += red[w2 * 5 * 128 + m * 128 + l];
        mods[((size_t)layer * 5 + m) * MODW + col0 + l] = s + ada_b[(size_t)layer * MODW + col0 + l]; }
    __syncthreads();
}

#define FILLER(U, ADA_FIRST, NIT, SEGS) do { int Gl = G; asm volatile("" : "+s"(Gl)); const int nfull = (U) % Gl; \
    if (nfull == 0 || bxp >= nfull) { const int rank = nfull ? bxp - nfull : bxp, nidle = nfull ? Gl - nfull : Gl, nada = ((ADA_FIRST) >= 0 && nidle > ADA_IT) ? ADA_IT : 0; \
        int tid = threadIdx.x; asm volatile("" : "+v"(tid)); const int lane = tid & 63, wave = __builtin_amdgcn_readfirstlane(tid >> 6); \
        if ((ADA_FIRST) >= 0 && nada == 0) { ada_fill_ssil(ptab, lds, tid); for (int it_ = rank; it_ < ADA_IT; it_ += nidle) ada_wg_item(ptab, lds, (ADA_FIRST) + it_, tid); }     \
        if (rank < nada) { ada_fill_ssil(ptab, lds, tid); ada_wg_item(ptab, lds, (ADA_FIRST) + rank, tid); } \
        else CONV_RUN((rank - nada) * NWAVES + wave, (nidle - nada) * NWAVES, NIT, SEGS); } } while (0)

#define FILLER2(K, ADA_FIRST, NIT, SEGS) do { int Gl = G; asm volatile("" : "+s"(Gl)); const int cc_ = __builtin_amdgcn_readfirstlane(*(volatile const LAS int*)(lds + pg8::CC_TAB_OFF + 4 * (K))); \
    if (cc_ >= Gl || bxp >= cc_) { const int rank = cc_ >= Gl ? bxp : bxp - cc_, nidle = cc_ >= Gl ? Gl : Gl - cc_; \
        int tid = threadIdx.x; asm volatile("" : "+v"(tid)); const int lane = tid & 63, wave = __builtin_amdgcn_readfirstlane(tid >> 6); \
        if ((ADA_FIRST) >= 0) { ada_fill_ssil(ptab, lds, tid); for (int it_ = rank; it_ < ADA_IT; it_ += nidle) ada_wg_item(ptab, lds, (ADA_FIRST) + it_, tid); } \
        CONV_RUN(rank * NWAVES + wave, nidle * NWAVES, NIT, SEGS); } } while (0)

__device__ __forceinline__ void norm_load(const float* xrow, f32x4 (&v)[8], int lane) {
    const f32x4* xr = (const f32x4*)xrow + lane;
#pragma unroll
    for (int j = 0; j < 8; ++j) v[j] = xr[64 * j];
}
__device__ __forceinline__ void norm_load(const bf16_t* xrow, f32x4 (&v)[8], int lane) {
    const u32x2* xr = (const u32x2*)xrow + lane; u32x2 r[8];
#pragma unroll
    for (int j = 0; j < 8; ++j) r[j] = xr[64 * j];
#pragma unroll
    for (int j = 0; j < 8; ++j) v[j] = (f32x4){bf_lo(r[j].x), bf_hi(r[j].x), bf_lo(r[j].y), bf_hi(r[j].y)};
}
template <int MODE>
__device__ __forceinline__ void norm_vecs(const float* g, const float* sh, const float* sc, f32x4 (&GG)[8], f32x4 (&SS)[8], int lane) {
#pragma unroll
    for (int j = 0; j < 8; ++j) { GG[j] = ((const f32x4*)g)[lane + 64 * j];
        if (MODE == 0) { GG[j] = GG[j] * (((const f32x4*)sc)[lane + 64 * j] + 1.f); SS[j] = ((const f32x4*)sh)[lane + 64 * j]; } }
}
template <int MODE>
__device__ __forceinline__ void norm_apply(f32x4 (&v)[8], bf16_t* xcopy, const f32x4 (&GG)[8], const f32x4 (&SS)[8], bf16_t* obf, float* of32, int lane, const float* slabrow = nullptr, const float* gate = nullptr) {
    float ss = 0.f;
    if (slabrow) {
#pragma unroll
        for (int jh = 0; jh < 2; ++jh) { u32x2 p[4][8];
#pragma unroll
            for (int jj = 0; jj < 4; ++jj) { const int j = jh * 4 + jj; const u32x2* sp = (const u32x2*)((const bf16_t*)slabrow + (size_t)j * 8 * 65536) + lane;
#pragma unroll
                for (int s = 0; s < 8; ++s) p[jj][s] = sp[(size_t)s * 16384]; }
            __builtin_amdgcn_sched_barrier(0);
#pragma unroll
            for (int jj = 0; jj < 4; ++jj) { const int j = jh * 4 + jj; const f32x4 gt = ((const f32x4*)gate)[lane + 64 * j];
                f32x4 a = {bf_lo(p[jj][0].x), bf_hi(p[jj][0].x), bf_lo(p[jj][0].y), bf_hi(p[jj][0].y)};
#pragma unroll
                for (int s = 1; s < 8; ++s) a += (f32x4){bf_lo(p[jj][s].x), bf_hi(p[jj][s].x), bf_lo(p[jj][s].y), bf_hi(p[jj][s].y)};
                v[j] += gt * a; }
            __builtin_amdgcn_sched_barrier(0); } }
#pragma unroll
    for (int j = 0; j < 8; ++j) ss += (v[j].x * v[j].x + v[j].y * v[j].y) + (v[j].z * v[j].z + v[j].w * v[j].w);
    const float rstd = rsqrtf(wave_sum(ss) * (1.f / D) + 1e-6f);
    if (xcopy) {
#pragma unroll
        for (int j = 0; j < 8; ++j) { u32x2 w; w.x = pk2(v[j].x, v[j].y); w.y = pk2(v[j].z, v[j].w); ((u32x2*)xcopy)[lane + 64 * j] = w; } }
#pragma unroll
    for (int j = 0; j < 8; ++j) { const int c4 = lane + 64 * j;
        f32x4 h = v[j] * rstd * GG[j];
        if (MODE == 0) { h = h + SS[j]; u32x2 w; w.x = pk2(h.x, h.y); w.y = pk2(h.z, h.w); ((u32x2*)obf)[c4] = w; }
        else ((f32x4*)of32)[c4] = h; }
}
#define NORM_LATENT(VECS, ROWSRC, APPLY) do { const int rpw_ = (ML + NGW - 1) / NGW; const int r0_ = gw * rpw_, r1_ = (r0_ + rpw_ < ML) ? r0_ + rpw_ : ML; \
    if (r0_ < r1_) { f32x4 GG[8], SS[8], vA[8], vB[8]; int mc_ = r0_ / SEQ; VECS(mc_); norm_load(ROWSRC(r0_), vA, lane); \
        for (int r_ = r0_; r_ < r1_; r_ += 2) { \
            { const int rn_ = (r_ + 1 < r1_) ? r_ + 1 : r_; norm_load(ROWSRC(rn_), vB, lane); } \
            if (r_ / SEQ != mc_) { mc_ = r_ / SEQ; VECS(mc_); } \
            APPLY(vA, r_); \
            if (r_ + 1 < r1_) { { const int rn_ = (r_ + 2 < r1_) ? r_ + 2 : r_ + 1; norm_load(ROWSRC(rn_), vA, lane); } \
                if ((r_ + 1) / SEQ != mc_) { mc_ = (r_ + 1) / SEQ; VECS(mc_); } \
                APPLY(vB, r_ + 1); } } } } while (0)

template <bool LOCAL>
__device__ __forceinline__ void attn_unit(const bf16_t* Q, const bf16_t* KT, const bf16_t* VT, bf16_t* O, LAS unsigned char* lds, int b, int h, int r, int w, int tq, int lane) {
    const int g = lane >> 4, q = lane & 15;
    const int qrow = LOCAL ? (b * SEQ + r * GRID_W + 16 * w + q) : (ML + b * CTX + 16 * tq + q);
    bf16x8 bq[4];
    { const bf16_t* qp = Q + (size_t)qrow * D + h * HD + 8 * g;
#pragma unroll
      for (int ks = 0; ks < 4; ++ks) bq[ks] = *(const bf16x8*)(qp + 32 * ks); }
    constexpr int NP = LOCAL ? 16 : 8, CP = LOCAL ? 8 : 0;
    f32x4 s[2 * NP];
    int rs = 0, ws = 0;
    if (LOCAL) { rs = r - 4; rs = rs < 0 ? 0 : (rs > 24 ? 24 : rs); ws = 16 * w - 8; ws = ws < 0 ? 0 : (ws > 32 ? 32 : ws); }
    const int rgl = b * SEQ + rs * GRID_W + ws;
    if (LOCAL) {
        const bf16_t* kloc = KT + ((size_t)(((rgl >> 3) + (q >> 2)) * NH + h)) * 1024 + (q & 3) * 32 + g * 8;
        bf16x8 ka[2][8];
#define ATT_KLOAD(buf, p) do { const bf16_t* kp_ = kloc + (size_t)((p) * 8 * NH) * 1024; \
        _Pragma("unroll") for (int f = 0; f < 2; ++f) _Pragma("unroll") for (int ks = 0; ks < 4; ++ks) ka[buf][f * 4 + ks] = *(const bf16x8*)(kp_ + f * 128 + ks * 256); } while (0)
        ATT_KLOAD(0, 0);
#pragma unroll
        for (int p = 0; p < 8; ++p) {
            __builtin_amdgcn_s_barrier();
            if (p + 1 < 8) ATT_KLOAD((p + 1) & 1, p + 1);
            __builtin_amdgcn_sched_barrier(0);
#pragma unroll
            for (int f = 0; f < 2; ++f) { f32x4 a = {0.f, 0.f, 0.f, 0.f};
#pragma unroll
                for (int ks = 0; ks < 4; ++ks) a = __builtin_amdgcn_mfma_f32_16x16x32_bf16(ka[p & 1][f * 4 + ks], bq[ks], a, 0, 0, 0);
                s[2 * p + f] = a; }
            __builtin_amdgcn_sched_barrier(0);
        }
#undef ATT_KLOAD
    }
    {
        const LAS unsigned char* kl = lds + (q >> 2) * 2048 + (((q & 3) * 4 + g) ^ ((q >> 2) & 2)) * 16;
#pragma unroll
        for (int p = 0; p < 8; ++p)
#pragma unroll
            for (int f = 0; f < 2; ++f) { f32x4 a = {0.f, 0.f, 0.f, 0.f};
#pragma unroll
                for (int ks = 0; ks < 4; ++ks) a = __builtin_amdgcn_mfma_f32_16x16x32_bf16(*(const LAS bf16x8*)(kl + p * 8192 + ks * 512 + f * 256), bq[ks], a, 0, 0, 0);
                s[2 * (CP + p) + f] = a; }
    }
    if (LOCAL) {
        const int c = 16 * w + q; int cs = c - 8; cs = cs < 0 ? 0 : (cs > 48 ? 48 : cs);
        const LAS float* rp = (const LAS float*)(lds + LDS_MISC + 1024);
#pragma unroll
        for (int p = 0; p < 8; ++p) { const int ro = (rs + p - r + 7) * 31;
#pragma unroll
            for (int f = 0; f < 2; ++f)
#pragma unroll
                for (int j = 0; j < 4; ++j) { const int kc = ws + 8 * g + 4 * f + j; const bool valid = (kc >= cs) && (kc < cs + 16);
                    int rel = kc - c + 15; rel = rel < 0 ? 0 : (rel > 30 ? 30 : rel);
                    const float bias = rp[ro + rel];
                    s[p * 2 + f][j] = valid ? s[p * 2 + f][j] + bias : -INFINITY; } }
    }
    float mx = -INFINITY;
#pragma unroll
    for (int i = 0; i < 2 * NP; ++i) mx = fmaxf(mx, fmaxf(fmaxf(s[i][0], s[i][1]), fmaxf(s[i][2], s[i][3])));
    mx = fmaxf(mx, __shfl_xor(mx, 16)); mx = fmaxf(mx, __shfl_xor(mx, 32));
    float sum = 0.f; const float mxl = mx * 1.4426950408889634f;
    bf16x8 pb[NP];
#pragma unroll
    for (int p = 0; p < NP; ++p) { float e[8];
#pragma unroll
        for (int f = 0; f < 2; ++f)
#pragma unroll
            for (int j = 0; j < 4; ++j) { e[4 * f + j] = fast_exp2(fmaf(s[2 * p + f][j], 1.4426950408889634f, -mxl)); sum += e[4 * f + j]; }
        u32x4 pw; pw.x = cvt_pk_bf16(e[0], e[1]); pw.y = cvt_pk_bf16(e[2], e[3]); pw.z = cvt_pk_bf16(e[4], e[5]); pw.w = cvt_pk_bf16(e[6], e[7]);
        pb[p] = __builtin_bit_cast(bf16x8, pw); }
    sum += __shfl_xor(sum, 16); sum += __shfl_xor(sum, 32);
    f32x4 o[8];
#pragma unroll
    for (int df = 0; df < 8; ++df) o[df] = (f32x4){0.f, 0.f, 0.f, 0.f};
    if (LOCAL) {
        const bf16_t* vloc = VT + ((size_t)(((rgl >> 3) + g) * NH + h)) * 1024 + q * 8;
        bf16x8 va[2][8];
#define ATT_VLOAD(buf, p) do { const bf16_t* vp_ = vloc + (size_t)((p) * 8 * NH) * 1024; \
        _Pragma("unroll") for (int df = 0; df < 8; ++df) va[buf][df] = *(const bf16x8*)(vp_ + df * 128); } while (0)
        ATT_VLOAD(0, 0);
#pragma unroll
        for (int p = 0; p < 8; ++p) {
            __builtin_amdgcn_s_barrier();
            if (p + 1 < 8) ATT_VLOAD((p + 1) & 1, p + 1);
            __builtin_amdgcn_sched_barrier(0);
#pragma unroll
            for (int df = 0; df < 8; ++df) o[df] = __builtin_amdgcn_mfma_f32_16x16x32_bf16(va[p & 1][df], pb[p], o[df], 0, 0, 0);
            __builtin_amdgcn_sched_barrier(0);
        }
#undef ATT_VLOAD
    }
    {
        const LAS unsigned char* vl = lds + 65536 + g * 2048 + q * 16;
#pragma unroll
        for (int p = 0; p < 8; ++p)
#pragma unroll
            for (int df = 0; df < 8; ++df) o[df] = __builtin_amdgcn_mfma_f32_16x16x32_bf16(*(const LAS bf16x8*)(vl + p * 8192 + df * 256), pb[CP + p], o[df], 0, 0, 0);
    }
    const float inv = 1.f / sum;
    bf16_t* op = O + (size_t)qrow * D + h * HD + 4 * g;
#pragma unroll
    for (int df = 0; df < 8; ++df) { u32x2 wv; wv.x = cvt_pk_bf16(o[df][0] * inv, o[df][1] * inv); wv.y = cvt_pk_bf16(o[df][2] * inv, o[df][3] * inv); *(u32x2*)(op + 16 * df) = wv; }
}

#define LRU_STEP(h, l, x) do { const float a_ = fast_exp2(l); h = fmaf(a_, h, __builtin_amdgcn_sqrtf(fmaxf(fmaf(-a_, a_, 1.f), 0.f)) * (x)); } while (0)
__global__ void __launch_bounds__(NTHREADS, 2) mega(Args args) {
    extern __shared__ __attribute__((aligned(16))) unsigned char lds_raw[];
    LAS unsigned char* lds = (LAS unsigned char*)lds_raw;
    const int G = gridDim.x; const int bx = blockIdx.x; const int vcu = ((G & 7) == 0) ? (bx & 7) * (G >> 3) + (bx >> 3) : bx;
    const int NGW = G * NWAVES;
    const int lo = args.ph_lo, hi = args.ph_hi;
    volatile LAS unsigned* ptab = (volatile LAS unsigned*)(lds + LDS_MISC + 64);
    { const int tid = threadIdx.x;
    for (int u = tid; u < (LDS_BYTES - LDS_MISC) / 4; u += NTHREADS) ((LAS unsigned*)(lds + LDS_MISC))[u] = 0u;
    __syncthreads();
    if (tid < 25) { const unsigned long long pv = tid < 23 ? (unsigned long long)args.in[tid] : (tid == 23 ? (unsigned long long)args.out : (unsigned long long)args.ws);
        ptab[2 * tid] = (unsigned)pv; ptab[2 * tid + 1] = (unsigned)(pv >> 32); }
    if (tid == 32) { volatile LAS int* cct = (volatile LAS int*)(lds + pg8::CC_TAB_OFF); static_assert(pg8::CC_TAB_OFF == LDS_MISC + 512, "cc table");
        cct[1] = pg8::gemm_cc(36 * (2 * LW / 256), G); cct[2] = pg8::gemm_cc(36 * (2 * D / 256) + (D / 256) * 36, G); cct[3] = pg8::gemm_cc(36 * NLB * 4, G); cct[4] = pg8::gemm_cc(36 * (FF / 256), G); }
    __syncthreads(); }
    unsigned char* const ws0 = args.ws;
    XcdBarrier bar; bar.bar = (unsigned*)(ws0 + WS_CTL) + CW_BAR; bar.x = 0; bar.st = nullptr;
    const bool multi = (hi - lo) > 1;
    if (multi) bar = xcd_barrier_post((unsigned*)(ws0 + WS_CTL) + CW_BAR, (volatile LAS unsigned*)(lds + LDS_MISC + 32));
    bool need_bar = false;
#define IN(k) (lo <= (k) && (k) < hi)
#define TABP(i) tabp(ptab, (i))
#define INP(i) ((const float*)TABP(i))
#define WSF(off) ((float*)(wsl + (off)))
#define WSB(off) ((bf16_t*)(wsl + (off)))
#define PHASE_BEGIN() if (need_bar) xcd_barrier(bar); need_bar = true; int tid = threadIdx.x; asm volatile("" : "+v"(tid)); const int lane = tid & 63, wave = __builtin_amdgcn_readfirstlane(tid >> 6), gw = vcu * NWAVES + wave; (void)lane; (void)gw; unsigned char* const wsl = TABP(24); (void)wsl; int bxp = bx; asm volatile("" : "+s"(bxp)); (void)bxp

    if (IN(PH_PROLOGUE)) {
        PHASE_BEGIN();
        for (int rep = 0; rep < REP_PRO; ++rep) {
        __syncthreads();
        ada_fill_ssil(ptab, lds, tid);
        constexpr int ADA0 = ADA_IT;
        { const float* lam = INP(13); float* CAw = WSF(WS_CA);
          for (int i = gw * 64 + lane; i < 2 * 2 * LW; i += NGW * 64) CAw[i] = -8.f * log1pf(expf(-lam[i])) * 1.4426950408889634f; }
        constexpr int NITEMS = C_IN;
#define SEGS_P CSEG(2, 0, C_IN)
        if (G > 2 * ADA0) { if (vcu < ADA0) ada_wg_item(ptab, lds, vcu, tid); else CONV_RUN((vcu - ADA0) * NWAVES + wave, (G - ADA0) * NWAVES, NITEMS, SEGS_P); }
        else { for (int it_ = vcu; it_ < ADA0; it_ += G) ada_wg_item(ptab, lds, it_, tid); CONV_RUN(vcu * NWAVES + wave, G * NWAVES, NITEMS, SEGS_P); }
#undef SEGS_P
        }
    }
    if (IN(PH_NORM0)) {
        PHASE_BEGIN();
        const float* x = INP(0); const float* ctx = INP(2); const float* norm1_g = INP(6); const float* mods = WSF(WS_MODS); bf16_t* X = WSB(WS_X); bf16_t* XN = WSB(WS_XN);
#define VECS0(m) norm_vecs<0>(norm1_g, mods + (size_t)(m) * MODW, mods + (size_t)(m) * MODW + D, GG, SS, lane)
#define SRC0(r) (x + (size_t)(r) * D)
#define APP0(v, r) norm_apply<0>(v, nullptr, GG, SS, XN + (size_t)(r) * D, nullptr, lane)
        for (int rep = 0; rep < REP_NORM; ++rep) {
            NORM_LATENT(VECS0, SRC0, APP0);
            { f32x4 GG[8], SS[8]; VECS0(4);
              for (int row = ML + gw; row < M; row += NGW) { f32x4 v[8]; norm_load(ctx + (size_t)(row - ML) * D, v, lane); norm_apply<0>(v, X + (size_t)row * D, GG, SS, XN + (size_t)row * D, nullptr, lane); } } }
#undef VECS0
#undef SRC0
#undef APP0
    }
    for (int L = 0; L < DEPTH; ++L) {
        const int base = PH_LAYER0 + PH_PER_LAYER * L; const bool lru = !(L & 1); const int j = L >> 1; const bool lastL = (L == DEPTH - 1);
        const int nMrows = lastL ? 32 : 36;
        if (IN(base + 0)) {
            if (threadIdx.x == 0 && lru) { const int U_ = 36 * (2 * LW / 256), R_ = (U_ + G - 1) / G + (L == 0 ? 1 : 0); int c_ = ((U_ + R_ - 1) / R_ + 7) & ~7; if ((G & 7) || c_ > G) c_ = G;
                ((volatile LAS int*)(lds + pg8::CC_TAB_OFF))[1] = c_; }
            PHASE_BEGIN();
            if (lru) {
                pg8::Gemm g{WSB(WS_XN), WSB(WS_WIN) + (size_t)j * (2 * LW) * D, D, D, D, -1, nullptr, nullptr, 0}; pg8::StaticOrder S; S.init(36, 2 * LW / 256, G, bxp);
                pg8::EpiAct<0> E{WSB(WS_BIG), 2 * LW};
                pg8::gemm_phase<pg8::EpiAct<0>, true, true, 1>(lds, g, S, E);
#define SEGS_A CSEG(6, 0, C_G); CSEG(3, 0, C_OUT); CSEG(0, 0, C_W); CSEG(1, 0, C_W); CSEG(4, 0, C_QKV); CSEG(5, 0, C_O); CSEG(0, 1, C_W); CSEG(1, 1, C_W)
#define SEGS_E CSEG(1, 2, C_W); CSEG(4, 1, C_QKV); CSEG(5, 1, C_O)
                if (L == 0) FILLER2(1, ADA_IT, C_G + C_OUT + 4 * C_W + C_QKV + C_O, SEGS_A);
                if (L == 2) FILLER2(1, -1, C_W + C_QKV + C_O, SEGS_E);
#undef SEGS_A
#undef SEGS_E
            } else {
                const bf16_t* wq = WSB(WS_WQKV) + (size_t)j * (3 * D) * D; const bf16_t* XN = WSB(WS_XN);
                pg8::Gemm g{XN, wq, D, D, D, -1, wq + (size_t)(2 * D) * D, XN, 0}; pg8::StaticOrder S; S.init(36, 2 * D / 256, G, bxp, D / 256, 36);
                pg8::EpiQKV E{WSB(WS_BIG), WSB(WS_BIG + 36 * MiB), WSB(WS_BIG + 72 * MiB), 0.08838834764831845f};
                pg8::gemm_phase<pg8::EpiQKV, true, true, 2>(lds, g, S, E);
#define SEGS_C CSEG(3, 1, C_OUT); CSEG(6, 1, C_G)
#define SEGS_F CSEG(1, 3, C_W)
                if (L == 1) FILLER2(2, 3 * ADA_IT, C_OUT + C_G, SEGS_C);
                if (L == 3) FILLER2(2, -1, C_W, SEGS_F);
#undef SEGS_C
#undef SEGS_F
            }
        }
        if (IN(base + 1)) {
            PHASE_BEGIN();
            if (lru) {
                const float* cw = INP(11) + (size_t)j * 4 * LW; const float* cb = INP(12) + (size_t)j * LW; const bf16_t* GU = WSB(WS_BIG); bf16_t* UC = WSB(WS_UC);
                for (int rep = 0; rep < REP_CONV; ++rep)
                for (int it = gw; it < 288 * NLB; it += NGW) {
                    const int strip = it / NLB, cg = it % NLB, ch = cg * 256 + 4 * lane;
                    int seg0, seglen, t0; if (strip < 256) { seg0 = (strip >> 6) * SEQ; seglen = SEQ; t0 = (strip & 63) * 32; } else { const int s2 = strip - 256; seg0 = ML + (s2 >> 3) * CTX; seglen = CTX; t0 = (s2 & 7) * 32; }
                    const f32x4 w0 = *(const f32x4*)(cw + ch), w1 = *(const f32x4*)(cw + LW + ch), w2 = *(const f32x4*)(cw + 2 * LW + ch), w3 = *(const f32x4*)(cw + 3 * LW + ch), bv = *(const f32x4*)(cb + ch);
                    u32x2 uw[35];
#pragma unroll
                    for (int i = 0; i < 35; ++i) { const int t = t0 - 2 + i; const int tc = t < 0 ? 0 : (t >= seglen ? seglen - 1 : t); uw[i] = *(const u32x2*)(GU + (size_t)(seg0 + tc) * (2 * LW) + LW + ch); }
                    __builtin_amdgcn_sched_barrier(0);
                    auto cvu = [&](int i) -> f32x4 { const int t = t0 - 2 + i; const float z = (t < 0 || t >= seglen) ? 0.f : 1.f; return (f32x4){bf_lo(uw[i].x) * z, bf_hi(uw[i].x) * z, bf_lo(uw[i].y) * z, bf_hi(uw[i].y) * z}; };
                    f32x4 um2 = cvu(0), um1 = cvu(1), u0 = cvu(2);
#pragma unroll
                    for (int t = 0; t < 32; ++t) { const f32x4 up1 = cvu(t + 3);
                        const f32x4 y = w0 * um2 + w1 * um1 + w2 * u0 + w3 * up1 + bv;
                        u32x2 wv; wv.x = pk2(y.x, y.y); wv.y = pk2(y.z, y.w); *(u32x2*)(UC + (size_t)(seg0 + t0 + t) * LW + ch) = wv;
                        um2 = um1; um1 = u0; u0 = up1; }
                }
            } else {
                const bf16_t* Qb = WSB(WS_BIG); const bf16_t* KTp = WSB(WS_BIG + 36 * MiB); const bf16_t* VTp = WSB(WS_BIG + 72 * MiB); bf16_t* Ob = WSB(WS_O);
                const float* rpg = INP(20) + (size_t)j * NH * 465;
                for (int rep = 0; rep < REP_ATTN; ++rep)
                for (int it = vcu; it < BATCH * NH * 4; it += G) { const int qr = it & 3, h = (it >> 2) & 15, b = it >> 6;
                    __syncthreads();
                    { const int oc0 = (ML + b * CTX) >> 3;
                      for (int ci = tid; ci < 4096; ci += NTHREADS) { const int o = ci >> 7, wq = ci & 127;
                          const u32x4 kv = *(const u32x4*)(KTp + ((size_t)((oc0 + o) * NH + h)) * 1024 + wq * 8);
                          *(LAS u32x4*)(lds + o * 2048 + (wq & ~15) * 16 + ((wq & 15) ^ (o & 2)) * 16) = kv;
                          const u32x4 vv = *(const u32x4*)(VTp + ((size_t)((oc0 + o) * NH + h)) * 1024 + wq * 8);
                          *(LAS u32x4*)(lds + 65536 + o * 2048 + wq * 16) = vv; }
                      LAS float* rp = (LAS float*)(lds + LDS_MISC + 1024);
                      for (int i = tid; i < 465; i += NTHREADS) rp[i] = rpg[h * 465 + i]; }
                    __syncthreads();
#pragma unroll 1
                    for (int rd = 0; rd < 4; ++rd) attn_unit<true>(Qb, KTp, VTp, Ob, lds, b, h, 8 * qr + 2 * rd + (wave >> 2), wave & 3, 0, lane);
                    if (!lastL && wave < 4) attn_unit<false>(Qb, KTp, VTp, Ob, lds, b, h, 0, 0, 4 * qr + wave, lane);
                }
                __syncthreads();
            }
        }
        if (lru) {
            if (IN(base + 2)) {
                PHASE_BEGIN();
                const bf16_t* UC = WSB(WS_UC);
                pg8::Gemm g{UC, WSB(WS_WG) + (size_t)j * (NLB * 1024) * LB, LW, LB, LB, 2, nullptr, nullptr, 0}; pg8::StaticOrder S; S.init(36, NLB * 4, G, bxp);
                pg8::EpiGates E{UC, (unsigned*)(wsl + WS_LA), INP(15) + (size_t)j * 2 * LW, INP(17) + (size_t)j * 2 * LW, WSF(WS_CA) + (size_t)j * 2 * LW};
                for (int rep = 0; rep < REP_GATES; ++rep) pg8::gemm_phase<pg8::EpiGates, false, true>(lds, g, S, E);
#define SEGS_H0 CSEG(5, 0, C_O)
#define SEGS_H1 CSEG(5, 1, C_O)
#undef SEGS_H0
#undef SEGS_H1
            }
            if (IN(base + 3)) {
                PHASE_BEGIN();
                const unsigned* LB = (const unsigned*)(wsl + WS_LA); float* AGGA = WSF(WS_AGGA); float* AGGH = WSF(WS_AGGH);
                for (int rep = 0; rep < REP_S1; ++rep)
                for (int it = gw; it < 2 * BATCH * 72 * 22; it += NGW) {
                    const int cg = it % 22, r1 = it / 22, q = r1 % 72, r2 = r1 / 72, b = r2 & 3, dir = r2 >> 2;
                    const int ch = cg * 128 + 2 * lane;
                    const int rbase = q < 8 ? ML + b * CTX + 32 * q : b * SEQ + 32 * (q - 8);
                    const unsigned* lp = LB + ((size_t)dir * M + rbase) * LW + ch;
                    float sl0 = 0.f, sl1 = 0.f, h0 = 0.f, h1 = 0.f;
                    u32x2 lb[32];
#pragma unroll
                    for (int t = 0; t < 32; ++t) lb[t] = *(const u32x2*)(lp + (size_t)t * LW);
                    __builtin_amdgcn_sched_barrier(0);
                    if (dir == 0) {
#pragma unroll
                        for (int t = 0; t < 32; ++t) { const float l0 = bf_lo(lb[t].x), l1 = bf_lo(lb[t].y); LRU_STEP(h0, l0, bf_hi(lb[t].x)); LRU_STEP(h1, l1, bf_hi(lb[t].y)); sl0 += l0; sl1 += l1; }
                    } else {
#pragma unroll
                        for (int t = 31; t >= 0; --t) { const float l0 = bf_lo(lb[t].x), l1 = bf_lo(lb[t].y); LRU_STEP(h0, l0, bf_hi(lb[t].x)); LRU_STEP(h1, l1, bf_hi(lb[t].y)); sl0 += l0; sl1 += l1; }
                    }
                    const size_t o = ((size_t)(dir * BATCH + b) * 72 + q) * LW + ch;
                    *(f32x2*)(AGGA + o) = (f32x2){fast_exp2(sl0), fast_exp2(sl1)}; *(f32x2*)(AGGH + o) = (f32x2){h0, h1};
                }
            }
            if (IN(base + 4)) {
                PHASE_BEGIN();
                const float* AGGA = WSF(WS_AGGA); const float* AGGH = WSF(WS_AGGH); float* CARRY = WSF(WS_CARRY);
                for (int rep = 0; rep < REP_S2; ++rep)
                for (int i = (wave * G + vcu) * 64 + lane; i < 2 * BATCH * LW; i += NGW * 64) {
                    const int ch = i % LW, db = i / LW, dir = db >> 2;
                    const size_t o = (size_t)db * 72 * LW + ch; float h = 0.f;
                    for (int bt = 0; bt < 2; ++bt) { float av[36], hv[36];
#pragma unroll
                        for (int k = 0; k < 36; ++k) { const int st = bt * 36 + k, q = dir ? (st < 8 ? 7 - st : 79 - st) : st; av[k] = AGGA[o + (size_t)q * LW]; hv[k] = AGGH[o + (size_t)q * LW]; }
#pragma unroll
                        for (int k = 0; k < 36; ++k) { const int st = bt * 36 + k, q = dir ? (st < 8 ? 7 - st : 79 - st) : st; CARRY[o + (size_t)q * LW] = h; h = av[k] * h + hv[k]; } }
                }
            }
            if (IN(base + 5)) {
                PHASE_BEGIN();
                const unsigned* LB = (const unsigned*)(wsl + WS_LA); const float* CARRY = WSF(WS_CARRY); const bf16_t* GU = WSB(WS_BIG); bf16_t* Zb = WSB(WS_Z);
                for (int rep = 0; rep < REP_S3; ++rep)
                for (int it = gw; it < BATCH * 72 * 22; it += NGW) {
                    const int cg = it % 22, r1 = it / 22, q = r1 % 72, b = r1 / 72;
                    const int ch = cg * 128 + 2 * lane;
                    const int rbase = q < 8 ? ML + b * CTX + 32 * q : b * SEQ + 32 * (q - 8);
                    const size_t ro = (size_t)rbase * LW + ch;
                    const size_t c0 = ((size_t)(0 * BATCH + b) * 72 + q) * LW + ch, c1 = ((size_t)(1 * BATCH + b) * 72 + q) * LW + ch;
                    float hf0[32], hf1[32];
                    { u32x2 lb[32]; const f32x2 hc = *(const f32x2*)(CARRY + c0);
#pragma unroll
                      for (int t = 0; t < 32; ++t) lb[t] = *(const u32x2*)(LB + ro + (size_t)t * LW);
                      __builtin_amdgcn_sched_barrier(0);
                      float h0 = hc.x, h1 = hc.y;
#pragma unroll
                      for (int t = 0; t < 32; ++t) { LRU_STEP(h0, bf_lo(lb[t].x), bf_hi(lb[t].x)); LRU_STEP(h1, bf_lo(lb[t].y), bf_hi(lb[t].y)); hf0[t] = h0; hf1[t] = h1; } }
                    { u32x2 lb[32]; unsigned gwv[32]; const f32x2 hc = *(const f32x2*)(CARRY + c1);
                      const unsigned* l1p = LB + (size_t)M * LW + ro;
#pragma unroll
                      for (int t = 0; t < 32; ++t) { lb[t] = *(const u32x2*)(l1p + (size_t)t * LW); gwv[t] = *(const unsigned*)(GU + (size_t)(rbase + t) * (2 * LW) + ch); }
                      __builtin_amdgcn_sched_barrier(0);
                      float h0 = hc.x, h1 = hc.y;
#pragma unroll
                      for (int t = 31; t >= 0; --t) { LRU_STEP(h0, bf_lo(lb[t].x), bf_hi(lb[t].x)); LRU_STEP(h1, bf_lo(lb[t].y), bf_hi(lb[t].y));
                          const float g0 = bf_lo(gwv[t]), g1 = bf_hi(gwv[t]);
                          const float z0 = g0 * fast_sigmoid(1.5957691216057308f * (g0 + 0.044715f * g0 * g0 * g0)) * (hf0[t] + h0);
                          const float z1 = g1 * fast_sigmoid(1.5957691216057308f * (g1 + 0.044715f * g1 * g1 * g1)) * (hf1[t] + h1);
                          *(unsigned*)(Zb + ro + (size_t)t * LW) = pk2(z0, z1); } }
                }
            }
        }
        if (IN(base + 6)) {
            PHASE_BEGIN();
            const bf16_t* Ao = lru ? WSB(WS_Z) : WSB(WS_O); const bf16_t* Bo = lru ? WSB(WS_WOUT) + (size_t)j * D * LW : WSB(WS_WO) + (size_t)j * D * D; const int Ko = lru ? LW : D;
            pg8::Gemm g{Ao, Bo, Ko, Ko, Ko, -1, Ao, Bo, 1};
            pg8::StaticOrder S; if (lastL) S.init(32, D / 256, G, bxp); else if (G == 256) S.init(32, D / 256, -G, bxp + 256, 4, D / 256, 1);
            else S.init(32, D / 256, G, bxp, 4, D / 256, 1);
            if (L == 0) { pg8::EpiResidT<true, 1> E{WSB(WS_X), WSF(WS_MODS) + (size_t)L * 5 * MODW, 2, WSF(WS_SLAB), INP(0), INP(7) + (size_t)L * D, 3 * D, 64u * (2 * L + 1), lds};
                pg8::gemm_phase<pg8::EpiResidT<true, 1>, true, true>(lds, g, S, E); }
            else { pg8::EpiResidT<false, 1> E{WSB(WS_X), WSF(WS_MODS) + (size_t)L * 5 * MODW, 2, WSF(WS_SLAB), nullptr, INP(7) + (size_t)L * D, 3 * D, 64u * (2 * L + 1), lds};
                pg8::gemm_phase<pg8::EpiResidT<false, 1>, true, true>(lds, g, S, E); }
        }
        if (IN(base + 7) && !lastL) {
            PHASE_BEGIN();
            const float* ml = WSF(WS_MODS) + (size_t)L * 5 * MODW; bf16_t* X = WSB(WS_X); bf16_t* XN = WSB(WS_XN); const float* g2 = INP(7) + (size_t)L * D;
            const float* slab = WSF(WS_SLAB);
#define VECS7(m) norm_vecs<0>(g2, ml + (size_t)(m) * MODW + 3 * D, ml + (size_t)(m) * MODW + 4 * D, GG, SS, lane)
#define SRC7(r) (X + (size_t)(r) * D)
#define APP7(v, r) norm_apply<0>(v, nullptr, GG, SS, XN + (size_t)(r) * D, nullptr, lane)
            if (!lastL) { f32x4 GG[8], SS[8]; VECS7(4); const float* mm = ml + (size_t)4 * MODW;
                for (int row = ML + gw; row < M; row += NGW) { f32x4 v[8]; norm_load(X + (size_t)row * D, v, lane);
                    norm_apply<0>(v, X + (size_t)row * D, GG, SS, XN + (size_t)row * D, nullptr, lane,
                                  (const float*)((const bf16_t*)slab + (size_t)((row - ML) >> 8) * 64 * 65536 + (size_t)(row & 255) * 256), mm + 2 * D); } }
#undef VECS7
#undef SRC7
#undef APP7
        }
        if (IN(base + 8)) {
            if (threadIdx.x == 0) ((volatile LAS int*)(lds + pg8::CC_TAB_OFF))[4] = lastL ? G : pg8::gemm_cc(36 * (FF / 256), G);
            PHASE_BEGIN();
            pg8::Gemm g{WSB(WS_XN), WSB(WS_W1) + (size_t)L * FF * D, D, D, D, -1, nullptr, nullptr, 0}; pg8::StaticOrder S; S.init(nMrows, FF / 256, G, bxp);
            pg8::EpiAct<1> E{WSB(WS_BIG), FF};
            pg8::gemm_phase<pg8::EpiAct<1>, true, true, 4>(lds, g, S, E);
#define SEGS_B CSEG(2, 1, C_IN)
#define SEGS_D CSEG(0, 2, C_W)
#define SEGS_G CSEG(0, 3, C_W)
            if (L == 0) FILLER2(4, 2 * ADA_IT, C_IN, SEGS_B);
            if (L == 1) FILLER2(4, -1, C_W, SEGS_D);
            if (L == 2) FILLER2(4, -1, C_W, SEGS_G);
#undef SEGS_B
#undef SEGS_D
#undef SEGS_G
        }
        if (IN(base + 9)) {
            PHASE_BEGIN();
            const bf16_t* Ao = WSB(WS_BIG); const bf16_t* Bo = WSB(WS_W2) + (size_t)L * D * FF;
            pg8::Gemm g{Ao, Bo, FF, FF, FF, -1, Ao, Bo, 1};
            pg8::StaticOrder S; if (lastL) S.init(32, D / 256, G, bxp); else if (G == 256) S.init(32, D / 256, -G, bxp + 256, 4, D / 256, 1);
            else S.init(32, D / 256, G, bxp, 4, D / 256, 1);
            if (lastL) { pg8::EpiResidT<false, 2> E{WSB(WS_X), WSF(WS_MODS) + (size_t)L * 5 * MODW, 5, (float*)TABP(23), nullptr, INP(22), 0, 64u * (2 * L + 2), lds};
                pg8::gemm_phase<pg8::EpiResidT<false, 2>, true, true>(lds, g, S, E); }
            else { pg8::EpiResidT<false, 1> E{WSB(WS_X), WSF(WS_MODS) + (size_t)L * 5 * MODW, 5, WSF(WS_SLAB), nullptr, INP(6) + (size_t)(L + 1) * D, 5 * MODW, 64u * (2 * L + 2), lds};
                pg8::gemm_phase<pg8::EpiResidT<false, 1>, true, true>(lds, g, S, E); }
        }
        if (IN(base + 10) && !lastL) {
            PHASE_BEGIN();
            bf16_t* X = WSB(WS_X);
#define SRC10(r) (X + (size_t)(r) * D)
            { const float* mn = WSF(WS_MODS) + (size_t)(L + 1) * 5 * MODW; bf16_t* XN = WSB(WS_XN); const float* g1n = INP(6) + (size_t)(L + 1) * D;
                const float* slab = WSF(WS_SLAB); const float* gate5 = WSF(WS_MODS) + ((size_t)L * 5 + 4) * MODW + 5 * D;
#define VECS10B(m) norm_vecs<0>(g1n, mn + (size_t)(m) * MODW, mn + (size_t)(m) * MODW + D, GG, SS, lane)
#define APP10B(v, r) norm_apply<0>(v, nullptr, GG, SS, XN + (size_t)(r) * D, nullptr, lane)
                { f32x4 GG[8], SS[8]; VECS10B(4);
                  for (int row = ML + gw; row < M; row += NGW) { f32x4 v[8]; norm_load(X + (size_t)row * D, v, lane);
                      norm_apply<0>(v, X + (size_t)row * D, GG, SS, XN + (size_t)row * D, nullptr, lane,
                                    (const float*)((const bf16_t*)slab + (size_t)((row - ML) >> 8) * 64 * 65536 + (size_t)(row & 255) * 256), gate5); } }
#undef VECS10B
#undef APP10B
            }
#undef SRC10
        }
    }
#undef IN
#undef PHASE_BEGIN
}

static inline dim3 g1(size_t n) { return dim3((unsigned)((n + 255) / 256)); }

extern "C" void kernel_launch(void* const* d_in, const int* in_sizes, int n_in, void* d_out, int out_size, void* d_ws, size_t ws_size, hipStream_t stream) {
    static int grid = 0;
    if (grid == 0) {
        int dev = 0, cus = 0;
        if (hipGetDevice(&dev) != hipSuccess || hipDeviceGetAttribute(&cus, hipDeviceAttributeMultiprocessorCount, dev) != hipSuccess) { grid = -1; return; }
        if (hipFuncSetAttribute((const void*)mega, hipFuncAttributeMaxDynamicSharedMemorySize, LDS_BYTES) != hipSuccess) { fprintf(stderr, "hipFuncSetAttribute failed\n"); grid = -1; return; }
        int per_cu = 0; (void)hipOccupancyMaxActiveBlocksPerMultiprocessor(&per_cu, (const void*)mega, NTHREADS, LDS_BYTES); (void)hipGetLastError();
        grid = cus;
    }
    if (grid < 0) return;
    const float* norm1_g = (const float*)d_in[6]; const float* norm2_g = (const float*)d_in[7];
    const float* lru_w_in = (const float*)d_in[10]; const float* lru_conv_w = (const float*)d_in[11];
    const float* lru_conv_b = (const float*)d_in[12]; const float* lru_lambda = (const float*)d_in[13]; const float* lru_wa = (const float*)d_in[14]; const float* lru_ba = (const float*)d_in[15];
    const float* lru_wx = (const float*)d_in[16]; const float* lru_bx = (const float*)d_in[17]; const float* lru_w_out = (const float*)d_in[18]; const float* na_w_qkv = (const float*)d_in[19];
    const float* na_rpb = (const float*)d_in[20]; const float* na_w_o = (const float*)d_in[21];
    (void)norm2_g;
    char* ws = (char*)d_ws;
    (void)hipMemsetAsync(ws + WS_CTL, 0, CTL_ZERO_BYTES, stream);
    Args a{};
    for (int i = 0; i < 23; ++i) a.in[i] = (const float*)d_in[i];
    a.out = (float*)d_out; a.ws = (unsigned char*)d_ws;
    auto run = [&](int lo, int hi) { a.ph_lo = lo; a.ph_hi = hi; hipLaunchKernelGGL(mega, dim3(grid), dim3(NTHREADS), LDS_BYTES, stream, a); };
#if ONE_LAUNCH
    if (WS_FAST_END > ws_size) { fprintf(stderr, "ws too small\n"); return; }
    run(0, PH_END);
#else
    size_t off = (FAST_LRU ? WS_FAST_END : WS_NV);
    auto alloc = [&](size_t bytes) { float* p = (float*)(ws + off); off += (bytes + 255) & ~(size_t)255; return p; };
    float* H = alloc((size_t)M * D * 4); float* T1 = alloc((size_t)M * D * 4);
    float* BIGF = alloc((size_t)M * 3 * D * 4);
    float* UCf = alloc((size_t)M * LW * 4); float* RA = alloc((size_t)M * LW * 4); float* RX = alloc((size_t)M * LW * 4); float* Y = alloc((size_t)M * LW * 4);
    if (!(FAST_LRU && FAST_NA)) { if (off > ws_size) { fprintf(stderr, "ws too small: need %zu have %zu\n", off, ws_size); return; } }
    else if (WS_FAST_END > ws_size) return;
    float* mods = (float*)(ws + WS_MODS); float* X = (float*)(ws + WS_X);
    run(PH_PROLOGUE, PH_PROLOGUE + 1);
    run(PH_NORM0, PH_NORM0 + 1);
    for (int L = 0; L < DEPTH; ++L) {
        const int base = PH_LAYER0 + PH_PER_LAYER * L; const bool lru = !(L & 1); const int j = L / 2;
        const float* ml = mods + (size_t)L * 5 * MODW;
        if (lru) {
            if (FAST_LRU) { for (int p = 0; p <= 6; ++p) run(base + p, base + p + 1); }
            else {
                nv::k_norm_mod<<<M, 256, 0, stream>>>(X, norm1_g + (size_t)L * D, ml, 0, H, D);
                float* GUf = BIGF;
                nv::k_sgemm<<<dim3(2 * LW / 128, M / 128, 1), 256, 0, stream>>>(H, D, 0, lru_w_in + (size_t)j * D * 2 * LW, 2 * LW, 0, GUf, 2 * LW, 0, D);
                nv::k_conv<<<g1((size_t)M * LW), 256, 0, stream>>>(GUf, lru_conv_w + (size_t)j * 4 * LW, lru_conv_b + (size_t)j * LW, UCf);
                for (int d = 0; d < 2; ++d) {
                    const size_t wo = ((size_t)j * 2 + d) * NLB * LB * LB, bo = ((size_t)j * 2 + d) * LW;
                    nv::k_sgemm<<<dim3(LB / 128, M / 128, NLB), 256, 0, stream>>>(UCf, LW, LB, lru_wa + wo, LB, (size_t)LB * LB, RA, LW, LB, LB);
                    nv::k_sgemm<<<dim3(LB / 128, M / 128, NLB), 256, 0, stream>>>(UCf, LW, LB, lru_wx + wo, LB, (size_t)LB * LB, RX, LW, LB, LB);
                    nv::k_lru_coef<<<g1((size_t)M * LW), 256, 0, stream>>>(RA, RX, UCf, lru_ba + bo, lru_bx + bo, lru_lambda + bo);
                    nv::k_scan_dir<<<g1(BATCH * LW), 256, 0, stream>>>(RA, RX, Y, d);
                }
                nv::k_gate_mul<<<g1((size_t)M * LW), 256, 0, stream>>>(GUf, Y, UCf);
                nv::k_sgemm<<<dim3(D / 128, M / 128, 1), 256, 0, stream>>>(UCf, LW, 0, lru_w_out + (size_t)j * LW * D, D, 0, T1, D, 0, LW);
                nv::k_resid<<<g1((size_t)M * D), 256, 0, stream>>>(X, T1, ml, 2, M);
            }
        } else {
            if (FAST_NA) { run(base + 0, base + 1); run(base + 1, base + 2); run(base + 6, base + 7); }
            else {
                nv::k_norm_mod<<<M, 256, 0, stream>>>(X, norm1_g + (size_t)L * D, ml, 0, H, D);
                float* QKV = BIGF;
                nv::k_sgemm<<<dim3(3 * D / 128, M / 128, 1), 256, 0, stream>>>(H, D, 0, na_w_qkv + (size_t)j * D * 3 * D, 3 * D, 0, QKV, 3 * D, 0, D);
                nv::k_attn<<<M * NH / 4, 256, 0, stream>>>(QKV, na_rpb + (size_t)j * NH * 15 * 31, H);
                nv::k_sgemm<<<dim3(D / 128, M / 128, 1), 256, 0, stream>>>(H, D, 0, na_w_o + (size_t)j * D * D, D, 0, T1, D, 0, D);
                nv::k_resid<<<g1((size_t)M * D), 256, 0, stream>>>(X, T1, ml, 2, M);
            }
        }
        run(base + 7, base + 8); run(base + 8, base + 9); run(base + 9, base + 10); run(base + 10, base + 11);
    }
#endif
}
```

```cpp
#include <hip/hip_runtime.h>
#include <cstdint>
#include <cstdio>

#ifndef FAST_MLP
#define FAST_MLP 1
#endif
#ifndef FAST_NA
#define FAST_NA 1
#endif
#ifndef FAST_LRU
#define FAST_LRU 1
#endif
#ifndef REP_PRO
#define REP_PRO 1
#endif
#ifndef REP_NORM
#define REP_NORM 1
#endif
#ifndef REP_ATTN
#define REP_ATTN 1
#endif
#ifndef REP_SCAN
#define REP_SCAN 1
#endif
#ifndef REP_CONV
#define REP_CONV 1
#endif
#ifndef REP_S1
#define REP_S1 1
#endif
#ifndef REP_S2
#define REP_S2 1
#endif
#ifndef REP_S3
#define REP_S3 1
#endif
#ifndef REP_IN
#define REP_IN 1
#endif
#ifndef REP_GATES
#define REP_GATES 1
#endif
#ifndef REP_MLP1
#define REP_MLP1 1
#endif
#ifndef REP_OUT
#define REP_OUT 1
#endif
#ifndef REP_MLP2
#define REP_MLP2 1
#endif
#ifndef REP_GEMM
#define REP_GEMM 1
#endif
#ifndef ONE_LAUNCH
#define ONE_LAUNCH 1
#endif

namespace cfg {
constexpr int D = 2048, BATCH = 4, SEQ = 2048, DEPTH = 4, GRID_W = 64, CTX = 256, NH = 16, HD = 128;
constexpr int LW = 2816, NLB = 11, LB = 256, FF = 8192, NMOD = 6;
constexpr int ML = BATCH * SEQ, MC = BATCH * CTX, M = ML + MC;
constexpr int MODW = NMOD * D;
}
using namespace cfg;

#define LAS __attribute__((address_space(3)))
#define GAS __attribute__((address_space(1)))
typedef unsigned short bf16_t;
typedef short bf16x8 __attribute__((ext_vector_type(8)));
typedef float f32x4 __attribute__((ext_vector_type(4)));
typedef float f32x2 __attribute__((ext_vector_type(2)));
typedef unsigned u32x4 __attribute__((ext_vector_type(4)));
typedef unsigned u32x2 __attribute__((ext_vector_type(2)));

__device__ __forceinline__ float sigmoidf_(float x) { return 1.f / (1.f + expf(-x)); }
__device__ __forceinline__ float siluf_(float x) { return x * sigmoidf_(x); }
__device__ __forceinline__ float gelu_tanh(float x) { return 0.5f * x * (1.f + tanhf(0.7978845608028654f * (x + 0.044715f * x * x * x))); }
__device__ __forceinline__ int row_mod(int row) { return row < ML ? row / SEQ : 4; }
__device__ __forceinline__ unsigned f2bf(float f) { unsigned u = __builtin_bit_cast(unsigned, f); return (u + 0x7fffu + ((u >> 16) & 1u)) >> 16; }
__device__ __forceinline__ unsigned pk2(float lo, float hi) { return f2bf(lo) | (f2bf(hi) << 16); }
__device__ __forceinline__ float bf_lo(unsigned w) { return __builtin_bit_cast(float, w << 16); }
__device__ __forceinline__ float bf_hi(unsigned w) { return __builtin_bit_cast(float, w & 0xffff0000u); }
__device__ __forceinline__ unsigned cvt_pk_bf16(float lo, float hi) { unsigned r; asm volatile("v_cvt_pk_bf16_f32 %0, %1, %2" : "=v"(r) : "v"(lo), "v"(hi)); return r; }
__device__ __forceinline__ float fast_exp2(float x) { return __builtin_amdgcn_exp2f(x); }
__device__ __forceinline__ float fast_rcp(float x) { return __builtin_amdgcn_rcpf(x); }
__device__ __forceinline__ float fast_sigmoid(float x) { return fast_rcp(1.f + fast_exp2(-1.4426950408889634f * x)); }

namespace nv {
__global__ void k_norm_mod(const float* X, const float* g, const float* mods_l, int sh_idx, float* H, int ldh) {
    const int row = blockIdx.x, tid = threadIdx.x;
    const float* xr = X + (size_t)row * D;
    float v[8], ss = 0.f;
#pragma unroll
    for (int j = 0; j < 8; ++j) { v[j] = xr[tid + 256 * j]; ss += v[j] * v[j]; }
    __shared__ float red[256];
    red[tid] = ss; __syncthreads();
    for (int o = 128; o > 0; o >>= 1) { if (tid < o) red[tid] += red[tid + o]; __syncthreads(); }
    const float rstd = rsqrtf(red[0] / D + 1e-6f);
    const int m = row_mod(row);
#pragma unroll
    for (int j = 0; j < 8; ++j) {
        const int col = tid + 256 * j; float h = v[j] * rstd * g[col];
        if (sh_idx >= 0) { const float sh = mods_l[(size_t)m * MODW + sh_idx * D + col], sc = mods_l[(size_t)m * MODW + (sh_idx + 1) * D + col]; h = h * (1.f + sc) + sh; }
        H[(size_t)row * ldh + col] = h;
    }
}
__global__ __launch_bounds__(256) void k_sgemm(const float* A, int lda, size_t sA, const float* B, int ldb, size_t sB, float* C, int ldc, size_t sC, int K) {
    __shared__ float As[16][128 + 4], Bs[16][128 + 4];
    A += blockIdx.z * sA; B += blockIdx.z * sB; C += blockIdx.z * sC;
    const int tid = threadIdx.x, tx = tid & 15, ty = tid >> 4;
    const int m0 = blockIdx.y * 128, n0 = blockIdx.x * 128;
    float acc[8][8];
#pragma unroll
    for (int i = 0; i < 8; ++i)
#pragma unroll
        for (int j = 0; j < 8; ++j) acc[i][j] = 0.f;
    for (int k0 = 0; k0 < K; k0 += 16) {
#pragma unroll
        for (int i = 0; i < 2; ++i) {
            const int r = (tid >> 2) + 64 * i, kq = (tid & 3) * 4;
            const float4 a = *(const float4*)(A + (size_t)(m0 + r) * lda + k0 + kq);
            As[kq + 0][r] = a.x; As[kq + 1][r] = a.y; As[kq + 2][r] = a.z; As[kq + 3][r] = a.w;
            const int kk = (tid >> 5) + 8 * i, nq = (tid & 31) * 4;
            const float4 b = *(const float4*)(B + (size_t)(k0 + kk) * ldb + n0 + nq);
            *(float4*)&Bs[kk][nq] = b;
        }
        __syncthreads();
#pragma unroll
        for (int k = 0; k < 16; ++k) {
            float a[8], b[8];
            *(float4*)&a[0] = *(const float4*)&As[k][ty * 4]; *(float4*)&a[4] = *(const float4*)&As[k][64 + ty * 4];
            *(float4*)&b[0] = *(const float4*)&Bs[k][tx * 4]; *(float4*)&b[4] = *(const float4*)&Bs[k][64 + tx * 4];
#pragma unroll
            for (int i = 0; i < 8; ++i)
#pragma unroll
                for (int j = 0; j < 8; ++j) acc[i][j] += a[i] * b[j];
        }
        __syncthreads();
    }
#pragma unroll
    for (int i = 0; i < 8; ++i) {
        const int r = m0 + (i < 4 ? ty * 4 + i : 64 + ty * 4 + i - 4);
        *(float4*)(C + (size_t)r * ldc + n0 + tx * 4) = make_float4(acc[i][0], acc[i][1], acc[i][2], acc[i][3]);
        *(float4*)(C + (size_t)r * ldc + n0 + 64 + tx * 4) = make_float4(acc[i][4], acc[i][5], acc[i][6], acc[i][7]);
    }
}
__global__ void k_resid(float* X, const float* O, const float* mods_l, int g_idx, int rows) {
    const size_t i = (size_t)blockIdx.x * 256 + threadIdx.x; if (i >= (size_t)rows * D) return;
    const int row = i / D, col = i % D, m = row_mod(row);
    X[i] += mods_l[(size_t)m * MODW + g_idx * D + col] * O[i];
}
__global__ void k_sqrelu(float* A, size_t n) { const size_t i = (size_t)blockIdx.x * 256 + threadIdx.x; if (i < n) { const float v = fmaxf(A[i], 0.f); A[i] = v * v; } }
__global__ void k_conv(const float* GU, const float* cw, const float* cb, float* UC) {
    const size_t i = (size_t)blockIdx.x * 256 + threadIdx.x; if (i >= (size_t)M * LW) return;
    const int row = i / LW, c = i % LW;
    int seg0, seglen; if (row < ML) { seg0 = (row / SEQ) * SEQ; seglen = SEQ; } else { seg0 = ML + ((row - ML) / CTX) * CTX; seglen = CTX; }
    const int t = row - seg0; float s = cb[c];
    for (int j = 0; j < 4; ++j) { const int tt = t + j - 2; if (tt >= 0 && tt < seglen) s += cw[j * LW + c] * GU[(size_t)(seg0 + tt) * (2 * LW) + LW + c]; }
    UC[i] = s;
}
__global__ void k_lru_coef(float* RA, float* RX, const float* UC, const float* ba, const float* bx, const float* lam) {
    const size_t i = (size_t)blockIdx.x * 256 + threadIdx.x; if (i >= (size_t)M * LW) return;
    const int c = i % LW;
    const float r = sigmoidf_(RA[i] + ba[c]), ig = sigmoidf_(RX[i] + bx[c]);
    const float sp = log1pf(expf(-lam[c]));
    const float log_a = -8.f * r * sp;
    RA[i] = expf(log_a);
    RX[i] = sqrtf(-expm1f(2.f * log_a)) * (ig * UC[i]);
}
__global__ void k_scan_dir(const float* A, const float* Bc, float* Y, int dir) {
    const int idx = blockIdx.x * 256 + threadIdx.x; if (idx >= BATCH * LW) return;
    const int b = idx / LW, c = idx % LW;
    float h = 0.f;
    if (dir == 0) {
        for (int t = 0; t < CTX; ++t) { const size_t o = (size_t)(ML + b * CTX + t) * LW + c; h = A[o] * h + Bc[o]; Y[o] = h; }
        for (int t = 0; t < SEQ; ++t) { const size_t o = (size_t)(b * SEQ + t) * LW + c; h = A[o] * h + Bc[o]; Y[o] = h; }
    } else {
        for (int t = CTX - 1; t >= 0; --t) { const size_t o = (size_t)(ML + b * CTX + t) * LW + c; h = A[o] * h + Bc[o]; Y[o] += h; }
        for (int t = SEQ - 1; t >= 0; --t) { const size_t o = (size_t)(b * SEQ + t) * LW + c; h = A[o] * h + Bc[o]; Y[o] += h; }
    }
}
__global__ void k_gate_mul(const float* GU, const float* Y, float* Z) {
    const size_t i = (size_t)blockIdx.x * 256 + threadIdx.x; if (i >= (size_t)M * LW) return;
    const int row = i / LW, c = i % LW;
    Z[i] = gelu_tanh(GU[(size_t)row * (2 * LW) + c]) * Y[i];
}
__global__ __launch_bounds__(256) void k_attn(const float* QKV, const float* rpb_l, float* O) {
    __shared__ float qs[4][HD], ps[4][384];
    const int w = threadIdx.x >> 6, lane = threadIdx.x & 63;
    const int gw = blockIdx.x * 4 + w; const int row = gw / NH, h = gw % NH;
    const bool lat = row < ML;
    const int b = lat ? row / SEQ : (row - ML) / CTX;
    const int t = lat ? row % SEQ : 0, r = t / GRID_W, c = t % GRID_W;
    int rs = r - 4; rs = rs < 0 ? 0 : (rs > 24 ? 24 : rs);
    int cs = c - 8; cs = cs < 0 ? 0 : (cs > 48 ? 48 : cs);
    const float scale = 0.08838834764831845f;
    qs[w][lane] = QKV[(size_t)row * (3 * D) + h * HD + lane]; qs[w][lane + 64] = QKV[(size_t)row * (3 * D) + h * HD + lane + 64];
    __syncthreads();
    float s[6]; float mx = -1e30f;
#pragma unroll
    for (int i = 0; i < 6; ++i) {
        const int j = lane + 64 * i; int krow; float bias = 0.f; bool valid = true;
        if (j < 128) { const int a = j >> 4, kk = j & 15; krow = b * SEQ + (rs + a) * GRID_W + cs + kk; bias = rpb_l[(h * 15 + (rs + a - r + 7)) * 31 + (cs + kk - c + 15)]; valid = lat; }
        else krow = ML + b * CTX + (j - 128);
        float d = 0.f;
        if (valid) { const float* kp = QKV + (size_t)krow * (3 * D) + D + h * HD; for (int e = 0; e < HD; ++e) d += qs[w][e] * kp[e]; d = d * scale + bias; } else d = -1e30f;
        s[i] = d; mx = fmaxf(mx, d);
    }
    for (int o = 32; o > 0; o >>= 1) mx = fmaxf(mx, __shfl_xor(mx, o));
    float sum = 0.f;
#pragma unroll
    for (int i = 0; i < 6; ++i) { const float p = (s[i] <= -1e29f) ? 0.f : expf(s[i] - mx); s[i] = p; sum += p; }
    for (int o = 32; o > 0; o >>= 1) sum += __shfl_xor(sum, o);
    const float inv = 1.f / sum;
#pragma unroll
    for (int i = 0; i < 6; ++i) ps[w][lane + 64 * i] = s[i] * inv;
    __syncthreads();
    float o0 = 0.f, o1 = 0.f;
    for (int j = lat ? 0 : 128; j < 384; ++j) {
        int krow; if (j < 128) { const int a = j >> 4, kk = j & 15; krow = b * SEQ + (rs + a) * GRID_W + cs + kk; } else krow = ML + b * CTX + (j - 128);
        const float* vp = QKV + (size_t)krow * (3 * D) + 2 * D + h * HD; const float p = ps[w][j];
        o0 += p * vp[lane]; o1 += p * vp[lane + 64];
    }
    O[(size_t)row * D + h * HD + lane] = o0; O[(size_t)row * D + h * HD + lane + 64] = o1;
}
}

namespace pg8 {
constexpr int BM = 256, BK = 64, HALF = 128, HTB = HALF * BK * 2, STAGE_BYTES = 8 * HTB, NXCD = 8, WGM = 4;
__host__ __device__ __forceinline__ int lds_byte(int r, int c) { const int st = (r >> 4) * 2 + (c >> 5), rr = r & 15, cc = c & 31, ob = rr * 64 + cc * 2; return st * 1024 + (ob ^ (((ob >> 9) & 1) << 5)); }
__host__ __device__ __forceinline__ void stage_rc(int b, int& R, int& C) { const int st = b / 1024, sb = b % 1024, swz = sb ^ (((sb >> 9) & 1) << 5); R = (st >> 1) * 16 + swz / 64; C = (st & 1) * 32 + (swz % 64) / 2; }
__host__ __device__ __forceinline__ int perm32(int rho) { const int n = rho >> 4, i = rho & 15; return 8 * (i >> 2) + 4 * n + (i & 3); }
struct Unit { int pm, pn, sw, ks; };
struct Gemm { const bf16_t* A; const bf16_t* Bt; int lda, ldb, K, apn_shift; const bf16_t* A2; const bf16_t* Bt2; int ksplit; };
__device__ __forceinline__ int gemm_cc(int U, int G) { if (G & 7) return G; const int R = (U + G - 1) / G; int c = (U + R - 1) / R; c = (c + 7) & ~7; return c > G ? G : c; }
constexpr int CC_TAB_OFF = 131072 + 512;
struct StaticOrder {
    int nM, nN, nwg, G, c, nM2, nN2, nwg2, split;
    __device__ void init(int nM_, int nN_, int G_, int c_, int nM2_ = 0, int nN2_ = 0, int split_ = 0) { nM = nM_; nN = nN_; nwg = nM * nN; G = G_; c = c_; nM2 = nM2_; nN2 = nN2_; split = split_; nwg2 = split_ ? nM2 * nN2 * 8 : nM2 * nN2; }
    __device__ static void map(int wgid, int nM, int nN, int nwg, Unit& u) {
        { const int q = nwg / NXCD, r = nwg % NXCD, xcd = wgid % NXCD, off = wgid / NXCD; wgid = (xcd < r ? xcd * (q + 1) : r * (q + 1) + (xcd - r) * q) + off; }
        const int nig = WGM * nN, gid = wgid / nig, fm = gid * WGM, gsz = (nM - fm) < WGM ? (nM - fm) : WGM;
        u.pm = fm + ((wgid % nig) % gsz); u.pn = (wgid % nig) / gsz;
    }
    __device__ bool next(int i, Unit& u, const LAS unsigned char* lds, int cck) const {
        int Gs = G, cs = c; if (cck) { Gs = __builtin_amdgcn_readfirstlane(*(volatile const LAS int*)(lds + CC_TAB_OFF + 4 * cck)); cs = c < Gs ? c : (1 << 28); }
        const long L = (long)i * Gs + cs; if ((unsigned long)L >= (unsigned long)(nwg + nwg2)) return false;
        u.ks = 0;
        if (L < nwg) { map((int)L, nM, nN, nwg, u); u.sw = 0; }
        else if (!split) { map((int)L - nwg, nM2, nN2, nwg2, u); u.sw = 1; }
        else { const int L2 = (int)L - nwg; int tile, ks;
            if (nwg2 == 256) { const int x = L2 & 7, jj = L2 >> 3; tile = x * 4 + (jj >> 3); ks = jj & 7; } else { tile = L2 >> 3; ks = L2 & 7; }
            u.pm = nM + tile / nN2; u.pn = tile % nN2; u.sw = 1; u.ks = ks; }
        return true;
    }
};
template <class Epi, bool ALIGN_EPI, bool SP2, int CCK = 0>
__device__ __forceinline__ void gemm_phase(LAS unsigned char* lds, const Gemm g, const StaticOrder& S, const Epi& E) {
    int tid = threadIdx.x; asm volatile("" : "+v"(tid));
    const int wid = __builtin_amdgcn_readfirstlane(tid >> 6), lane = tid & 63, wr = wid >> 2, wc = wid & 3, fr = lane & 15, fq = lane >> 4;
    const int KT = g.K / BK, spl_e = (KT / 8) & ~1, spl_x = (KT - 8 * spl_e) / 2;
    unsigned voffA[2], voffB[2];
#pragma unroll
    for (int i = 0; i < 2; ++i) { int R, C; stage_rc(tid * 16 + i * 8192, R, C); const int Rb = Epi::PERM ? ((R & ~31) + perm32(R & 31)) : R;
        voffA[i] = (unsigned)(R * g.lda + C) * 2u; voffB[i] = (unsigned)(Rb * g.ldb + C) * 2u; }
    const size_t kstep = (size_t)(BK * 2);
    const size_t hstepA = (size_t)HALF * g.lda * 2, tstepA = 2 * hstepA, hstepB = (size_t)HALF * g.ldb * 2, tstepB = 2 * hstepB;
    const unsigned ldsw = (unsigned)wid * 1024u;
    const int aoff = lds_byte(wr * 64 + fr, fq * 8), boff = lds_byte(wc * 32 + fr, fq * 8);
#define PG8_SA(b, h) (((b) * 2 + (h)) * HTB)
#define PG8_SB(b, h) ((4 + (b) * 2 + (h)) * HTB)
#define PG8_STAGE(bufoff, gbase, voff) do { _Pragma("unroll") for (int _i = 0; _i < 2; ++_i) \
        __builtin_amdgcn_global_load_lds((const unsigned*)((const char*)(gbase) + (voff)[_i]), (LAS unsigned*)(lds + (bufoff) + ldsw + _i * 8192), 16, 0, 0); } while (0)
#define PG8_LDA(dst, b, h) do { _Pragma("unroll") for (int m = 0; m < 4; ++m) _Pragma("unroll") for (int k = 0; k < 2; ++k) dst[m][k] = *(const LAS bf16x8*)(lds + PG8_SA(b, h) + aoff + m * 2048 + k * 1024); } while (0)
#define PG8_LDB(dst, b, h) do { _Pragma("unroll") for (int n = 0; n < 2; ++n) _Pragma("unroll") for (int k = 0; k < 2; ++k) dst[n][k] = *(const LAS bf16x8*)(lds + PG8_SB(b, h) + boff + n * 2048 + k * 1024); } while (0)
#define PG8_MMA(ai, bj, At, Bt) do { __builtin_amdgcn_s_setprio(1); _Pragma("unroll") for (int m = 0; m < 4; ++m) _Pragma("unroll") for (int n = 0; n < 2; ++n) _Pragma("unroll") for (int k = 0; k < 2; ++k) \
        acc[ai][bj][m][n] = __builtin_amdgcn_mfma_f32_16x16x32_bf16(Bt[n][k], At[m][k], acc[ai][bj][m][n], 0, 0, 0); __builtin_amdgcn_s_setprio(0); } while (0)
#define PG8_WAIT_V(n) asm volatile("s_waitcnt vmcnt(" #n ")" ::: "memory")
#define PG8_WAIT_L(n) asm volatile("s_waitcnt lgkmcnt(" #n ")" ::: "memory")
#define PG8_BAR __builtin_amdgcn_s_barrier()
#define PG8_SCHED __builtin_amdgcn_sched_barrier(0)
#define PG8_KOFF(u) ((g.ksplit && (u).sw) ? (size_t)(spl_e * (u).ks + 2 * ((u).ks < spl_x ? (u).ks : spl_x)) * kstep : (size_t)0)
#define PG8_NT(u) ((g.ksplit && (u).sw) ? spl_e + ((u).ks < spl_x ? 2 : 0) : KT)
#define PG8_APTR(u) ((const char*)((u).sw ? g.A2 : g.A) + (size_t)(u).pm * tstepA + (g.apn_shift >= 0 ? (size_t)((u).pn >> g.apn_shift) * 512 : (size_t)0) + PG8_KOFF(u))
#define PG8_BPTR(u) ((const char*)((u).sw ? g.Bt2 : g.Bt) + (size_t)(u).pn * tstepB + PG8_KOFF(u))
    Unit cur, nxt; int ui = 0;
    if (!S.next(0, cur, lds, CCK)) return;
    f32x4 acc[2][2][4][2];
#pragma unroll
    for (int a = 0; a < 2; ++a)
#pragma unroll
        for (int b = 0; b < 2; ++b)
#pragma unroll
            for (int m = 0; m < 4; ++m)
#pragma unroll
                for (int n = 0; n < 2; ++n) acc[a][b][m][n] = (f32x4){0.f, 0.f, 0.f, 0.f};
    bf16x8 At[4][2], B0[2][2], B1[2][2];
    const char* cA = PG8_APTR(cur); const char* cB = PG8_BPTR(cur); int nt = PG8_NT(cur);
    if constexpr (SP2) {
        PG8_STAGE(PG8_SB(0, 0), cB, voffB); PG8_STAGE(PG8_SB(0, 1), cB + hstepB, voffB); PG8_STAGE(PG8_SA(0, 0), cA, voffA); PG8_STAGE(PG8_SA(0, 1), cA + hstepA, voffA);
        if (wr == 1) PG8_BAR;
        PG8_WAIT_V(2); PG8_BAR;
        PG8_STAGE(PG8_SB(1, 0), cB + kstep, voffB); PG8_STAGE(PG8_SA(1, 0), cA + kstep, voffA); PG8_STAGE(PG8_SB(1, 1), cB + hstepB + kstep, voffB);
        PG8_WAIT_V(6); PG8_BAR;
    } else {
        PG8_STAGE(PG8_SB(0, 0), cB, voffB); PG8_STAGE(PG8_SA(0, 0), cA, voffA); PG8_STAGE(PG8_SB(0, 1), cB + hstepB, voffB); PG8_STAGE(PG8_SA(0, 1), cA + hstepA, voffA);
        if (wr == 1) PG8_BAR;
        PG8_WAIT_V(4); PG8_BAR;
        PG8_STAGE(PG8_SB(1, 0), cB + kstep, voffB); PG8_STAGE(PG8_SA(1, 0), cA + kstep, voffA); PG8_STAGE(PG8_SB(1, 1), cB + hstepB + kstep, voffB);
        PG8_WAIT_V(6); PG8_BAR;
    }
    for (;;) {
        const bool has_next = S.next(ui + 1, nxt, lds, CCK);
        const char* nA = has_next ? PG8_APTR(nxt) : cA; const char* nB = has_next ? PG8_BPTR(nxt) : cB;
        for (int t = 0; t < nt; t += 2) {
            const bool last = (t == nt - 2);
            const char* a1 = cA + (size_t)(t + 1) * kstep;
            const char* a2 = last ? nA : cA + (size_t)(t + 2) * kstep; const char* b2 = last ? nB : cB + (size_t)(t + 2) * kstep;
            const char* a3 = a2 + kstep; const char* b3 = b2 + kstep;
            if constexpr (SP2) {
            PG8_LDB(B0, 0, 0); PG8_LDB(B1, 0, 1); PG8_SCHED; PG8_LDA(At, 0, 0); PG8_STAGE(PG8_SA(1, 1), a1 + hstepA, voffA);
            PG8_WAIT_V(8); PG8_WAIT_L(0); PG8_BAR; PG8_MMA(0, 0, At, B0); PG8_MMA(0, 1, At, B1); PG8_BAR; PG8_SCHED;
            PG8_LDA(At, 0, 1); PG8_STAGE(PG8_SB(0, 0), b2, voffB); PG8_STAGE(PG8_SB(0, 1), b2 + hstepB, voffB); PG8_STAGE(PG8_SA(0, 0), a2, voffA);
            PG8_WAIT_V(8); PG8_WAIT_L(0); PG8_BAR; PG8_MMA(1, 0, At, B0); PG8_MMA(1, 1, At, B1); PG8_BAR; PG8_SCHED;
            PG8_LDB(B0, 1, 0); PG8_LDB(B1, 1, 1); PG8_SCHED; PG8_LDA(At, 1, 0); PG8_STAGE(PG8_SA(0, 1), a2 + hstepA, voffA);
            PG8_WAIT_V(8); PG8_WAIT_L(0); PG8_BAR; PG8_MMA(0, 0, At, B0); PG8_MMA(0, 1, At, B1); PG8_BAR; PG8_SCHED;
            PG8_LDA(At, 1, 1); PG8_STAGE(PG8_SB(1, 0), b3, voffB); PG8_STAGE(PG8_SB(1, 1), b3 + hstepB, voffB); PG8_STAGE(PG8_SA(1, 0), a3, voffA);
            PG8_WAIT_V(8); PG8_WAIT_L(0); PG8_BAR; PG8_MMA(1, 0, At, B0); PG8_MMA(1, 1, At, B1); PG8_BAR; PG8_SCHED;
            } else {
            PG8_LDB(B0, 0, 0); PG8_SCHED; PG8_LDA(At, 0, 0); PG8_STAGE(PG8_SA(1, 1), a1 + hstepA, voffA);
            PG8_WAIT_L(8); PG8_BAR; PG8_WAIT_L(0); PG8_MMA(0, 0, At, B0); PG8_BAR; PG8_SCHED;
            PG8_LDB(B1, 0, 1); PG8_STAGE(PG8_SB(0, 0), b2, voffB);
            PG8_BAR; PG8_WAIT_L(0); PG8_MMA(0, 1, At, B1); PG8_BAR;
            PG8_LDA(At, 0, 1); PG8_STAGE(PG8_SA(0, 0), a2, voffA);
            PG8_BAR; PG8_WAIT_L(0); PG8_MMA(1, 0, At, B0); PG8_BAR; PG8_SCHED;
            PG8_STAGE(PG8_SB(0, 1), b2 + hstepB, voffB);
            PG8_WAIT_V(6); PG8_BAR; PG8_MMA(1, 1, At, B1); PG8_BAR;
            PG8_LDB(B0, 1, 0); PG8_SCHED; PG8_LDA(At, 1, 0); PG8_STAGE(PG8_SA(0, 1), a2 + hstepA, voffA);
            PG8_WAIT_L(8); PG8_BAR; PG8_WAIT_L(0); PG8_MMA(0, 0, At, B0); PG8_BAR; PG8_SCHED;
            PG8_LDB(B1, 1, 1); PG8_STAGE(PG8_SB(1, 0), b3, voffB);
            PG8_BAR; PG8_WAIT_L(0); PG8_MMA(0, 1, At, B1); PG8_BAR;
            PG8_LDA(At, 1, 1); PG8_STAGE(PG8_SA(1, 0), a3, voffA);
            PG8_BAR; PG8_WAIT_L(0); PG8_MMA(1, 0, At, B0); PG8_BAR; PG8_SCHED;
            PG8_STAGE(PG8_SB(1, 1), b3 + hstepB, voffB);
            PG8_WAIT_V(6); PG8_BAR; PG8_MMA(1, 1, At, B1); PG8_BAR;
            }
        }
        if constexpr (ALIGN_EPI) { if (wr == 0) PG8_BAR; }
        { int tz = threadIdx.x; asm volatile("" : "+v"(tz));
          const int wz = __builtin_amdgcn_readfirstlane(tz >> 6), lz = tz & 63; E(acc, cur, wz >> 2, wz & 3, lz & 15, lz >> 4); }
        if (!has_next) break;
#pragma unroll
        for (int a = 0; a < 2; ++a)
#pragma unroll
            for (int b = 0; b < 2; ++b)
#pragma unroll
                for (int m = 0; m < 4; ++m)
#pragma unroll
                    for (int n = 0; n < 2; ++n) acc[a][b][m][n] = (f32x4){0.f, 0.f, 0.f, 0.f};
        cur = nxt; cA = nA; cB = nB; ++ui; nt = PG8_NT(cur);
        if constexpr (ALIGN_EPI) { if (wr == 1) PG8_BAR; }
    }
    PG8_WAIT_V(0);
    if constexpr (!ALIGN_EPI) { if (wr == 0) PG8_BAR; }
    PG8_BAR;
#undef PG8_SA
#undef PG8_SB
#undef PG8_STAGE
#undef PG8_LDA
#undef PG8_LDB
#undef PG8_MMA
#undef PG8_WAIT_V
#undef PG8_WAIT_L
#undef PG8_BAR
#undef PG8_SCHED
#undef PG8_APTR
#undef PG8_BPTR
#undef PG8_KOFF
#undef PG8_NT
}

template <int ACT> struct EpiAct {
    static constexpr bool PERM = true;
    bf16_t* O; int ldc;
    __device__ __forceinline__ void operator()(const f32x4 (&acc)[2][2][4][2], const Unit& u, int wr, int wc, int fr, int fq) const {
        const int row0 = u.pm * BM + wr * 64 + fr, col0 = u.pn * BM + wc * 32 + 8 * fq;
#pragma unroll
        for (int ai = 0; ai < 2; ++ai)
#pragma unroll
            for (int m = 0; m < 4; ++m) { bf16_t* rowp = O + (size_t)(row0 + ai * HALF + m * 16) * ldc + col0;
#pragma unroll
                for (int bj = 0; bj < 2; ++bj) { f32x4 v0 = acc[ai][bj][m][0], v1 = acc[ai][bj][m][1];
                    if (ACT == 1) {
#pragma unroll
                        for (int j = 0; j < 4; ++j) { const float a = fmaxf(v0[j], 0.f), b = fmaxf(v1[j], 0.f); v0[j] = a * a; v1[j] = b * b; } }
                    u32x4 w; w.x = cvt_pk_bf16(v0[0], v0[1]); w.y = cvt_pk_bf16(v0[2], v0[3]); w.z = cvt_pk_bf16(v1[0], v1[1]); w.w = cvt_pk_bf16(v1[2], v1[3]);
                    *(u32x4*)(rowp + bj * HALF) = w; } }
    }
};
constexpr long long RN_DXN = (471ll - 399ll) << 20;
constexpr long long RN_DSLOT = (838ll - 399ll) << 20;
constexpr long long RN_DCNT = 131072ll - (399ll << 20);
constexpr int RN_LDS = 131072 + 4096;
template <bool XF32, int FUSE = 0  > struct EpiResidT {
    static constexpr bool PERM = true;
    bf16_t* X; const float* mods_l; int gidx; float* slab; const float* xin; const float* ng; int nsh_off; unsigned want; LAS unsigned char* lds;
    __device__ __forceinline__ void fuse_tail(f32x4 (&acc)[2][2][4][2], const float (&ssq)[2][4], const Unit& u, int wr, int wc, int fr, int fq, int mi, int row0, int col0) const {
        LAS float* P = (LAS float*)(lds + RN_LDS); LAS float* S = P + 1024; LAS unsigned* flag = (LAS unsigned*)(S + 256);
        const int wid = wr * 4 + wc, lane = fq * 16 + fr;
#pragma unroll
        for (int ai = 0; ai < 2; ++ai)
#pragma unroll
            for (int m = 0; m < 4; ++m) { float t = ssq[ai][m]; t += __shfl_xor(t, 16); t += __shfl_xor(t, 32);
                if (fq == 0) P[(ai * HALF + wr * 64 + m * 16 + fr) * 4 + wc] = t; }
        asm volatile("s_waitcnt lgkmcnt(0)" ::: "memory"); __builtin_amdgcn_s_barrier(); asm volatile("" ::: "memory");
        const int row = wid * 32 + (lane & 31);
        unsigned* slots = (unsigned*)((char*)X + RN_DSLOT) + ((size_t)(u.pm * BM + row) * 8);
        unsigned* pc = (unsigned*)((char*)X + RN_DCNT) + 64 * u.pm;
        if (lane < 32) { const f32x4 p = *(const LAS f32x4*)(P + row * 4); const float t = (p[0] + p[1]) + (p[2] + p[3]);
            __hip_atomic_store(slots + u.pn, __builtin_bit_cast(unsigned, t), __ATOMIC_RELAXED, __HIP_MEMORY_SCOPE_AGENT); }
        asm volatile("s_waitcnt vmcnt(0)" ::: "memory");
        if (lane == 0) __hip_atomic_fetch_add(pc, 1u, __ATOMIC_RELAXED, __HIP_MEMORY_SCOPE_AGENT);
        if (FUSE == 1 && !XF32) {
            int r0o = row0; asm volatile("" : "+v"(r0o)); bf16_t* xb = X + (size_t)r0o * D + col0;
#pragma unroll
            for (int ai = 0; ai < 2; ++ai)
#pragma unroll
                for (int m = 0; m < 4; ++m)
#pragma unroll
                    for (int bj = 0; bj < 2; ++bj) { const f32x4 v0 = acc[ai][bj][m][0], v1 = acc[ai][bj][m][1];
                        u32x4 w; w.x = cvt_pk_bf16(v0[0], v0[1]); w.y = cvt_pk_bf16(v0[2], v0[3]); w.z = cvt_pk_bf16(v1[0], v1[1]); w.w = cvt_pk_bf16(v1[2], v1[3]);
                        *(u32x4*)(xb + (size_t)(ai * HALF + m * 16) * D + bj * HALF) = w; }
        }
        if (wid == 0) { unsigned sp = 0u;
            while ((unsigned)__builtin_amdgcn_readfirstlane((int)__hip_atomic_load(pc, __ATOMIC_RELAXED, __HIP_MEMORY_SCOPE_AGENT)) < want) { __builtin_amdgcn_s_sleep(1); if (++sp > (1u << 18)) break; }
            __builtin_amdgcn_fence(__ATOMIC_ACQUIRE, "agent"); }
        asm volatile("s_waitcnt lgkmcnt(0)" ::: "memory"); __builtin_amdgcn_s_barrier(); asm volatile("" ::: "memory");
        if (lane < 32) { float t = 0.f;
#pragma unroll
            for (int k = 0; k < 8; ++k) t += __builtin_bit_cast(float, __hip_atomic_load(slots + k, __ATOMIC_RELAXED, __HIP_MEMORY_SCOPE_AGENT));
            S[row] = rsqrtf(t * (1.f / D) + 1e-6f); }
        asm volatile("s_waitcnt lgkmcnt(0)" ::: "memory"); __builtin_amdgcn_s_barrier(); asm volatile("" ::: "memory");
        if (FUSE == 2) {
            float* ob = slab + (size_t)row0 * D + col0;
#pragma unroll
            for (int bj = 0; bj < 2; ++bj) { const f32x4 G0 = *(const f32x4*)(ng + col0 + bj * HALF), G1 = *(const f32x4*)(ng + col0 + bj * HALF + 4);
#pragma unroll
                for (int ai = 0; ai < 2; ++ai)
#pragma unroll
                    for (int m = 0; m < 4; ++m) { const float rstd = S[ai * HALF + wr * 64 + m * 16 + fr];
                        *(f32x4*)(ob + (size_t)(ai * HALF + m * 16) * D + bj * HALF) = acc[ai][bj][m][0] * rstd * G0; *(f32x4*)(ob + (size_t)(ai * HALF + m * 16) * D + bj * HALF + 4) = acc[ai][bj][m][1] * rstd * G1; } }
            return;
        }
        bf16_t* XN = (bf16_t*)((char*)X + RN_DXN);
        const float* sh = mods_l + nsh_off + (size_t)mi * MODW + col0;
#pragma unroll
        for (int bj = 0; bj < 2; ++bj) { f32x4 GG[2], SS[2];
#pragma unroll
            for (int n = 0; n < 2; ++n) { GG[n] = *(const f32x4*)(ng + col0 + bj * HALF + 4 * n) * (*(const f32x4*)(sh + D + bj * HALF + 4 * n) + 1.f); SS[n] = *(const f32x4*)(sh + bj * HALF + 4 * n); }
#pragma unroll
            for (int ai = 0; ai < 2; ++ai)
#pragma unroll
                for (int m = 0; m < 4; ++m) { const float rstd = S[ai * HALF + wr * 64 + m * 16 + fr];
                    const f32x4 h0 = acc[ai][bj][m][0] * rstd * GG[0] + SS[0], h1 = acc[ai][bj][m][1] * rstd * GG[1] + SS[1];
                    u32x4 w; w.x = cvt_pk_bf16(h0[0], h0[1]); w.y = cvt_pk_bf16(h0[2], h0[3]); w.z = cvt_pk_bf16(h1[0], h1[1]); w.w = cvt_pk_bf16(h1[2], h1[3]);
                    *(u32x4*)(XN + (size_t)(row0 + ai * HALF + m * 16) * D + col0 + bj * HALF) = w; } }
    }
    __device__ __forceinline__ void operator()(f32x4 (&acc)[2][2][4][2], const Unit& u, int wr, int wc, int fr, int fq) const {
        if (u.sw) {
            bf16_t* base = (bf16_t*)slab + (size_t)(((u.pm - 32) * 8 + u.pn) * 8 + u.ks) * 65536 + (size_t)(wr * 64 + fr) * 256 + wc * 32 + 8 * fq;
#pragma unroll
            for (int ai = 0; ai < 2; ++ai)
#pragma unroll
                for (int m = 0; m < 4; ++m)
#pragma unroll
                    for (int bj = 0; bj < 2; ++bj) { const f32x4 v0 = acc[ai][bj][m][0], v1 = acc[ai][bj][m][1];
                        u32x4 w; w.x = cvt_pk_bf16(v0[0], v0[1]); w.y = cvt_pk_bf16(v0[2], v0[3]); w.z = cvt_pk_bf16(v1[0], v1[1]); w.w = cvt_pk_bf16(v1[2], v1[3]);
                        *(u32x4*)(base + (size_t)(ai * HALF + m * 16) * 256 + bj * HALF) = w; }
            return;
        }
        const int row0 = u.pm * BM + wr * 64 + fr, col0 = u.pn * BM + wc * 32 + 8 * fq;
        const int mi = u.pm < 32 ? (u.pm >> 3) : 4;
        const float* gt = mods_l + (size_t)mi * MODW + gidx * D + col0;
        f32x4 gv[2][2];
#pragma unroll
        for (int bj = 0; bj < 2; ++bj)
#pragma unroll
            for (int n = 0; n < 2; ++n) gv[bj][n] = *(const f32x4*)(gt + bj * HALF + 4 * n);
        float ssq[2][4];
#pragma unroll
        for (int ai = 0; ai < 2; ++ai)
#pragma unroll
            for (int m = 0; m < 4; ++m) ssq[ai][m] = 0.f;
        if (XF32) {
#pragma unroll
            for (int am = 0; am < 4; ++am) { const int ai = am >> 1, m0 = (am & 1) * 2;
                f32x4 xf[2][2][2];
#pragma unroll
                for (int mm = 0; mm < 2; ++mm)
#pragma unroll
                    for (int bj = 0; bj < 2; ++bj)
#pragma unroll
                        for (int n = 0; n < 2; ++n) xf[mm][bj][n] = *(const f32x4*)(xin + (size_t)(row0 + ai * HALF + (m0 + mm) * 16) * D + col0 + bj * HALF + 4 * n);
                __builtin_amdgcn_sched_barrier(0);
#pragma unroll
                for (int mm = 0; mm < 2; ++mm)
#pragma unroll
                    for (int bj = 0; bj < 2; ++bj) { const f32x4 v0 = xf[mm][bj][0] + gv[bj][0] * acc[ai][bj][m0 + mm][0], v1 = xf[mm][bj][1] + gv[bj][1] * acc[ai][bj][m0 + mm][1];
                        if (FUSE) { acc[ai][bj][m0 + mm][0] = v0; acc[ai][bj][m0 + mm][1] = v1; ssq[ai][m0 + mm] += ((v0[0] * v0[0] + v0[1] * v0[1]) + (v0[2] * v0[2] + v0[3] * v0[3])) + ((v1[0] * v1[0] + v1[1] * v1[1]) + (v1[2] * v1[2] + v1[3] * v1[3])); }
                        u32x4 w; w.x = cvt_pk_bf16(v0[0], v0[1]); w.y = cvt_pk_bf16(v0[2], v0[3]); w.z = cvt_pk_bf16(v1[0], v1[1]); w.w = cvt_pk_bf16(v1[2], v1[3]);
                        *(u32x4*)(X + (size_t)(row0 + ai * HALF + (m0 + mm) * 16) * D + col0 + bj * HALF) = w; }
                __builtin_amdgcn_sched_barrier(0);
            }
            if (FUSE) fuse_tail(acc, ssq, u, wr, wc, fr, fq, mi, row0, col0);
            return;
        }
#pragma unroll
        for (int ai = 0; ai < 2; ++ai) {
            u32x4 xo[4][2];
#pragma unroll
            for (int m = 0; m < 4; ++m)
#pragma unroll
                for (int bj = 0; bj < 2; ++bj) xo[m][bj] = *(const u32x4*)(X + (size_t)(row0 + ai * HALF + m * 16) * D + col0 + bj * HALF);
            __builtin_amdgcn_sched_barrier(0);
#pragma unroll
            for (int m = 0; m < 4; ++m)
#pragma unroll
                for (int bj = 0; bj < 2; ++bj) { const u32x4 x = xo[m][bj];
                    const f32x4 x0 = {bf_lo(x.x), bf_hi(x.x), bf_lo(x.y), bf_hi(x.y)}, x1 = {bf_lo(x.z), bf_hi(x.z), bf_lo(x.w), bf_hi(x.w)};
                    const f32x4 v0 = x0 + gv[bj][0] * acc[ai][bj][m][0], v1 = x1 + gv[bj][1] * acc[ai][bj][m][1];
                    if (FUSE) { acc[ai][bj][m][0] = v0; acc[ai][bj][m][1] = v1; ssq[ai][m] += ((v0[0] * v0[0] + v0[1] * v0[1]) + (v0[2] * v0[2] + v0[3] * v0[3])) + ((v1[0] * v1[0] + v1[1] * v1[1]) + (v1[2] * v1[2] + v1[3] * v1[3])); }
                    if (FUSE == 0) { u32x4 w; w.x = cvt_pk_bf16(v0[0], v0[1]); w.y = cvt_pk_bf16(v0[2], v0[3]); w.z = cvt_pk_bf16(v1[0], v1[1]); w.w = cvt_pk_bf16(v1[2], v1[3]);
                    *(u32x4*)(X + (size_t)(row0 + ai * HALF + m * 16) * D + col0 + bj * HALF) = w; } }
            __builtin_amdgcn_sched_barrier(0); asm volatile("" ::: "memory");
        }
        if (FUSE) fuse_tail(acc, ssq, u, wr, wc, fr, fq, mi, row0, col0);
    }
};
struct EpiQKV {
    static constexpr bool PERM = true;
    bf16_t* Q; bf16_t* KT; bf16_t* VT; float qscale;
    __device__ __forceinline__ void operator()(const f32x4 (&acc)[2][2][4][2], const Unit& u, int wr, int wc, int fr, int fq) const {
#pragma unroll
        for (int ai = 0; ai < 2; ++ai)
#pragma unroll
            for (int m = 0; m < 4; ++m)
#pragma unroll
                for (int bj = 0; bj < 2; ++bj) {
                    const int r = u.pm * BM + ai * HALF + wr * 64 + m * 16 + fr;
                    const int c = u.pn * BM + bj * HALF + wc * 32 + 8 * fq;
                    bf16_t* dst; float sc = 1.f;
                    if (!u.sw) {
                        if (u.pn < 8) { dst = Q + (size_t)r * D + c; sc = qscale; }
                        else { const int cc = c - D, h = cc >> 7, ch = (cc & 127) >> 3;
                            dst = KT + ((size_t)((r >> 3) * NH + h)) * 1024 + (ch >> 2) * 256 + ((r >> 2) & 1) * 128 + (r & 3) * 32 + (ch & 3) * 8; }
                    } else { const int h = r >> 7, d = r & 127;
                        dst = VT + ((size_t)(((c >> 3) * NH + h) * 8 + (d >> 4))) * 128 + (d & 15) * 8; }
                    const f32x4 v0 = acc[ai][bj][m][0] * sc, v1 = acc[ai][bj][m][1] * sc;
                    u32x4 w; w.x = cvt_pk_bf16(v0[0], v0[1]); w.y = cvt_pk_bf16(v0[2], v0[3]); w.z = cvt_pk_bf16(v1[0], v1[1]); w.w = cvt_pk_bf16(v1[2], v1[3]);
                    *(u32x4*)dst = w; }
    }
};
struct EpiGates {
    static constexpr bool PERM = true;
    const bf16_t* UC; unsigned* LB; const float* ba; const float* bx; const float* cA;
    __device__ __forceinline__ void operator()(const f32x4 (&acc)[2][2][4][2], const Unit& u, int wr, int wc, int fr, int fq) const {
        const int blk = u.pn >> 2, dir = (u.pn >> 1) & 1, half = u.pn & 1;
        const int row0 = u.pm * BM + wr * 64 + fr;
        unsigned* lb_d = LB + (size_t)dir * M * LW;
        const int ch0 = blk * 256 + half * 128 + wc * 32 + 8 * fq;
        unsigned pba[4], pbx[4], pca[4];
#pragma unroll
        for (int n = 0; n < 2; ++n) { const f32x4 t0 = *(const f32x4*)(ba + dir * LW + ch0 + 4 * n), t1 = *(const f32x4*)(bx + dir * LW + ch0 + 4 * n), t2 = *(const f32x4*)(cA + dir * LW + ch0 + 4 * n);
            pca[2 * n] = pk2(t2[0], t2[1]); pca[2 * n + 1] = pk2(t2[2], t2[3]);
            constexpr float NL = -1.4426950408889634f;
            pba[2 * n] = pk2(NL * t0[0], NL * t0[1]); pba[2 * n + 1] = pk2(NL * t0[2], NL * t0[3]); pbx[2 * n] = pk2(NL * t1[0], NL * t1[1]); pbx[2 * n + 1] = pk2(NL * t1[2], NL * t1[3]); }
        u32x4 ucw[2][2];
#define GATES_UCLOAD(buf, am_) do { _Pragma("unroll") for (int mm = 0; mm < 2; ++mm) ucw[buf][mm] = *(const u32x4*)(UC + (size_t)(row0 + ((am_) >> 1) * HALF + (((am_) & 1) * 2 + mm) * 16) * LW + ch0); } while (0)
        GATES_UCLOAD(0, 0);
#pragma unroll
        for (int am = 0; am < 4; ++am) { const int ai = am >> 1, m0 = (am & 1) * 2;
            if (am + 1 < 4) GATES_UCLOAD((am + 1) & 1, am + 1);
            __builtin_amdgcn_sched_barrier(0);
#pragma unroll
            for (int mm = 0; mm < 2; ++mm) { const int m = m0 + mm; const size_t ro = (size_t)(row0 + ai * HALF + m * 16) * LW + ch0;
                const unsigned uw[4] = {ucw[am & 1][mm].x, ucw[am & 1][mm].y, ucw[am & 1][mm].z, ucw[am & 1][mm].w};
                unsigned wv[8];
#pragma unroll
                for (int n = 0; n < 2; ++n) {
#pragma unroll
                    for (int j = 0; j < 4; ++j) { const int pi = 2 * n + (j >> 1);
                        const float ucv = (j & 1) ? bf_hi(uw[pi]) : bf_lo(uw[pi]), vb_a = (j & 1) ? bf_hi(pba[pi]) : bf_lo(pba[pi]), vb_x = (j & 1) ? bf_hi(pbx[pi]) : bf_lo(pbx[pi]);
                        const float rr = fast_rcp(1.f + fast_exp2(fmaf(acc[ai][0][m][n][j], -1.4426950408889634f, vb_a))), ig = fast_rcp(1.f + fast_exp2(fmaf(acc[ai][1][m][n][j], -1.4426950408889634f, vb_x)));
                        wv[4 * n + j] = cvt_pk_bf16(rr * ((j & 1) ? bf_hi(pca[pi]) : bf_lo(pca[pi])), ig * ucv); } }
                *(u32x4*)(lb_d + ro) = (u32x4){wv[0], wv[1], wv[2], wv[3]}; *(u32x4*)(lb_d + ro + 4) = (u32x4){wv[4], wv[5], wv[6], wv[7]}; }
            __builtin_amdgcn_sched_barrier(0);
        }
#undef GATES_UCLOAD
    }
};
}

#define XB_TMO      128
#define XB_XCNT(j)  (256  + 64 * (j))
#define XB_XSUB(j)  (1280 + 64 * (j))
#define XB_XGEN(j)  (2304 + 64 * (j))
#define XB_TOP      3328
#define XB_TOPGEN   3392
#define XCD_BAR_WORDS 3456
#define XB_SPIN_CAP (1u << 18)
__device__ __forceinline__ unsigned xb_ld(unsigned* p)              { return __hip_atomic_load(p, __ATOMIC_RELAXED, __HIP_MEMORY_SCOPE_AGENT); }
__device__ __forceinline__ unsigned xb_add(unsigned* p, unsigned v) { return __hip_atomic_fetch_add(p, v, __ATOMIC_RELAXED, __HIP_MEMORY_SCOPE_AGENT); }
__device__ __forceinline__ unsigned xb_xcc_id() { return (unsigned)__builtin_amdgcn_s_getreg((3 << 11) | 20) & 0xFu; }
#define XB_SPIN(cond, bar) do { unsigned _sp = 0; while (cond) { __builtin_amdgcn_s_sleep(1); \
    if ((++_sp & 255u) == 0u) { if (xb_ld(&(bar)[XB_TMO])) break; if (_sp > XB_SPIN_CAP) { atomicAdd(&(bar)[XB_TMO], 1u); break; } } } } while (0)
struct XcdBarrier { unsigned* bar; unsigned x; volatile LAS unsigned* st; };
__device__ __forceinline__ XcdBarrier xcd_barrier_post(unsigned* bar, volatile LAS unsigned* st) {
    XcdBarrier b; b.bar = bar; b.x = xb_xcc_id(); b.st = st;
    if (threadIdx.x == 0) (void)xb_add(&bar[XB_XCNT(b.x)], 1u);
    return b;
}
__device__ __forceinline__ void xcd_barrier_complete(unsigned* bar, unsigned x, unsigned& nloc, unsigned& nx) {
    const unsigned G = gridDim.x * gridDim.y * gridDim.z;
    unsigned sum, cnt, mine, sp = 0u;
    for (;;) {
        sum = 0u; cnt = 0u; mine = 0u;
#pragma unroll
        for (unsigned j = 0; j < 16; ++j) { const unsigned c = xb_ld(&bar[XB_XCNT(j)]); sum += c; cnt += (c > 0u) ? 1u : 0u; mine = (j == x) ? c : mine; }
        if (sum == G) break;
        __builtin_amdgcn_s_sleep(1);
        if ((++sp & 255u) == 0u) { if (xb_ld(&bar[XB_TMO])) break; if (sp > XB_SPIN_CAP) { atomicAdd(&bar[XB_TMO], 1u); break; } }
    }
    nloc = mine > 0u ? mine : 1u; nx = cnt > 0u ? cnt : 1u;
}
__device__ __forceinline__ void xcd_barrier(const XcdBarrier& b) {
    asm volatile("s_waitcnt vmcnt(0)" ::: "memory");
    __syncthreads();
    if (threadIdx.x == 0) {
        unsigned* bar = b.bar;
        __builtin_amdgcn_s_waitcnt(0);
        unsigned nloc = b.st[0], nx = b.st[1];
        if (nloc == 0u) { xcd_barrier_complete(bar, b.x, nloc, nx); b.st[0] = nloc; b.st[1] = nx; }
        const unsigned old = xb_add(&bar[XB_XSUB(b.x)], 1u);
        const unsigned gen = old / nloc;
        if (old + 1u == (gen + 1u) * nloc) {
            __builtin_amdgcn_fence(__ATOMIC_RELEASE, "agent");
            asm volatile("s_waitcnt vmcnt(0)" ::: "memory");
            const unsigned og = xb_add(&bar[XB_TOP], 1u);
            const unsigned tg = og / nx;
            if (og + 1u == (tg + 1u) * nx) xb_add(&bar[XB_TOPGEN], 1u);
            else XB_SPIN(xb_ld(&bar[XB_TOPGEN]) == tg, bar);
            __builtin_amdgcn_fence(__ATOMIC_ACQUIRE, "agent");
            xb_add(&bar[XB_XGEN(b.x)], 1u);
            asm volatile("s_waitcnt vmcnt(0)" ::: "memory");
        } else {
            XB_SPIN(xb_ld(&bar[XB_XGEN(b.x)]) == gen, bar);
            __builtin_amdgcn_fence(__ATOMIC_ACQUIRE, "agent");
            asm volatile("s_waitcnt vmcnt(0)" ::: "memory");
        }
    }
    __syncthreads();
}

constexpr size_t MiB = 1u << 20;
constexpr size_t WS_CTL = 0, CTL_ZERO_BYTES = 1 * MiB;
constexpr size_t WS_MODS = 1 * MiB;
constexpr size_t WS_WIN = 2 * MiB;
constexpr size_t WS_WG = 46 * MiB;
constexpr size_t WS_WOUT = 57 * MiB;
constexpr size_t WS_WQKV = 79 * MiB;
constexpr size_t WS_WO = 127 * MiB;
constexpr size_t WS_W1 = 143 * MiB;
constexpr size_t WS_W2 = 271 * MiB;
constexpr size_t WS_X = 399 * MiB;
constexpr size_t WS_XN = 471 * MiB;
constexpr size_t WS_BIG = 507 * MiB;
constexpr size_t WS_O = 651 * MiB;
constexpr size_t WS_CA = 687 * MiB;
constexpr size_t WS_UC = 688 * MiB;
constexpr size_t WS_LA = 738 * MiB;
constexpr size_t WS_BB = 838 * MiB;
constexpr size_t WS_Z = 938 * MiB;
constexpr size_t WS_AGGA = 988 * MiB, WS_AGGH = 995 * MiB, WS_CARRY = 1002 * MiB;
constexpr size_t WS_SLAB = 1009 * MiB;
constexpr size_t WS_FAST_END = 1073 * MiB;
constexpr size_t WS_NV = 688 * MiB;
static_assert((long long)WS_XN - (long long)WS_X == pg8::RN_DXN && (long long)WS_BB - (long long)WS_X == pg8::RN_DSLOT && (long long)WS_CTL + 131072 - (long long)WS_X == pg8::RN_DCNT && CTL_ZERO_BYTES >= 131072 + 32 * 256, "fused-norm exchange: slots (256 KiB at WS_BB, otherwise unused), panel counters in CTL");
constexpr int CW_BAR = 4096;
constexpr int CW_SPLIT = 16384;

constexpr int NWAVES = 8, NTHREADS = 512;
constexpr int LDS_BYTES = 147456;
constexpr int LDS_MISC = 131072;
constexpr int PH_PROLOGUE = 0, PH_NORM0 = 1, PH_LAYER0 = 2, PH_PER_LAYER = 12, PH_END = PH_LAYER0 + PH_PER_LAYER * DEPTH;

struct Args {
    const float* in[23]; float* out; unsigned char* ws; int ph_lo, ph_hi;
};

__device__ __forceinline__ float wave_sum(float v) {
#pragma unroll
    for (int o = 1; o < 64; o <<= 1) v += __shfl_xor(v, o);
    return v;
}
__device__ __forceinline__ void transpose_item(const float* W, int K, int N, bf16_t* WT, int k0, int n0, int dst_row0, int lane) {
    const int kb = lane & 7, nl = lane >> 3;
    const float* src = W + (size_t)(k0 + 8 * kb) * N + n0 + 4 * nl;
    f32x4 v[8];
#pragma unroll
    for (int i = 0; i < 8; ++i) v[i] = __builtin_nontemporal_load((const f32x4*)(src + (size_t)i * N));
    bf16_t* dst = WT + (size_t)(dst_row0 + 4 * nl) * K + k0 + 8 * kb;
#pragma unroll
    for (int j = 0; j < 4; ++j) { u32x4 o; o.x = pk2(v[0][j], v[1][j]); o.y = pk2(v[2][j], v[3][j]); o.z = pk2(v[4][j], v[5][j]); o.w = pk2(v[6][j], v[7][j]);
        *(u32x4*)(dst + (size_t)j * K) = o; }
}
__device__ __forceinline__ void transpose_group(int r, const float* src, int K, int N, bf16_t* dst, int lane) {
    const int nblk = N / 32, per = (K / 64) * nblk; const int mat = r / per, q = r % per, kb = q / nblk, nb = q % nblk;
    transpose_item(src + (size_t)mat * K * N, K, N, dst + (size_t)mat * N * K, 64 * kb, 32 * nb, 32 * nb, lane);
}


__device__ __forceinline__ unsigned char* tabp(volatile LAS unsigned* ptab, int i) {
    unsigned base = (unsigned)(size_t)ptab; asm volatile("" : "+v"(base));
    const u32x2 w = *(volatile LAS u32x2*)(base + 8u * (unsigned)i);
    return (unsigned char*)(GAS unsigned char*)(((unsigned long long)(unsigned)__builtin_amdgcn_readfirstlane((int)w.y) << 32) | (unsigned)__builtin_amdgcn_readfirstlane((int)w.x));
}
constexpr int C_W = (D / 64) * (FF / 32), C_IN = (D / 64) * (2 * LW / 32), C_OUT = (LW / 64) * (D / 32), C_QKV = (D / 64) * (3 * D / 32), C_O = (D / 64) * (D / 32), C_G = 2 * NLB * 2 * 32;
struct ConvAddr { const float* src; bf16_t* dst; int N, K; };
__device__ __forceinline__ ConvAddr conv_addr(volatile LAS unsigned* ptab, int kind, int l, int r, int lane) {
    unsigned char* ws = tabp(ptab, 24); const int kbl = lane & 7, nl = lane >> 3; ConvAddr a;
    if (kind == 6) { const int matl = r >> 5, q = r & 31, kb = q >> 3, nb = q & 7;
        const int gsel = matl & 1, db = matl >> 1, blk = db % NLB, d = db / NLB;
        const float* s0 = (const float*)tabp(ptab, gsel ? 16 : 14) + (size_t)((l * 2 + d) * NLB + blk) * LB * LB;
        const int n0 = 32 * nb, half = n0 >> 7, chn = n0 & 127, drow = blk * 1024 + ((d * 2 + half) * 2 + gsel) * 128 + chn;
        a.N = LB; a.K = LB; a.src = s0 + (size_t)(64 * kb + 8 * kbl) * LB + n0 + 4 * nl;
        a.dst = (bf16_t*)(ws + WS_WG) + (size_t)l * (NLB * 1024) * LB + (size_t)(drow + 4 * nl) * LB + 64 * kb + 8 * kbl;
        return a; }
    int K, N, inp; size_t wso;
    switch (kind) { case 0: K = D; N = FF; inp = 8; wso = WS_W1; break; case 1: K = FF; N = D; inp = 9; wso = WS_W2; break; case 2: K = D; N = 2 * LW; inp = 10; wso = WS_WIN; break;
                    case 3: K = LW; N = D; inp = 18; wso = WS_WOUT; break; case 4: K = D; N = 3 * D; inp = 19; wso = WS_WQKV; break; default: K = D; N = D; inp = 21; wso = WS_WO; break; }
    const int nblk = N / 32, kb = r / nblk, nb = r % nblk;
    a.N = N; a.K = K; a.src = (const float*)tabp(ptab, inp) + (size_t)l * K * N + (size_t)(64 * kb + 8 * kbl) * N + 32 * nb + 4 * nl;
    a.dst = (bf16_t*)(ws + wso) + (size_t)l * N * K + (size_t)(32 * nb + 4 * nl) * K + 64 * kb + 8 * kbl;
    return a;
}
__device__ __forceinline__ void conv_load(const ConvAddr& a, f32x4 (&v)[8]) {
#pragma unroll
    for (int i = 0; i < 8; ++i) v[i] = __builtin_nontemporal_load((const f32x4*)(a.src + (size_t)i * a.N));
}
__device__ __forceinline__ void conv_store(const ConvAddr& a, const f32x4 (&v)[8]) {
#pragma unroll
    for (int j = 0; j < 4; ++j) { u32x4 o; o.x = pk2(v[0][j], v[1][j]); o.y = pk2(v[2][j], v[3][j]); o.z = pk2(v[4][j], v[5][j]); o.w = pk2(v[6][j], v[7][j]);
        *(u32x4*)(a.dst + (size_t)j * a.K) = o; }
}
#define CSEG(kind, l, cnt) if (!fnd_ && r < (cnt)) { ck_ = (kind); cl_ = (l); fnd_ = true; } else if (!fnd_) r -= (cnt)
#define CSEGO(kind, l, off, cnt) if (!fnd_ && r < (cnt)) { ck_ = (kind); cl_ = (l); r += (off); fnd_ = true; } else if (!fnd_) r -= (cnt)
#define CONV_RUN(it0, st, nit, SEGS) do { for (int it_ = (it0); it_ < (nit); it_ += 2 * (st)) { ConvAddr ca_, cb_; f32x4 va_[8], vb_[8]; const bool two_ = it_ + (st) < (nit); \
        { int r = it_, ck_ = 0, cl_ = 0; bool fnd_ = false; SEGS; ca_ = conv_addr(ptab, ck_, cl_, r, lane); } conv_load(ca_, va_); \
        { int r = two_ ? it_ + (st) : it_, ck_ = 0, cl_ = 0; bool fnd_ = false; SEGS; cb_ = conv_addr(ptab, ck_, cl_, r, lane); } conv_load(cb_, vb_); \
        __builtin_amdgcn_sched_barrier(0); conv_store(ca_, va_); if (two_) conv_store(cb_, vb_); } } while (0)
__device__ __forceinline__ void ada_fill_ssil(volatile LAS unsigned* ptab, LAS unsigned char* lds, int tid) {
    const float* c = (const float*)tabp(ptab, 1); const float* c_ctx = (const float*)tabp(ptab, 3); LAS float* ssil = (LAS float*)lds;
    for (int i = tid; i < 5 * D; i += NTHREADS) { const int m = i / D, k = i % D; const float v = m < 4 ? c[m * D + k] : c_ctx[k]; ssil[i] = v / (1.f + expf(-v)); }
    __syncthreads();
}
constexpr int ADA_IT = 96;
__device__ __forceinline__ void ada_wg_item(volatile LAS unsigned* ptab, LAS unsigned char* lds, int it, int tid) {
    int lane = tid & 63; asm volatile("" : "+v"(lane)); const int wave = __builtin_amdgcn_readfirstlane(tid >> 6);
    const float* ada_w = (const float*)tabp(ptab, 4); const float* ada_b = (const float*)tabp(ptab, 5); float* mods = (float*)(tabp(ptab, 24) + WS_MODS);
    LAS float* ssil = (LAS float*)lds; LAS float* red = (LAS float*)(lds + 40960);
    const int layer = it / ADA_IT, col0 = (it % ADA_IT) * 128;
    const int kr = lane >> 5, c4 = lane & 31;
    const float* W = ada_w + ((size_t)layer * D + wave * 256 + 16 * kr) * MODW + col0 + 4 * c4;
    f32x4 a0 = {0.f, 0.f, 0.f, 0.f}, a1 = a0, a2 = a0, a3 = a0, a4 = a0;
    const LAS float* sp = ssil + wave * 256 + 16 * kr;
    for (int k = 0; k < 256; k += 32) {
        f32x4 wv[16];
#pragma unroll
        for (int kk = 0; kk < 16; ++kk) wv[kk] = __builtin_nontemporal_load((const f32x4*)(W + (size_t)(k + kk) * MODW));
#pragma unroll
        for (int hh = 0; hh < 4; ++hh) { const int k4 = k + 4 * hh;
            const f32x4 s0 = *(const LAS f32x4*)(sp + k4), s1 = *(const LAS f32x4*)(sp + D + k4), s2 = *(const LAS f32x4*)(sp + 2 * D + k4), s3 = *(const LAS f32x4*)(sp + 3 * D + k4), s4 = *(const LAS f32x4*)(sp + 4 * D + k4);
#pragma unroll
            for (int kk = 0; kk < 4; ++kk) { const f32x4 w4 = wv[4 * hh + kk]; a0 += w4 * s0[kk]; a1 += w4 * s1[kk]; a2 += w4 * s2[kk]; a3 += w4 * s3[kk]; a4 += w4 * s4[kk]; } }
    }
    { LAS f32x4* rw = (LAS f32x4*)(red + (wave * 2 + kr) * 5 * 128) + c4;
      rw[0] = a0; rw[32] = a1; rw[64] = a2; rw[96] = a3; rw[128] = a4; }
    __syncthreads();
    for (int i = tid; i < 5 * 128; i += NTHREADS) { const int m = i >> 7, l = i & 127; float s = 0.f;
#pragma unroll
        for (int w2 = 0; w2 < 16; ++w2) s += red[w2 * 5 * 128 + m * 128 + l];
        mods[((size_t)layer * 5 + m) * MODW + col0 + l] = s + ada_b[(size_t)layer * MODW + col0 + l]; }
    __syncthreads();
}

#define FILLER(U, ADA_FIRST, NIT, SEGS) do { int Gl = G; asm volatile("" : "+s"(Gl)); const int nfull = (U) % Gl; \
    if (nfull == 0 || bxp >= nfull) { const int rank = nfull ? bxp - nfull : bxp, nidle = nfull ? Gl - nfull : Gl, nada = ((ADA_FIRST) >= 0 && nidle > ADA_IT) ? ADA_IT : 0; \
        int tid = threadIdx.x; asm volatile("" : "+v"(tid)); const int lane = tid & 63, wave = __builtin_amdgcn_readfirstlane(tid >> 6); \
        if ((ADA_FIRST) >= 0 && nada == 0) { ada_fill_ssil(ptab, lds, tid); for (int it_ = rank; it_ < ADA_IT; it_ += nidle) ada_wg_item(ptab, lds, (ADA_FIRST) + it_, tid); }     \
        if (rank < nada) { ada_fill_ssil(ptab, lds, tid); ada_wg_item(ptab, lds, (ADA_FIRST) + rank, tid); } \
        else CONV_RUN((rank - nada) * NWAVES + wave, (nidle - nada) * NWAVES, NIT, SEGS); } } while (0)

#define FILLER2(K, ADA_FIRST, NIT, SEGS) do { int Gl = G; asm volatile("" : "+s"(Gl)); const int cc_ = __builtin_amdgcn_readfirstlane(*(volatile const LAS int*)(lds + pg8::CC_TAB_OFF + 4 * (K))); \
    if (cc_ >= Gl || bxp >= cc_) { const int rank = cc_ >= Gl ? bxp : bxp - cc_, nidle = cc_ >= Gl ? Gl : Gl - cc_; \
        int tid = threadIdx.x; asm volatile("" : "+v"(tid)); const int lane = tid & 63, wave = __builtin_amdgcn_readfirstlane(tid >> 6); \
        if ((ADA_FIRST) >= 0) { ada_fill_ssil(ptab, lds, tid); for (int it_ = rank; it_ < ADA_IT; it_ += nidle) ada_wg_item(ptab, lds, (ADA_FIRST) + it_, tid); } \
        CONV_RUN(rank * NWAVES + wave, nidle * NWAVES, NIT, SEGS); } } while (0)

__device__ __forceinline__ void norm_load(const float* xrow, f32x4 (&v)[8], int lane) {
    const f32x4* xr = (const f32x4*)xrow + lane;
#pragma unroll
    for (int j = 0; j < 8; ++j) v[j] = xr[64 * j];
}
__device__ __forceinline__ void norm_load(const bf16_t* xrow, f32x4 (&v)[8], int lane) {
    const u32x2* xr = (const u32x2*)xrow + lane; u32x2 r[8];
#pragma unroll
    for (int j = 0; j < 8; ++j) r[j] = xr[64 * j];
#pragma unroll
    for (int j = 0; j < 8; ++j) v[j] = (f32x4){bf_lo(r[j].x), bf_hi(r[j].x), bf_lo(r[j].y), bf_hi(r[j].y)};
}
template <int MODE>
__device__ __forceinline__ void norm_vecs(const float* g, const float* sh, const float* sc, f32x4 (&GG)[8], f32x4 (&SS)[8], int lane) {
#pragma unroll
    for (int j = 0; j < 8; ++j) { GG[j] = ((const f32x4*)g)[lane + 64 * j];
        if (MODE == 0) { GG[j] = GG[j] * (((const f32x4*)sc)[lane + 64 * j] + 1.f); SS[j] = ((const f32x4*)sh)[lane + 64 * j]; } }
}
template <int MODE>
__device__ __forceinline__ void norm_apply(f32x4 (&v)[8], bf16_t* xcopy, const f32x4 (&GG)[8], const f32x4 (&SS)[8], bf16_t* obf, float* of32, int lane, const float* slabrow = nullptr, const float* gate = nullptr) {
    float ss = 0.f;
    if (slabrow) {
#pragma unroll
        for (int jh = 0; jh < 2; ++jh) { u32x2 p[4][8];
#pragma unroll
            for (int jj = 0; jj < 4; ++jj) { const int j = jh * 4 + jj; const u32x2* sp = (const u32x2*)((const bf16_t*)slabrow + (size_t)j * 8 * 65536) + lane;
#pragma unroll
                for (int s = 0; s < 8; ++s) p[jj][s] = sp[(size_t)s * 16384]; }
            __builtin_amdgcn_sched_barrier(0);
#pragma unroll
            for (int jj = 0; jj < 4; ++jj) { const int j = jh * 4 + jj; const f32x4 gt = ((const f32x4*)gate)[lane + 64 * j];
                f32x4 a = {bf_lo(p[jj][0].x), bf_hi(p[jj][0].x), bf_lo(p[jj][0].y), bf_hi(p[jj][0].y)};
#pragma unroll
                for (int s = 1; s < 8; ++s) a += (f32x4){bf_lo(p[jj][s].x), bf_hi(p[jj][s].x), bf_lo(p[jj][s].y), bf_hi(p[jj][s].y)};
                v[j] += gt * a; }
            __builtin_amdgcn_sched_barrier(0); } }
#pragma unroll
    for (int j = 0; j < 8; ++j) ss += (v[j].x * v[j].x + v[j].y * v[j].y) + (v[j].z * v[j].z + v[j].w * v[j].w);
    const float rstd = rsqrtf(wave_sum(ss) * (1.f / D) + 1e-6f);
    if (xcopy) {
#pragma unroll
        for (int j = 0; j < 8; ++j) { u32x2 w; w.x = pk2(v[j].x, v[j].y); w.y = pk2(v[j].z, v[j].w); ((u32x2*)xcopy)[lane + 64 * j] = w; } }
#pragma unroll
    for (int j = 0; j < 8; ++j) { const int c4 = lane + 64 * j;
        f32x4 h = v[j] * rstd * GG[j];
        if (MODE == 0) { h = h + SS[j]; u32x2 w; w.x = pk2(h.x, h.y); w.y = pk2(h.z, h.w); ((u32x2*)obf)[c4] = w; }
        else ((f32x4*)of32)[c4] = h; }
}
#define NORM_LATENT(VECS, ROWSRC, APPLY) do { const int rpw_ = (ML + NGW - 1) / NGW; const int r0_ = gw * rpw_, r1_ = (r0_ + rpw_ < ML) ? r0_ + rpw_ : ML; \
    if (r0_ < r1_) { f32x4 GG[8], SS[8], vA[8], vB[8]; int mc_ = r0_ / SEQ; VECS(mc_); norm_load(ROWSRC(r0_), vA, lane); \
        for (int r_ = r0_; r_ < r1_; r_ += 2) { \
            { const int rn_ = (r_ + 1 < r1_) ? r_ + 1 : r_; norm_load(ROWSRC(rn_), vB, lane); } \
            if (r_ / SEQ != mc_) { mc_ = r_ / SEQ; VECS(mc_); } \
            APPLY(vA, r_); \
            if (r_ + 1 < r1_) { { const int rn_ = (r_ + 2 < r1_) ? r_ + 2 : r_ + 1; norm_load(ROWSRC(rn_), vA, lane); } \
                if ((r_ + 1) / SEQ != mc_) { mc_ = (r_ + 1) / SEQ; VECS(mc_); } \
                APPLY(vB, r_ + 1); } } } } while (0)

template <bool LOCAL>
__device__ __forceinline__ void attn_unit(const bf16_t* Q, const bf16_t* KT, const bf16_t* VT, bf16_t* O, LAS unsigned char* lds, int b, int h, int r, int w, int tq, int lane) {
    const int g = lane >> 4, q = lane & 15;
    const int qrow = LOCAL ? (b * SEQ + r * GRID_W + 16 * w + q) : (ML + b * CTX + 16 * tq + q);
    bf16x8 bq[4];
    { const bf16_t* qp = Q + (size_t)qrow * D + h * HD + 8 * g;
#pragma unroll
      for (int ks = 0; ks < 4; ++ks) bq[ks] = *(const bf16x8*)(qp + 32 * ks); }
    constexpr int NP = LOCAL ? 16 : 8, CP = LOCAL ? 8 : 0;
    f32x4 s[2 * NP];
    int rs = 0, ws = 0;
    if (LOCAL) { rs = r - 4; rs = rs < 0 ? 0 : (rs > 24 ? 24 : rs); ws = 16 * w - 8; ws = ws < 0 ? 0 : (ws > 32 ? 32 : ws); }
    const int rgl = b * SEQ + rs * GRID_W + ws;
    if (LOCAL) {
        const bf16_t* kloc = KT + ((size_t)(((rgl >> 3) + (q >> 2)) * NH + h)) * 1024 + (q & 3) * 32 + g * 8;
        bf16x8 ka[2][8];
#define ATT_KLOAD(buf, p) do { const bf16_t* kp_ = kloc + (size_t)((p) * 8 * NH) * 1024; \
        _Pragma("unroll") for (int f = 0; f < 2; ++f) _Pragma("unroll") for (int ks = 0; ks < 4; ++ks) ka[buf][f * 4 + ks] = *(const bf16x8*)(kp_ + f * 128 + ks * 256); } while (0)
        ATT_KLOAD(0, 0);
#pragma unroll
        for (int p = 0; p < 8; ++p) {
            __builtin_amdgcn_s_barrier();
            if (p + 1 < 8) ATT_KLOAD((p + 1) & 1, p + 1);
            __builtin_amdgcn_sched_barrier(0);
#pragma unroll
            for (int f = 0; f < 2; ++f) { f32x4 a = {0.f, 0.f, 0.f, 0.f};
#pragma unroll
                for (int ks = 0; ks < 4; ++ks) a = __builtin_amdgcn_mfma_f32_16x16x32_bf16(ka[p & 1][f * 4 + ks], bq[ks], a, 0, 0, 0);
                s[2 * p + f] = a; }
            __builtin_amdgcn_sched_barrier(0);
        }
#undef ATT_KLOAD
    }
    {
        const LAS unsigned char* kl = lds + (q >> 2) * 2048 + (((q & 3) * 4 + g) ^ ((q >> 2) & 2)) * 16;
#pragma unroll
        for (int p = 0; p < 8; ++p)
#pragma unroll
            for (int f = 0; f < 2; ++f) { f32x4 a = {0.f, 0.f, 0.f, 0.f};
#pragma unroll
                for (int ks = 0; ks < 4; ++ks) a = __builtin_amdgcn_mfma_f32_16x16x32_bf16(*(const LAS bf16x8*)(kl + p * 8192 + ks * 512 + f * 256), bq[ks], a, 0, 0, 0);
                s[2 * (CP + p) + f] = a; }
    }
    if (LOCAL) {
        const int c = 16 * w + q; int cs = c - 8; cs = cs < 0 ? 0 : (cs > 48 ? 48 : cs);
        const LAS float* rp = (const LAS float*)(lds + LDS_MISC + 1024);
#pragma unroll
        for (int p = 0; p < 8; ++p) { const int ro = (rs + p - r + 7) * 31;
#pragma unroll
            for (int f = 0; f < 2; ++f)
#pragma unroll
                for (int j = 0; j < 4; ++j) { const int kc = ws + 8 * g + 4 * f + j; const bool valid = (kc >= cs) && (kc < cs + 16);
                    int rel = kc - c + 15; rel = rel < 0 ? 0 : (rel > 30 ? 30 : rel);
                    const float bias = rp[ro + rel];
                    s[p * 2 + f][j] = valid ? s[p * 2 + f][j] + bias : -INFINITY; } }
    }
    float mx = -INFINITY;
#pragma unroll
    for (int i = 0; i < 2 * NP; ++i) mx = fmaxf(mx, fmaxf(fmaxf(s[i][0], s[i][1]), fmaxf(s[i][2], s[i][3])));
    mx = fmaxf(mx, __shfl_xor(mx, 16)); mx = fmaxf(mx, __shfl_xor(mx, 32));
    float sum = 0.f; const float mxl = mx * 1.4426950408889634f;
    bf16x8 pb[NP];
#pragma unroll
    for (int p = 0; p < NP; ++p) { float e[8];
#pragma unroll
        for (int f = 0; f < 2; ++f)
#pragma unroll
            for (int j = 0; j < 4; ++j) { e[4 * f + j] = fast_exp2(fmaf(s[2 * p + f][j], 1.4426950408889634f, -mxl)); sum += e[4 * f + j]; }
        u32x4 pw; pw.x = cvt_pk_bf16(e[0], e[1]); pw.y = cvt_pk_bf16(e[2], e[3]); pw.z = cvt_pk_bf16(e[4], e[5]); pw.w = cvt_pk_bf16(e[6], e[7]);
        pb[p] = __builtin_bit_cast(bf16x8, pw); }
    sum += __shfl_xor(sum, 16); sum += __shfl_xor(sum, 32);
    f32x4 o[8];
#pragma unroll
    for (int df = 0; df < 8; ++df) o[df] = (f32x4){0.f, 0.f, 0.f, 0.f};
    if (LOCAL) {
        const bf16_t* vloc = VT + ((size_t)(((rgl >> 3) + g) * NH + h)) * 1024 + q * 8;
        bf16x8 va[2][8];
#define ATT_VLOAD(buf, p) do { const bf16_t* vp_ = vloc + (size_t)((p) * 8 * NH) * 1024; \
        _Pragma("unroll") for (int df = 0; df < 8; ++df) va[buf][df] = *(const bf16x8*)(vp_ + df * 128); } while (0)
        ATT_VLOAD(0, 0);
#pragma unroll
        for (int p = 0; p < 8; ++p) {
            __builtin_amdgcn_s_barrier();
            if (p + 1 < 8) ATT_VLOAD((p + 1) & 1, p + 1);
            __builtin_amdgcn_sched_barrier(0);
#pragma unroll
            for (int df = 0; df < 8; ++df) o[df] = __builtin_amdgcn_mfma_f32_16x16x32_bf16(va[p & 1][df], pb[p], o[df], 0, 0, 0);
            __builtin_amdgcn_sched_barrier(0);
        }
#undef ATT_VLOAD
    }
    {
        const LAS unsigned char* vl = lds + 65536 + g * 2048 + q * 16;
#pragma unroll
        for (int p = 0; p < 8; ++p)
#pragma unroll
            for (int df = 0; df < 8; ++df) o[df] = __builtin_amdgcn_mfma_f32_16x16x32_bf16(*(const LAS bf16x8*)(vl + p * 8192 + df * 256), pb[CP + p], o[df], 0, 0, 0);
    }
    const float inv = 1.f / sum;
    bf16_t* op = O + (size_t)qrow * D + h * HD + 4 * g;
#pragma unroll
    for (int df = 0; df < 8; ++df) { u32x2 wv; wv.x = cvt_pk_bf16(o[df][0] * inv, o[df][1] * inv); wv.y = cvt_pk_bf16(o[df][2] * inv, o[df][3] * inv); *(u32x2*)(op + 16 * df) = wv; }
}

#define LRU_STEP(h, l, x) do { const float a_ = fast_exp2(l); h = fmaf(a_, h, __builtin_amdgcn_sqrtf(fmaxf(fmaf(-a_, a_, 1.f), 0.f)) * (x)); } while (0)
__global__ void __launch_bounds__(NTHREADS, 2) mega(Args args) {
    extern __shared__ __attribute__((aligned(16))) unsigned char lds_raw[];
    LAS unsigned char* lds = (LAS unsigned char*)lds_raw;
    const int G = gridDim.x; const int bx = blockIdx.x; const int vcu = ((G & 7) == 0) ? (bx & 7) * (G >> 3) + (bx >> 3) : bx;
    const int NGW = G * NWAVES;
    const int lo = args.ph_lo, hi = args.ph_hi;
    volatile LAS unsigned* ptab = (volatile LAS unsigned*)(lds + LDS_MISC + 64);
    { const int tid = threadIdx.x;
    for (int u = tid; u < (LDS_BYTES - LDS_MISC) / 4; u += NTHREADS) ((LAS unsigned*)(lds + LDS_MISC))[u] = 0u;
    __syncthreads();
    if (tid < 25) { const unsigned long long pv = tid < 23 ? (unsigned long long)args.in[tid] : (tid == 23 ? (unsigned long long)args.out : (unsigned long long)args.ws);
        ptab[2 * tid] = (unsigned)pv; ptab[2 * tid + 1] = (unsigned)(pv >> 32); }
    if (tid == 32) { volatile LAS int* cct = (volatile LAS int*)(lds + pg8::CC_TAB_OFF); static_assert(pg8::CC_TAB_OFF == LDS_MISC + 512, "cc table");
        cct[1] = pg8::gemm_cc(36 * (2 * LW / 256), G); cct[2] = pg8::gemm_cc(36 * (2 * D / 256) + (D / 256) * 36, G); cct[3] = pg8::gemm_cc(36 * NLB * 4, G); cct[4] = pg8::gemm_cc(36 * (FF / 256), G); }
    __syncthreads(); }
    unsigned char* const ws0 = args.ws;
    XcdBarrier bar; bar.bar = (unsigned*)(ws0 + WS_CTL) + CW_BAR; bar.x = 0; bar.st = nullptr;
    const bool multi = (hi - lo) > 1;
    if (multi) bar = xcd_barrier_post((unsigned*)(ws0 + WS_CTL) + CW_BAR, (volatile LAS unsigned*)(lds + LDS_MISC + 32));
    bool need_bar = false;
#define IN(k) (lo <= (k) && (k) < hi)
#define TABP(i) tabp(ptab, (i))
#define INP(i) ((const float*)TABP(i))
#define WSF(off) ((float*)(wsl + (off)))
#define WSB(off) ((bf16_t*)(wsl + (off)))
#define PHASE_BEGIN() if (need_bar) xcd_barrier(bar); need_bar = true; int tid = threadIdx.x; asm volatile("" : "+v"(tid)); const int lane = tid & 63, wave = __builtin_amdgcn_readfirstlane(tid >> 6), gw = vcu * NWAVES + wave; (void)lane; (void)gw; unsigned char* const wsl = TABP(24); (void)wsl; int bxp = bx; asm volatile("" : "+s"(bxp)); (void)bxp

    if (IN(PH_PROLOGUE)) {
        PHASE_BEGIN();
        for (int rep = 0; rep < REP_PRO; ++rep) {
        __syncthreads();
        ada_fill_ssil(ptab, lds, tid);
        constexpr int ADA0 = ADA_IT;
        { const float* lam = INP(13); float* CAw = WSF(WS_CA);
          for (int i = gw * 64 + lane; i < 2 * 2 * LW; i += NGW * 64) CAw[i] = -8.f * log1pf(expf(-lam[i])) * 1.4426950408889634f; }
        constexpr int NITEMS = C_IN;
#define SEGS_P CSEG(2, 0, C_IN)
        if (G > 2 * ADA0) { if (vcu < ADA0) ada_wg_item(ptab, lds, vcu, tid); else CONV_RUN((vcu - ADA0) * NWAVES + wave, (G - ADA0) * NWAVES, NITEMS, SEGS_P); }
        else { for (int it_ = vcu; it_ < ADA0; it_ += G) ada_wg_item(ptab, lds, it_, tid); CONV_RUN(vcu * NWAVES + wave, G * NWAVES, NITEMS, SEGS_P); }
#undef SEGS_P
        }
    }
    if (IN(PH_NORM0)) {
        PHASE_BEGIN();
        const float* x = INP(0); const float* ctx = INP(2); const float* norm1_g = INP(6); const float* mods = WSF(WS_MODS); bf16_t* X = WSB(WS_X); bf16_t* XN = WSB(WS_XN);
#define VECS0(m) norm_vecs<0>(norm1_g, mods + (size_t)(m) * MODW, mods + (size_t)(m) * MODW + D, GG, SS, lane)
#define SRC0(r) (x + (size_t)(r) * D)
#define APP0(v, r) norm_apply<0>(v, nullptr, GG, SS, XN + (size_t)(r) * D, nullptr, lane)
        for (int rep = 0; rep < REP_NORM; ++rep) {
            NORM_LATENT(VECS0, SRC0, APP0);
            { f32x4 GG[8], SS[8]; VECS0(4);
              for (int row = ML + gw; row < M; row += NGW) { f32x4 v[8]; norm_load(ctx + (size_t)(row - ML) * D, v, lane); norm_apply<0>(v, X + (size_t)row * D, GG, SS, XN + (size_t)row * D, nullptr, lane); } } }
#undef VECS0
#undef SRC0
#undef APP0
    }
    for (int L = 0; L < DEPTH; ++L) {
        const int base = PH_LAYER0 + PH_PER_LAYER * L; const bool lru = !(L & 1); const int j = L >> 1; const bool lastL = (L == DEPTH - 1);
        const int nMrows = lastL ? 32 : 36;
        if (IN(base + 0)) {
            if (threadIdx.x == 0 && lru) { const int U_ = 36 * (2 * LW / 256), R_ = (U_ + G - 1) / G + (L == 0 ? 1 : 0); int c_ = ((U_ + R_ - 1) / R_ + 7) & ~7; if ((G & 7) || c_ > G) c_ = G;
                ((volatile LAS int*)(lds + pg8::CC_TAB_OFF))[1] = c_; }
            PHASE_BEGIN();
            if (lru) {
                pg8::Gemm g{WSB(WS_XN), WSB(WS_WIN) + (size_t)j * (2 * LW) * D, D, D, D, -1, nullptr, nullptr, 0}; pg8::StaticOrder S; S.init(36, 2 * LW / 256, G, bxp);
                pg8::EpiAct<0> E{WSB(WS_BIG), 2 * LW};
                pg8::gemm_phase<pg8::EpiAct<0>, true, true, 1>(lds, g, S, E);
#define SEGS_A CSEG(6, 0, C_G); CSEG(3, 0, C_OUT); CSEG(0, 0, C_W); CSEG(1, 0, C_W); CSEG(4, 0, C_QKV); CSEG(5, 0, C_O); CSEG(0, 1, C_W)
#define SEGS_E CSEG(1, 2, C_W); CSEG(4, 1, C_QKV); CSEG(5, 1, C_O)
                if (L == 0) FILLER2(1, ADA_IT, C_G + C_OUT + 3 * C_W + C_QKV + C_O, SEGS_A);
                if (L == 2) FILLER2(1, -1, C_W + C_QKV + C_O, SEGS_E);
#undef SEGS_A
#undef SEGS_E
            } else {
                const bf16_t* wq = WSB(WS_WQKV) + (size_t)j * (3 * D) * D; const bf16_t* XN = WSB(WS_XN);
                pg8::Gemm g{XN, wq, D, D, D, -1, wq + (size_t)(2 * D) * D, XN, 0}; pg8::StaticOrder S; S.init(36, 2 * D / 256, G, bxp, D / 256, 36);
                pg8::EpiQKV E{WSB(WS_BIG), WSB(WS_BIG + 36 * MiB), WSB(WS_BIG + 72 * MiB), 0.08838834764831845f};
                pg8::gemm_phase<pg8::EpiQKV, true, true, 2>(lds, g, S, E);
#define SEGS_C CSEG(3, 1, C_OUT); CSEG(6, 1, C_G); CSEGO(1, 1, 0, C_W / 2)
#define SEGS_F CSEG(1, 3, C_W)
                if (L == 1) FILLER2(2, 3 * ADA_IT, C_OUT + C_G + C_W / 2, SEGS_C);
                if (L == 3) FILLER2(2, -1, C_W, SEGS_F);
#undef SEGS_C
#undef SEGS_F
            }
        }
        if (IN(base + 1)) {
            PHASE_BEGIN();
            if (lru) {
                const float* cw = INP(11) + (size_t)j * 4 * LW; const float* cb = INP(12) + (size_t)j * LW; const bf16_t* GU = WSB(WS_BIG); bf16_t* UC = WSB(WS_UC);
                for (int rep = 0; rep < REP_CONV; ++rep)
                for (int it = gw; it < 288 * NLB; it += NGW) {
                    const int strip = it / NLB, cg = it % NLB, ch = cg * 256 + 4 * lane;
                    int seg0, seglen, t0; if (strip < 256) { seg0 = (strip >> 6) * SEQ; seglen = SEQ; t0 = (strip & 63) * 32; } else { const int s2 = strip - 256; seg0 = ML + (s2 >> 3) * CTX; seglen = CTX; t0 = (s2 & 7) * 32; }
                    const f32x4 w0 = *(const f32x4*)(cw + ch), w1 = *(const f32x4*)(cw + LW + ch), w2 = *(const f32x4*)(cw + 2 * LW + ch), w3 = *(const f32x4*)(cw + 3 * LW + ch), bv = *(const f32x4*)(cb + ch);
                    u32x2 uw[35];
#pragma unroll
                    for (int i = 0; i < 35; ++i) { const int t = t0 - 2 + i; const int tc = t < 0 ? 0 : (t >= seglen ? seglen - 1 : t); uw[i] = *(const u32x2*)(GU + (size_t)(seg0 + tc) * (2 * LW) + LW + ch); }
                    __builtin_amdgcn_sched_barrier(0);
                    auto cvu = [&](int i) -> f32x4 { const int t = t0 - 2 + i; const float z = (t < 0 || t >= seglen) ? 0.f : 1.f; return (f32x4){bf_lo(uw[i].x) * z, bf_hi(uw[i].x) * z, bf_lo(uw[i].y) * z, bf_hi(uw[i].y) * z}; };
                    f32x4 um2 = cvu(0), um1 = cvu(1), u0 = cvu(2);
#pragma unroll
                    for (int t = 0; t < 32; ++t) { const f32x4 up1 = cvu(t + 3);
                        const f32x4 y = w0 * um2 + w1 * um1 + w2 * u0 + w3 * up1 + bv;
                        u32x2 wv; wv.x = pk2(y.x, y.y); wv.y = pk2(y.z, y.w); *(u32x2*)(UC + (size_t)(seg0 + t0 + t) * LW + ch) = wv;
                        um2 = um1; um1 = u0; u0 = up1; }
                }
            } else {
                const bf16_t* Qb = WSB(WS_BIG); const bf16_t* KTp = WSB(WS_BIG + 36 * MiB); const bf16_t* VTp = WSB(WS_BIG + 72 * MiB); bf16_t* Ob = WSB(WS_O);
                const float* rpg = INP(20) + (size_t)j * NH * 465;
                for (int rep = 0; rep < REP_ATTN; ++rep)
                for (int it = vcu; it < BATCH * NH * 4; it += G) { const int qr = it & 3, h = (it >> 2) & 15, b = it >> 6;
                    __syncthreads();
                    { const int oc0 = (ML + b * CTX) >> 3;
                      for (int ci = tid; ci < 4096; ci += NTHREADS) { const int o = ci >> 7, wq = ci & 127;
                          const u32x4 kv = *(const u32x4*)(KTp + ((size_t)((oc0 + o) * NH + h)) * 1024 + wq * 8);
                          *(LAS u32x4*)(lds + o * 2048 + (wq & ~15) * 16 + ((wq & 15) ^ (o & 2)) * 16) = kv;
                          const u32x4 vv = *(const u32x4*)(VTp + ((size_t)((oc0 + o) * NH + h)) * 1024 + wq * 8);
                          *(LAS u32x4*)(lds + 65536 + o * 2048 + wq * 16) = vv; }
                      LAS float* rp = (LAS float*)(lds + LDS_MISC + 1024);
                      for (int i = tid; i < 465; i += NTHREADS) rp[i] = rpg[h * 465 + i]; }
                    __syncthreads();
#pragma unroll 1
                    for (int rd = 0; rd < 4; ++rd) attn_unit<true>(Qb, KTp, VTp, Ob, lds, b, h, 8 * qr + 2 * rd + (wave >> 2), wave & 3, 0, lane);
                    if (!lastL && wave < 4) attn_unit<false>(Qb, KTp, VTp, Ob, lds, b, h, 0, 0, 4 * qr + wave, lane);
                }
                __syncthreads();
            }
        }
        if (lru) {
            if (IN(base + 2)) {
                PHASE_BEGIN();
                const bf16_t* UC = WSB(WS_UC);
                pg8::Gemm g{UC, WSB(WS_WG) + (size_t)j * (NLB * 1024) * LB, LW, LB, LB, 2, nullptr, nullptr, 0}; pg8::StaticOrder S; S.init(36, NLB * 4, G, bxp);
                pg8::EpiGates E{UC, (unsigned*)(wsl + WS_LA), INP(15) + (size_t)j * 2 * LW, INP(17) + (size_t)j * 2 * LW, WSF(WS_CA) + (size_t)j * 2 * LW};
                for (int rep = 0; rep < REP_GATES; ++rep) pg8::gemm_phase<pg8::EpiGates, false, true>(lds, g, S, E);
#define SEGS_H0 CSEG(5, 0, C_O)
#define SEGS_H1 CSEG(5, 1, C_O)
#undef SEGS_H0
#undef SEGS_H1
            }
            if (IN(base + 3)) {
                PHASE_BEGIN();
                const unsigned* LB = (const unsigned*)(wsl + WS_LA); float* AGGA = WSF(WS_AGGA); float* AGGH = WSF(WS_AGGH);
                for (int rep = 0; rep < REP_S1; ++rep)
                for (int it = gw; it < 2 * BATCH * 72 * 22; it += NGW) {
                    const int cg = it % 22, r1 = it / 22, q = r1 % 72, r2 = r1 / 72, b = r2 & 3, dir = r2 >> 2;
                    const int ch = cg * 128 + 2 * lane;
                    const int rbase = q < 8 ? ML + b * CTX + 32 * q : b * SEQ + 32 * (q - 8);
                    const unsigned* lp = LB + ((size_t)dir * M + rbase) * LW + ch;
                    float sl0 = 0.f, sl1 = 0.f, h0 = 0.f, h1 = 0.f;
                    u32x2 lb[32];
#pragma unroll
                    for (int t = 0; t < 32; ++t) lb[t] = *(const u32x2*)(lp + (size_t)t * LW);
                    __builtin_amdgcn_sched_barrier(0);
                    if (dir == 0) {
#pragma unroll
                        for (int t = 0; t < 32; ++t) { const float l0 = bf_lo(lb[t].x), l1 = bf_lo(lb[t].y); LRU_STEP(h0, l0, bf_hi(lb[t].x)); LRU_STEP(h1, l1, bf_hi(lb[t].y)); sl0 += l0; sl1 += l1; }
                    } else {
#pragma unroll
                        for (int t = 31; t >= 0; --t) { const float l0 = bf_lo(lb[t].x), l1 = bf_lo(lb[t].y); LRU_STEP(h0, l0, bf_hi(lb[t].x)); LRU_STEP(h1, l1, bf_hi(lb[t].y)); sl0 += l0; sl1 += l1; }
                    }
                    const size_t o = ((size_t)(dir * BATCH + b) * 72 + q) * LW + ch;
                    *(f32x2*)(AGGA + o) = (f32x2){fast_exp2(sl0), fast_exp2(sl1)}; *(f32x2*)(AGGH + o) = (f32x2){h0, h1};
                }
            }
            if (IN(base + 4)) {
                PHASE_BEGIN();
                const float* AGGA = WSF(WS_AGGA); const float* AGGH = WSF(WS_AGGH); float* CARRY = WSF(WS_CARRY);
                for (int rep = 0; rep < REP_S2; ++rep)
                for (int i = (wave * G + vcu) * 64 + lane; i < 2 * BATCH * LW; i += NGW * 64) {
                    const int ch = i % LW, db = i / LW, dir = db >> 2;
                    const size_t o = (size_t)db * 72 * LW + ch; float h = 0.f;
                    for (int bt = 0; bt < 2; ++bt) { float av[36], hv[36];
#pragma unroll
                        for (int k = 0; k < 36; ++k) { const int st = bt * 36 + k, q = dir ? (st < 8 ? 7 - st : 79 - st) : st; av[k] = AGGA[o + (size_t)q * LW]; hv[k] = AGGH[o + (size_t)q * LW]; }
#pragma unroll
                        for (int k = 0; k < 36; ++k) { const int st = bt * 36 + k, q = dir ? (st < 8 ? 7 - st : 79 - st) : st; CARRY[o + (size_t)q * LW] = h; h = av[k] * h + hv[k]; } }
                }
            }
            if (IN(base + 5)) {
                PHASE_BEGIN();
                const unsigned* LB = (const unsigned*)(wsl + WS_LA); const float* CARRY = WSF(WS_CARRY); const bf16_t* GU = WSB(WS_BIG); bf16_t* Zb = WSB(WS_Z);
                for (int rep = 0; rep < REP_S3; ++rep)
                for (int it = gw; it < BATCH * 72 * 22; it += NGW) {
                    const int cg = it % 22, r1 = it / 22, q = r1 % 72, b = r1 / 72;
                    const int ch = cg * 128 + 2 * lane;
                    const int rbase = q < 8 ? ML + b * CTX + 32 * q : b * SEQ + 32 * (q - 8);
                    const size_t ro = (size_t)rbase * LW + ch;
                    const size_t c0 = ((size_t)(0 * BATCH + b) * 72 + q) * LW + ch, c1 = ((size_t)(1 * BATCH + b) * 72 + q) * LW + ch;
                    float hf0[32], hf1[32];
                    { u32x2 lb[32]; const f32x2 hc = *(const f32x2*)(CARRY + c0);
#pragma unroll
                      for (int t = 0; t < 32; ++t) lb[t] = *(const u32x2*)(LB + ro + (size_t)t * LW);
                      __builtin_amdgcn_sched_barrier(0);
                      float h0 = hc.x, h1 = hc.y;
#pragma unroll
                      for (int t = 0; t < 32; ++t) { LRU_STEP(h0, bf_lo(lb[t].x), bf_hi(lb[t].x)); LRU_STEP(h1, bf_lo(lb[t].y), bf_hi(lb[t].y)); hf0[t] = h0; hf1[t] = h1; } }
                    { u32x2 lb[32]; unsigned gwv[32]; const f32x2 hc = *(const f32x2*)(CARRY + c1);
                      const unsigned* l1p = LB + (size_t)M * LW + ro;
#pragma unroll
                      for (int t = 0; t < 32; ++t) { lb[t] = *(const u32x2*)(l1p + (size_t)t * LW); gwv[t] = *(const unsigned*)(GU + (size_t)(rbase + t) * (2 * LW) + ch); }
                      __builtin_amdgcn_sched_barrier(0);
                      float h0 = hc.x, h1 = hc.y;
#pragma unroll
                      for (int t = 31; t >= 0; --t) { LRU_STEP(h0, bf_lo(lb[t].x), bf_hi(lb[t].x)); LRU_STEP(h1, bf_lo(lb[t].y), bf_hi(lb[t].y));
                          const float g0 = bf_lo(gwv[t]), g1 = bf_hi(gwv[t]);
                          const float z0 = g0 * fast_sigmoid(1.5957691216057308f * (g0 + 0.044715f * g0 * g0 * g0)) * (hf0[t] + h0);
                          const float z1 = g1 * fast_sigmoid(1.5957691216057308f * (g1 + 0.044715f * g1 * g1 * g1)) * (hf1[t] + h1);
                          *(unsigned*)(Zb + ro + (size_t)t * LW) = pk2(z0, z1); } }
                }
            }
        }
        if (IN(base + 6)) {
            PHASE_BEGIN();
            const bf16_t* Ao = lru ? WSB(WS_Z) : WSB(WS_O); const bf16_t* Bo = lru ? WSB(WS_WOUT) + (size_t)j * D * LW : WSB(WS_WO) + (size_t)j * D * D; const int Ko = lru ? LW : D;
            pg8::Gemm g{Ao, Bo, Ko, Ko, Ko, -1, Ao, Bo, 1};
            pg8::StaticOrder S; if (lastL) S.init(32, D / 256, G, bxp); else if (G == 256) S.init(32, D / 256, -G, bxp + 256, 4, D / 256, 1);
            else S.init(32, D / 256, G, bxp, 4, D / 256, 1);
            if (L == 0) { pg8::EpiResidT<true, 1> E{WSB(WS_X), WSF(WS_MODS) + (size_t)L * 5 * MODW, 2, WSF(WS_SLAB), INP(0), INP(7) + (size_t)L * D, 3 * D, 64u * (2 * L + 1), lds};
                pg8::gemm_phase<pg8::EpiResidT<true, 1>, true, true>(lds, g, S, E); }
            else { pg8::EpiResidT<false, 1> E{WSB(WS_X), WSF(WS_MODS) + (size_t)L * 5 * MODW, 2, WSF(WS_SLAB), nullptr, INP(7) + (size_t)L * D, 3 * D, 64u * (2 * L + 1), lds};
                pg8::gemm_phase<pg8::EpiResidT<false, 1>, true, true>(lds, g, S, E); }
        }
        if (IN(base + 7) && !lastL) {
            PHASE_BEGIN();
            const float* ml = WSF(WS_MODS) + (size_t)L * 5 * MODW; bf16_t* X = WSB(WS_X); bf16_t* XN = WSB(WS_XN); const float* g2 = INP(7) + (size_t)L * D;
            const float* slab = WSF(WS_SLAB);
#define VECS7(m) norm_vecs<0>(g2, ml + (size_t)(m) * MODW + 3 * D, ml + (size_t)(m) * MODW + 4 * D, GG, SS, lane)
#define SRC7(r) (X + (size_t)(r) * D)
#define APP7(v, r) norm_apply<0>(v, nullptr, GG, SS, XN + (size_t)(r) * D, nullptr, lane)
            if (!lastL) { f32x4 GG[8], SS[8]; VECS7(4); const float* mm = ml + (size_t)4 * MODW;
                for (int row = ML + gw; row < M; row += NGW) { f32x4 v[8]; norm_load(X + (size_t)row * D, v, lane);
                    norm_apply<0>(v, X + (size_t)row * D, GG, SS, XN + (size_t)row * D, nullptr, lane,
                                  (const float*)((const bf16_t*)slab + (size_t)((row - ML) >> 8) * 64 * 65536 + (size_t)(row & 255) * 256), mm + 2 * D); } }
#undef VECS7
#undef SRC7
#undef APP7
        }
        if (IN(base + 8)) {
            if (threadIdx.x == 0) ((volatile LAS int*)(lds + pg8::CC_TAB_OFF))[4] = lastL ? G : pg8::gemm_cc(36 * (FF / 256), G);
            PHASE_BEGIN();
            pg8::Gemm g{WSB(WS_XN), WSB(WS_W1) + (size_t)L * FF * D, D, D, D, -1, nullptr, nullptr, 0}; pg8::StaticOrder S; S.init(nMrows, FF / 256, G, bxp);
            pg8::EpiAct<1> E{WSB(WS_BIG), FF};
            pg8::gemm_phase<pg8::EpiAct<1>, true, true, 4>(lds, g, S, E);
#define SEGS_B CSEG(2, 1, C_IN)
#define SEGS_D CSEG(0, 2, C_W); CSEGO(1, 1, C_W / 2, C_W / 2)
#define SEGS_G CSEG(0, 3, C_W)
            if (L == 0) FILLER2(4, 2 * ADA_IT, C_IN, SEGS_B);
            if (L == 1) FILLER2(4, -1, C_W + C_W / 2, SEGS_D);
            if (L == 2) FILLER2(4, -1, C_W, SEGS_G);
#undef SEGS_B
#undef SEGS_D
#undef SEGS_G
        }
        if (IN(base + 9)) {
            PHASE_BEGIN();
            const bf16_t* Ao = WSB(WS_BIG); const bf16_t* Bo = WSB(WS_W2) + (size_t)L * D * FF;
            pg8::Gemm g{Ao, Bo, FF, FF, FF, -1, Ao, Bo, 1};
            pg8::StaticOrder S; if (lastL) S.init(32, D / 256, G, bxp); else if (G == 256) S.init(32, D / 256, -G, bxp + 256, 4, D / 256, 1);
            else S.init(32, D / 256, G, bxp, 4, D / 256, 1);
            if (lastL) { pg8::EpiResidT<false, 2> E{WSB(WS_X), WSF(WS_MODS) + (size_t)L * 5 * MODW, 5, (float*)TABP(23), nullptr, INP(22), 0, 64u * (2 * L + 2), lds};
                pg8::gemm_phase<pg8::EpiResidT<false, 2>, true, true>(lds, g, S, E); }
            else { pg8::EpiResidT<false, 1> E{WSB(WS_X), WSF(WS_MODS) + (size_t)L * 5 * MODW, 5, WSF(WS_SLAB), nullptr, INP(6) + (size_t)(L + 1) * D, 5 * MODW, 64u * (2 * L + 2), lds};
                pg8::gemm_phase<pg8::EpiResidT<false, 1>, true, true>(lds, g, S, E); }
        }
        if (IN(base + 10) && !lastL) {
            PHASE_BEGIN();
            bf16_t* X = WSB(WS_X);
#define SRC10(r) (X + (size_t)(r) * D)
            { const float* mn = WSF(WS_MODS) + (size_t)(L + 1) * 5 * MODW; bf16_t* XN = WSB(WS_XN); const float* g1n = INP(6) + (size_t)(L + 1) * D;
                const float* slab = WSF(WS_SLAB); const float* gate5 = WSF(WS_MODS) + ((size_t)L * 5 + 4) * MODW + 5 * D;
#define VECS10B(m) norm_vecs<0>(g1n, mn + (size_t)(m) * MODW, mn + (size_t)(m) * MODW + D, GG, SS, lane)
#define APP10B(v, r) norm_apply<0>(v, nullptr, GG, SS, XN + (size_t)(r) * D, nullptr, lane)
                { f32x4 GG[8], SS[8]; VECS10B(4);
                  for (int row = ML + gw; row < M; row += NGW) { f32x4 v[8]; norm_load(X + (size_t)row * D, v, lane);
                      norm_apply<0>(v, X + (size_t)row * D, GG, SS, XN + (size_t)row * D, nullptr, lane,
                                    (const float*)((const bf16_t*)slab + (size_t)((row - ML) >> 8) * 64 * 65536 + (size_t)(row & 255) * 256), gate5); } }
#undef VECS10B
#undef APP10B
            }
#undef SRC10
        }
    }
#undef IN
#undef PHASE_BEGIN
}

static inline dim3 g1(size_t n) { return dim3((unsigned)((n + 255) / 256)); }

extern "C" void kernel_launch(void* const* d_in, const int* in_sizes, int n_in, void* d_out, int out_size, void* d_ws, size_t ws_size, hipStream_t stream) {
    static int grid = 0;
    if (grid == 0) {
        int dev = 0, cus = 0;
        if (hipGetDevice(&dev) != hipSuccess || hipDeviceGetAttribute(&cus, hipDeviceAttributeMultiprocessorCount, dev) != hipSuccess) { grid = -1; return; }
        if (hipFuncSetAttribute((const void*)mega, hipFuncAttributeMaxDynamicSharedMemorySize, LDS_BYTES) != hipSuccess) { fprintf(stderr, "hipFuncSetAttribute failed\n"); grid = -1; return; }
        int per_cu = 0; (void)hipOccupancyMaxActiveBlocksPerMultiprocessor(&per_cu, (const void*)mega, NTHREADS, LDS_BYTES); (void)hipGetLastError();
        grid = cus;
    }
    if (grid < 0) return;
    const float* norm1_g = (const float*)d_in[6]; const float* norm2_g = (const float*)d_in[7];
    const float* lru_w_in = (const float*)d_in[10]; const float* lru_conv_w = (const float*)d_in[11];
    const float* lru_conv_b = (const float*)d_in[12]; const float* lru_lambda = (const float*)d_in[13]; const float* lru_wa = (const float*)d_in[14]; const float* lru_ba = (const float*)d_in[15];
    const float* lru_wx = (const float*)d_in[16]; const float* lru_bx = (const float*)d_in[17]; const float* lru_w_out = (const float*)d_in[18]; const float* na_w_qkv = (const float*)d_in[19];
    const float* na_rpb = (const float*)d_in[20]; const float* na_w_o = (const float*)d_in[21];
    (void)norm2_g;
    char* ws = (char*)d_ws;
    (void)hipMemsetAsync(ws + WS_CTL, 0, CTL_ZERO_BYTES, stream);
    Args a{};
    for (int i = 0; i < 23; ++i) a.in[i] = (const float*)d_in[i];
    a.out = (float*)d_out; a.ws = (unsigned char*)d_ws;
    auto run = [&](int lo, int hi) { a.ph_lo = lo; a.ph_hi = hi; hipLaunchKernelGGL(mega, dim3(grid), dim3(NTHREADS), LDS_BYTES, stream, a); };
#if ONE_LAUNCH
    if (WS_FAST_END > ws_size) { fprintf(stderr, "ws too small\n"); return; }
    run(0, PH_END);
#else
    size_t off = (FAST_LRU ? WS_FAST_END : WS_NV);
    auto alloc = [&](size_t bytes) { float* p = (float*)(ws + off); off += (bytes + 255) & ~(size_t)255; return p; };
    float* H = alloc((size_t)M * D * 4); float* T1 = alloc((size_t)M * D * 4);
    float* BIGF = alloc((size_t)M * 3 * D * 4);
    float* UCf = alloc((size_t)M * LW * 4); float* RA = alloc((size_t)M * LW * 4); float* RX = alloc((size_t)M * LW * 4); float* Y = alloc((size_t)M * LW * 4);
    if (!(FAST_LRU && FAST_NA)) { if (off > ws_size) { fprintf(stderr, "ws too small: need %zu have %zu\n", off, ws_size); return; } }
    else if (WS_FAST_END > ws_size) return;
    float* mods = (float*)(ws + WS_MODS); float* X = (float*)(ws + WS_X);
    run(PH_PROLOGUE, PH_PROLOGUE + 1);
    run(PH_NORM0, PH_NORM0 + 1);
    for (int L = 0; L < DEPTH; ++L) {
        const int base = PH_LAYER0 + PH_PER_LAYER * L; const bool lru = !(L & 1); const int j = L / 2;
        const float* ml = mods + (size_t)L * 5 * MODW;
        if (lru) {
            if (FAST_LRU) { for (int p = 0; p <= 6; ++p) run(base + p, base + p + 1); }
            else {
                nv::k_norm_mod<<<M, 256, 0, stream>>>(X, norm1_g + (size_t)L * D, ml, 0, H, D);
                float* GUf = BIGF;
                nv::k_sgemm<<<dim3(2 * LW / 128, M / 128, 1), 256, 0, stream>>>(H, D, 0, lru_w_in + (size_t)j * D * 2 * LW, 2 * LW, 0, GUf, 2 * LW, 0, D);
                nv::k_conv<<<g1((size_t)M * LW), 256, 0, stream>>>(GUf, lru_conv_w + (size_t)j * 4 * LW, lru_conv_b + (size_t)j * LW, UCf);
                for (int d = 0; d < 2; ++d) {
                    const size_t wo = ((size_t)j * 2 + d) * NLB * LB * LB, bo = ((size_t)j * 2 + d) * LW;
                    nv::k_sgemm<<<dim3(LB / 128, M / 128, NLB), 256, 0, stream>>>(UCf, LW, LB, lru_wa + wo, LB, (size_t)LB * LB, RA, LW, LB, LB);
                    nv::k_sgemm<<<dim3(LB / 128, M / 128, NLB), 256, 0, stream>>>(UCf, LW, LB, lru_wx + wo, LB, (size_t)LB * LB, RX, LW, LB, LB);
                    nv::k_lru_coef<<<g1((size_t)M * LW), 256, 0, stream>>>(RA, RX, UCf, lru_ba + bo, lru_bx + bo, lru_lambda + bo);
                    nv::k_scan_dir<<<g1(BATCH * LW), 256, 0, stream>>>(RA, RX, Y, d);
                }
                nv::k_gate_mul<<<g1((size_t)M * LW), 256, 0, stream>>>(GUf, Y, UCf);
                nv::k_sgemm<<<dim3(D / 128, M / 128, 1), 256, 0, stream>>>(UCf, LW, 0, lru_w_out + (size_t)j * LW * D, D, 0, T1, D, 0, LW);
                nv::k_resid<<<g1((size_t)M * D), 256, 0, stream>>>(X, T1, ml, 2, M);
            }
        } else {
            if (FAST_NA) { run(base + 0, base + 1); run(base + 1, base + 2); run(base + 6, base + 7); }
            else {
                nv::k_norm_mod<<<M, 256, 0, stream>>>(X, norm1_g + (size_t)L * D, ml, 0, H, D);
                float* QKV = BIGF;
                nv::k_sgemm<<<dim3(3 * D / 128, M / 128, 1), 256, 0, stream>>>(H, D, 0, na_w_qkv + (size_t)j * D * 3 * D, 3 * D, 0, QKV, 3 * D, 0, D);
                nv::k_attn<<<M * NH / 4, 256, 0, stream>>>(QKV, na_rpb + (size_t)j * NH * 15 * 31, H);
                nv::k_sgemm<<<dim3(D / 128, M / 128, 1), 256, 0, stream>>>(H, D, 0, na_w_o + (size_t)j * D * D, D, 0, T1, D, 0, D);
                nv::k_resid<<<g1((size_t)M * D), 256, 0, stream>>>(X, T1, ml, 2, M);
            }
        }
        run(base + 7, base + 8); run(base + 8, base + 9); run(base + 9, base + 10); run(base + 10, base + 11);
    }
#endif
}
```

```cpp
#include <hip/hip_runtime.h>
#include <cstdint>
#include <cstdio>

#ifndef FAST_MLP
#define FAST_MLP 1
#endif
#ifndef FAST_NA
#define FAST_NA 1
#endif
#ifndef FAST_LRU
#define FAST_LRU 1
#endif
#ifndef REP_PRO
#define REP_PRO 1
#endif
#ifndef REP_NORM
#define REP_NORM 1
#endif
#ifndef REP_ATTN
#define REP_ATTN 1
#endif
#ifndef REP_SCAN
#define REP_SCAN 1
#endif
#ifndef REP_CONV
#define REP_CONV 1
#endif
#ifndef REP_S1
#define REP_S1 1
#endif
#ifndef REP_S2
#define REP_S2 1
#endif
#ifndef REP_S3
#define REP_S3 1
#endif
#ifndef REP_IN
#define REP_IN 1
#endif
#ifndef REP_GATES
#define REP_GATES 1
#endif
#ifndef REP_MLP1
#define REP_MLP1 1
#endif
#ifndef REP_OUT
#define REP_OUT 1
#endif
#ifndef REP_MLP2
#define REP_MLP2 1
#endif
#ifndef REP_GEMM
#define REP_GEMM 1
#endif
#ifndef ONE_LAUNCH
#define ONE_LAUNCH 1
#endif

namespace cfg {
constexpr int D = 2048, BATCH = 4, SEQ = 2048, DEPTH = 4, GRID_W = 64, CTX = 256, NH = 16, HD = 128;
constexpr int LW = 2816, NLB = 11, LB = 256, FF = 8192, NMOD = 6;
constexpr int ML = BATCH * SEQ, MC = BATCH * CTX, M = ML + MC;
constexpr int MODW = NMOD * D;
}
using namespace cfg;

#define LAS __attribute__((address_space(3)))
#define GAS __attribute__((address_space(1)))
typedef unsigned short bf16_t;
typedef short bf16x8 __attribute__((ext_vector_type(8)));
typedef float f32x4 __attribute__((ext_vector_type(4)));
typedef float f32x2 __attribute__((ext_vector_type(2)));
typedef unsigned u32x4 __attribute__((ext_vector_type(4)));
typedef unsigned u32x2 __attribute__((ext_vector_type(2)));

__device__ __forceinline__ float sigmoidf_(float x) { return 1.f / (1.f + expf(-x)); }
__device__ __forceinline__ float siluf_(float x) { return x * sigmoidf_(x); }
__device__ __forceinline__ float gelu_tanh(float x) { return 0.5f * x * (1.f + tanhf(0.7978845608028654f * (x + 0.044715f * x * x * x))); }
__device__ __forceinline__ int row_mod(int row) { return row < ML ? row / SEQ : 4; }
__device__ __forceinline__ unsigned f2bf(float f) { unsigned u = __builtin_bit_cast(unsigned, f); return (u + 0x7fffu + ((u >> 16) & 1u)) >> 16; }
__device__ __forceinline__ unsigned pk2(float lo, float hi) { return f2bf(lo) | (f2bf(hi) << 16); }
__device__ __forceinline__ float bf_lo(unsigned w) { return __builtin_bit_cast(float, w << 16); }
__device__ __forceinline__ float bf_hi(unsigned w) { return __builtin_bit_cast(float, w & 0xffff0000u); }
__device__ __forceinline__ unsigned cvt_pk_bf16(float lo, float hi) { unsigned r; asm volatile("v_cvt_pk_bf16_f32 %0, %1, %2" : "=v"(r) : "v"(lo), "v"(hi)); return r; }
__device__ __forceinline__ float fast_exp2(float x) { return __builtin_amdgcn_exp2f(x); }
__device__ __forceinline__ float fast_rcp(float x) { return __builtin_amdgcn_rcpf(x); }
__device__ __forceinline__ float fast_sigmoid(float x) { return fast_rcp(1.f + fast_exp2(-1.4426950408889634f * x)); }

namespace nv {
__global__ void k_norm_mod(const float* X, const float* g, const float* mods_l, int sh_idx, float* H, int ldh) {
    const int row = blockIdx.x, tid = threadIdx.x;
    const float* xr = X + (size_t)row * D;
    float v[8], ss = 0.f;
#pragma unroll
    for (int j = 0; j < 8; ++j) { v[j] = xr[tid + 256 * j]; ss += v[j] * v[j]; }
    __shared__ float red[256];
    red[tid] = ss; __syncthreads();
    for (int o = 128; o > 0; o >>= 1) { if (tid < o) red[tid] += red[tid + o]; __syncthreads(); }
    const float rstd = rsqrtf(red[0] / D + 1e-6f);
    const int m = row_mod(row);
#pragma unroll
    for (int j = 0; j < 8; ++j) {
        const int col = tid + 256 * j; float h = v[j] * rstd * g[col];
        if (sh_idx >= 0) { const float sh = mods_l[(size_t)m * MODW + sh_idx * D + col], sc = mods_l[(size_t)m * MODW + (sh_idx + 1) * D + col]; h = h * (1.f + sc) + sh; }
        H[(size_t)row * ldh + col] = h;
    }
}
__global__ __launch_bounds__(256) void k_sgemm(const float* A, int lda, size_t sA, const float* B, int ldb, size_t sB, float* C, int ldc, size_t sC, int K) {
    __shared__ float As[16][128 + 4], Bs[16][128 + 4];
    A += blockIdx.z * sA; B += blockIdx.z * sB; C += blockIdx.z * sC;
    const int tid = threadIdx.x, tx = tid & 15, ty = tid >> 4;
    const int m0 = blockIdx.y * 128, n0 = blockIdx.x * 128;
    float acc[8][8];
#pragma unroll
    for (int i = 0; i < 8; ++i)
#pragma unroll
        for (int j = 0; j < 8; ++j) acc[i][j] = 0.f;
    for (int k0 = 0; k0 < K; k0 += 16) {
#pragma unroll
        for (int i = 0; i < 2; ++i) {
            const int r = (tid >> 2) + 64 * i, kq = (tid & 3) * 4;
            const float4 a = *(const float4*)(A + (size_t)(m0 + r) * lda + k0 + kq);
            As[kq + 0][r] = a.x; As[kq + 1][r] = a.y; As[kq + 2][r] = a.z; As[kq + 3][r] = a.w;
            const int kk = (tid >> 5) + 8 * i, nq = (tid & 31) * 4;
            const float4 b = *(const float4*)(B + (size_t)(k0 + kk) * ldb + n0 + nq);
            *(float4*)&Bs[kk][nq] = b;
        }
        __syncthreads();
#pragma unroll
        for (int k = 0; k < 16; ++k) {
            float a[8], b[8];
            *(float4*)&a[0] = *(const float4*)&As[k][ty * 4]; *(float4*)&a[4] = *(const float4*)&As[k][64 + ty * 4];
            *(float4*)&b[0] = *(const float4*)&Bs[k][tx * 4]; *(float4*)&b[4] = *(const float4*)&Bs[k][64 + tx * 4];
#pragma unroll
            for (int i = 0; i < 8; ++i)
#pragma unroll
                for (int j = 0; j < 8; ++j) acc[i][j] += a[i] * b[j];
        }
        __syncthreads();
    }
#pragma unroll
    for (int i = 0; i < 8; ++i) {
        const int r = m0 + (i < 4 ? ty * 4 + i : 64 + ty * 4 + i - 4);
        *(float4*)(C + (size_t)r * ldc + n0 + tx * 4) = make_float4(acc[i][0], acc[i][1], acc[i][2], acc[i][3]);
        *(float4*)(C + (size_t)r * ldc + n0 + 64 + tx * 4) = make_float4(acc[i][4], acc[i][5], acc[i][6], acc[i][7]);
    }
}
__global__ void k_resid(float* X, const float* O, const float* mods_l, int g_idx, int rows) {
    const size_t i = (size_t)blockIdx.x * 256 + threadIdx.x; if (i >= (size_t)rows * D) return;
    const int row = i / D, col = i % D, m = row_mod(row);
    X[i] += mods_l[(size_t)m * MODW + g_idx * D + col] * O[i];
}
__global__ void k_sqrelu(float* A, size_t n) { const size_t i = (size_t)blockIdx.x * 256 + threadIdx.x; if (i < n) { const float v = fmaxf(A[i], 0.f); A[i] = v * v; } }
__global__ void k_conv(const float* GU, const float* cw, const float* cb, float* UC) {
    const size_t i = (size_t)blockIdx.x * 256 + threadIdx.x; if (i >= (size_t)M * LW) return;
    const int row = i / LW, c = i % LW;
    int seg0, seglen; if (row < ML) { seg0 = (row / SEQ) * SEQ; seglen = SEQ; } else { seg0 = ML + ((row - ML) / CTX) * CTX; seglen = CTX; }
    const int t = row - seg0; float s = cb[c];
    for (int j = 0; j < 4; ++j) { const int tt = t + j - 2; if (tt >= 0 && tt < seglen) s += cw[j * LW + c] * GU[(size_t)(seg0 + tt) * (2 * LW) + LW + c]; }
    UC[i] = s;
}
__global__ void k_lru_coef(float* RA, float* RX, const float* UC, const float* ba, const float* bx, const float* lam) {
    const size_t i = (size_t)blockIdx.x * 256 + threadIdx.x; if (i >= (size_t)M * LW) return;
    const int c = i % LW;
    const float r = sigmoidf_(RA[i] + ba[c]), ig = sigmoidf_(RX[i] + bx[c]);
    const float sp = log1pf(expf(-lam[c]));
    const float log_a = -8.f * r * sp;
    RA[i] = expf(log_a);
    RX[i] = sqrtf(-expm1f(2.f * log_a)) * (ig * UC[i]);
}
__global__ void k_scan_dir(const float* A, const float* Bc, float* Y, int dir) {
    const int idx = blockIdx.x * 256 + threadIdx.x; if (idx >= BATCH * LW) return;
    const int b = idx / LW, c = idx % LW;
    float h = 0.f;
    if (dir == 0) {
        for (int t = 0; t < CTX; ++t) { const size_t o = (size_t)(ML + b * CTX + t) * LW + c; h = A[o] * h + Bc[o]; Y[o] = h; }
        for (int t = 0; t < SEQ; ++t) { const size_t o = (size_t)(b * SEQ + t) * LW + c; h = A[o] * h + Bc[o]; Y[o] = h; }
    } else {
        for (int t = CTX - 1; t >= 0; --t) { const size_t o = (size_t)(ML + b * CTX + t) * LW + c; h = A[o] * h + Bc[o]; Y[o] += h; }
        for (int t = SEQ - 1; t >= 0; --t) { const size_t o = (size_t)(b * SEQ + t) * LW + c; h = A[o] * h + Bc[o]; Y[o] += h; }
    }
}
__global__ void k_gate_mul(const float* GU, const float* Y, float* Z) {
    const size_t i = (size_t)blockIdx.x * 256 + threadIdx.x; if (i >= (size_t)M * LW) return;
    const int row = i / LW, c = i % LW;
    Z[i] = gelu_tanh(GU[(size_t)row * (2 * LW) + c]) * Y[i];
}
__global__ __launch_bounds__(256) void k_attn(const float* QKV, const float* rpb_l, float* O) {
    __shared__ float qs[4][HD], ps[4][384];
    const int w = threadIdx.x >> 6, lane = threadIdx.x & 63;
    const int gw = blockIdx.x * 4 + w; const int row = gw / NH, h = gw % NH;
    const bool lat = row < ML;
    const int b = lat ? row / SEQ : (row - ML) / CTX;
    const int t = lat ? row % SEQ : 0, r = t / GRID_W, c = t % GRID_W;
    int rs = r - 4; rs = rs < 0 ? 0 : (rs > 24 ? 24 : rs);
    int cs = c - 8; cs = cs < 0 ? 0 : (cs > 48 ? 48 : cs);
    const float scale = 0.08838834764831845f;
    qs[w][lane] = QKV[(size_t)row * (3 * D) + h * HD + lane]; qs[w][lane + 64] = QKV[(size_t)row * (3 * D) + h * HD + lane + 64];
    __syncthreads();
    float s[6]; float mx = -1e30f;
#pragma unroll
    for (int i = 0; i < 6; ++i) {
        const int j = lane + 64 * i; int krow; float bias = 0.f; bool valid = true;
        if (j < 128) { const int a = j >> 4, kk = j & 15; krow = b * SEQ + (rs + a) * GRID_W + cs + kk; bias = rpb_l[(h * 15 + (rs + a - r + 7)) * 31 + (cs + kk - c + 15)]; valid = lat; }
        else krow = ML + b * CTX + (j - 128);
        float d = 0.f;
        if (valid) { const float* kp = QKV + (size_t)krow * (3 * D) + D + h * HD; for (int e = 0; e < HD; ++e) d += qs[w][e] * kp[e]; d = d * scale + bias; } else d = -1e30f;
        s[i] = d; mx = fmaxf(mx, d);
    }
    for (int o = 32; o > 0; o >>= 1) mx = fmaxf(mx, __shfl_xor(mx, o));
    float sum = 0.f;
#pragma unroll
    for (int i = 0; i < 6; ++i) { const float p = (s[i] <= -1e29f) ? 0.f : expf(s[i] - mx); s[i] = p; sum += p; }
    for (int o = 32; o > 0; o >>= 1) sum += __shfl_xor(sum, o);
    const float inv = 1.f / sum;
#pragma unroll
    for (int i = 0; i < 6; ++i) ps[w][lane + 64 * i] = s[i] * inv;
    __syncthreads();
    float o0 = 0.f, o1 = 0.f;
    for (int j = lat ? 0 : 128; j < 384; ++j) {
        int krow; if (j < 128) { const int a = j >> 4, kk = j & 15; krow = b * SEQ + (rs + a) * GRID_W + cs + kk; } else krow = ML + b * CTX + (j - 128);
        const float* vp = QKV + (size_t)krow * (3 * D) + 2 * D + h * HD; const float p = ps[w][j];
        o0 += p * vp[lane]; o1 += p * vp[lane + 64];
    }
    O[(size_t)row * D + h * HD + lane] = o0; O[(size_t)row * D + h * HD + lane + 64] = o1;
}
}

namespace pg8 {
constexpr int BM = 256, BK = 64, HALF = 128, HTB = HALF * BK * 2, STAGE_BYTES = 8 * HTB, NXCD = 8, WGM = 4;
__host__ __device__ __forceinline__ int lds_byte(int r, int c) { const int st = (r >> 4) * 2 + (c >> 5), rr = r & 15, cc = c & 31, ob = rr * 64 + cc * 2; return st * 1024 + (ob ^ (((ob >> 9) & 1) << 5)); }
__host__ __device__ __forceinline__ void stage_rc(int b, int& R, int& C) { const int st = b / 1024, sb = b % 1024, swz = sb ^ (((sb >> 9) & 1) << 5); R = (st >> 1) * 16 + swz / 64; C = (st & 1) * 32 + (swz % 64) / 2; }
__host__ __device__ __forceinline__ int perm32(int rho) { const int n = rho >> 4, i = rho & 15; return 8 * (i >> 2) + 4 * n + (i & 3); }
struct Unit { int pm, pn, sw, ks; };
struct Gemm { const bf16_t* A; const bf16_t* Bt; int lda, ldb, K, apn_shift; const bf16_t* A2; const bf16_t* Bt2; int ksplit; };
__device__ __forceinline__ int gemm_cc(int U, int G) { if (G & 7) return G; const int R = (U + G - 1) / G; int c = (U + R - 1) / R; c = (c + 7) & ~7; return c > G ? G : c; }
constexpr int CC_TAB_OFF = 131072 + 512;
struct StaticOrder {
    int nM, nN, nwg, G, c, nM2, nN2, nwg2, split;
    __device__ void init(int nM_, int nN_, int G_, int c_, int nM2_ = 0, int nN2_ = 0, int split_ = 0) { nM = nM_; nN = nN_; nwg = nM * nN; G = G_; c = c_; nM2 = nM2_; nN2 = nN2_; split = split_; nwg2 = split_ ? nM2 * nN2 * 8 : nM2 * nN2; }
    __device__ static void map(int wgid, int nM, int nN, int nwg, Unit& u) {
        { const int q = nwg / NXCD, r = nwg % NXCD, xcd = wgid % NXCD, off = wgid / NXCD; wgid = (xcd < r ? xcd * (q + 1) : r * (q + 1) + (xcd - r) * q) + off; }
        const int nig = WGM * nN, gid = wgid / nig, fm = gid * WGM, gsz = (nM - fm) < WGM ? (nM - fm) : WGM;
        u.pm = fm + ((wgid % nig) % gsz); u.pn = (wgid % nig) / gsz;
    }
    __device__ bool next(int i, Unit& u, const LAS unsigned char* lds, int cck) const {
        int Gs = G, cs = c; if (cck) { Gs = __builtin_amdgcn_readfirstlane(*(volatile const LAS int*)(lds + CC_TAB_OFF + 4 * cck)); cs = c < Gs ? c : (1 << 28); }
        const long L = (long)i * Gs + cs; if ((unsigned long)L >= (unsigned long)(nwg + nwg2)) return false;
        u.ks = 0;
        if (L < nwg) { map((int)L, nM, nN, nwg, u); u.sw = 0; }
        else if (!split) { map((int)L - nwg, nM2, nN2, nwg2, u); u.sw = 1; }
        else { const int L2 = (int)L - nwg; int tile, ks;
            if (nwg2 == 256) { const int x = L2 & 7, jj = L2 >> 3; tile = x * 4 + (jj >> 3); ks = jj & 7; } else { tile = L2 >> 3; ks = L2 & 7; }
            u.pm = nM + tile / nN2; u.pn = tile % nN2; u.sw = 1; u.ks = ks; }
        return true;
    }
};
template <class Epi, bool ALIGN_EPI, bool SP2, int CCK = 0>
__device__ __forceinline__ void gemm_phase(LAS unsigned char* lds, const Gemm g, const StaticOrder& S, const Epi& E) {
    int tid = threadIdx.x; asm volatile("" : "+v"(tid));
    const int wid = __builtin_amdgcn_readfirstlane(tid >> 6), lane = tid & 63, wr = wid >> 2, wc = wid & 3, fr = lane & 15, fq = lane >> 4;
    const int KT = g.K / BK, spl_e = (KT / 8) & ~1, spl_x = (KT - 8 * spl_e) / 2;
    unsigned voffA[2], voffB[2];
#pragma unroll
    for (int i = 0; i < 2; ++i) { int R, C; stage_rc(tid * 16 + i * 8192, R, C); const int Rb = Epi::PERM ? ((R & ~31) + perm32(R & 31)) : R;
        voffA[i] = (unsigned)(R * g.lda + C) * 2u; voffB[i] = (unsigned)(Rb * g.ldb + C) * 2u; }
    const size_t kstep = (size_t)(BK * 2);
    const size_t hstepA = (size_t)HALF * g.lda * 2, tstepA = 2 * hstepA, hstepB = (size_t)HALF * g.ldb * 2, tstepB = 2 * hstepB;
    const unsigned ldsw = (unsigned)wid * 1024u;
    const int aoff = lds_byte(wr * 64 + fr, fq * 8), boff = lds_byte(wc * 32 + fr, fq * 8);
#define PG8_SA(b, h) (((b) * 2 + (h)) * HTB)
#define PG8_SB(b, h) ((4 + (b) * 2 + (h)) * HTB)
#define PG8_STAGE(bufoff, gbase, voff) do { _Pragma("unroll") for (int _i = 0; _i < 2; ++_i) \
        __builtin_amdgcn_global_load_lds((const unsigned*)((const char*)(gbase) + (voff)[_i]), (LAS unsigned*)(lds + (bufoff) + ldsw + _i * 8192), 16, 0, 0); } while (0)
#define PG8_LDA(dst, b, h) do { _Pragma("unroll") for (int m = 0; m < 4; ++m) _Pragma("unroll") for (int k = 0; k < 2; ++k) dst[m][k] = *(const LAS bf16x8*)(lds + PG8_SA(b, h) + aoff + m * 2048 + k * 1024); } while (0)
#define PG8_LDB(dst, b, h) do { _Pragma("unroll") for (int n = 0; n < 2; ++n) _Pragma("unroll") for (int k = 0; k < 2; ++k) dst[n][k] = *(const LAS bf16x8*)(lds + PG8_SB(b, h) + boff + n * 2048 + k * 1024); } while (0)
#define PG8_MMA(ai, bj, At, Bt) do { __builtin_amdgcn_s_setprio(1); _Pragma("unroll") for (int m = 0; m < 4; ++m) _Pragma("unroll") for (int n = 0; n < 2; ++n) _Pragma("unroll") for (int k = 0; k < 2; ++k) \
        acc[ai][bj][m][n] = __builtin_amdgcn_mfma_f32_16x16x32_bf16(Bt[n][k], At[m][k], acc[ai][bj][m][n], 0, 0, 0); __builtin_amdgcn_s_setprio(0); } while (0)
#define PG8_WAIT_V(n) asm volatile("s_waitcnt vmcnt(" #n ")" ::: "memory")
#define PG8_WAIT_L(n) asm volatile("s_waitcnt lgkmcnt(" #n ")" ::: "memory")
#define PG8_BAR __builtin_amdgcn_s_barrier()
#define PG8_SCHED __builtin_amdgcn_sched_barrier(0)
#define PG8_KOFF(u) ((g.ksplit && (u).sw) ? (size_t)(spl_e * (u).ks + 2 * ((u).ks < spl_x ? (u).ks : spl_x)) * kstep : (size_t)0)
#define PG8_NT(u) ((g.ksplit && (u).sw) ? spl_e + ((u).ks < spl_x ? 2 : 0) : KT)
#define PG8_APTR(u) ((const char*)((u).sw ? g.A2 : g.A) + (size_t)(u).pm * tstepA + (g.apn_shift >= 0 ? (size_t)((u).pn >> g.apn_shift) * 512 : (size_t)0) + PG8_KOFF(u))
#define PG8_BPTR(u) ((const char*)((u).sw ? g.Bt2 : g.Bt) + (size_t)(u).pn * tstepB + PG8_KOFF(u))
    Unit cur, nxt; int ui = 0;
    if (!S.next(0, cur, lds, CCK)) return;
    f32x4 acc[2][2][4][2];
#pragma unroll
    for (int a = 0; a < 2; ++a)
#pragma unroll
        for (int b = 0; b < 2; ++b)
#pragma unroll
            for (int m = 0; m < 4; ++m)
#pragma unroll
                for (int n = 0; n < 2; ++n) acc[a][b][m][n] = (f32x4){0.f, 0.f, 0.f, 0.f};
    bf16x8 At[4][2], B0[2][2], B1[2][2];
    const char* cA = PG8_APTR(cur); const char* cB = PG8_BPTR(cur); int nt = PG8_NT(cur);
    if constexpr (SP2) {
        PG8_STAGE(PG8_SB(0, 0), cB, voffB); PG8_STAGE(PG8_SB(0, 1), cB + hstepB, voffB); PG8_STAGE(PG8_SA(0, 0), cA, voffA); PG8_STAGE(PG8_SA(0, 1), cA + hstepA, voffA);
        if (wr == 1) PG8_BAR;
        PG8_WAIT_V(2); PG8_BAR;
        PG8_STAGE(PG8_SB(1, 0), cB + kstep, voffB); PG8_STAGE(PG8_SA(1, 0), cA + kstep, voffA); PG8_STAGE(PG8_SB(1, 1), cB + hstepB + kstep, voffB);
        PG8_WAIT_V(6); PG8_BAR;
    } else {
        PG8_STAGE(PG8_SB(0, 0), cB, voffB); PG8_STAGE(PG8_SA(0, 0), cA, voffA); PG8_STAGE(PG8_SB(0, 1), cB + hstepB, voffB); PG8_STAGE(PG8_SA(0, 1), cA + hstepA, voffA);
        if (wr == 1) PG8_BAR;
        PG8_WAIT_V(4); PG8_BAR;
        PG8_STAGE(PG8_SB(1, 0), cB + kstep, voffB); PG8_STAGE(PG8_SA(1, 0), cA + kstep, voffA); PG8_STAGE(PG8_SB(1, 1), cB + hstepB + kstep, voffB);
        PG8_WAIT_V(6); PG8_BAR;
    }
    for (;;) {
        const bool has_next = S.next(ui + 1, nxt, lds, CCK);
        const char* nA = has_next ? PG8_APTR(nxt) : cA; const char* nB = has_next ? PG8_BPTR(nxt) : cB;
        for (int t = 0; t < nt; t += 2) {
            const bool last = (t == nt - 2);
            const char* a1 = cA + (size_t)(t + 1) * kstep;
            const char* a2 = last ? nA : cA + (size_t)(t + 2) * kstep; const char* b2 = last ? nB : cB + (size_t)(t + 2) * kstep;
            const char* a3 = a2 + kstep; const char* b3 = b2 + kstep;
            if constexpr (SP2) {
            PG8_LDB(B0, 0, 0); PG8_LDB(B1, 0, 1); PG8_SCHED; PG8_LDA(At, 0, 0); PG8_STAGE(PG8_SA(1, 1), a1 + hstepA, voffA);
            PG8_WAIT_V(8); PG8_WAIT_L(0); PG8_BAR; PG8_MMA(0, 0, At, B0); PG8_MMA(0, 1, At, B1); PG8_BAR; PG8_SCHED;
            PG8_LDA(At, 0, 1); PG8_STAGE(PG8_SB(0, 0), b2, voffB); PG8_STAGE(PG8_SB(0, 1), b2 + hstepB, voffB); PG8_STAGE(PG8_SA(0, 0), a2, voffA);
            PG8_WAIT_V(8); PG8_WAIT_L(0); PG8_BAR; PG8_MMA(1, 0, At, B0); PG8_MMA(1, 1, At, B1); PG8_BAR; PG8_SCHED;
            PG8_LDB(B0, 1, 0); PG8_LDB(B1, 1, 1); PG8_SCHED; PG8_LDA(At, 1, 0); PG8_STAGE(PG8_SA(0, 1), a2 + hstepA, voffA);
            PG8_WAIT_V(8); PG8_WAIT_L(0); PG8_BAR; PG8_MMA(0, 0, At, B0); PG8_MMA(0, 1, At, B1); PG8_BAR; PG8_SCHED;
            PG8_LDA(At, 1, 1); PG8_STAGE(PG8_SB(1, 0), b3, voffB); PG8_STAGE(PG8_SB(1, 1), b3 + hstepB, voffB); PG8_STAGE(PG8_SA(1, 0), a3, voffA);
            PG8_WAIT_V(8); PG8_WAIT_L(0); PG8_BAR; PG8_MMA(1, 0, At, B0); PG8_MMA(1, 1, At, B1); PG8_BAR; PG8_SCHED;
            } else {
            PG8_LDB(B0, 0, 0); PG8_SCHED; PG8_LDA(At, 0, 0); PG8_STAGE(PG8_SA(1, 1), a1 + hstepA, voffA);
            PG8_WAIT_L(8); PG8_BAR; PG8_WAIT_L(0); PG8_MMA(0, 0, At, B0); PG8_BAR; PG8_SCHED;
            PG8_LDB(B1, 0, 1); PG8_STAGE(PG8_SB(0, 0), b2, voffB);
            PG8_BAR; PG8_WAIT_L(0); PG8_MMA(0, 1, At, B1); PG8_BAR;
            PG8_LDA(At, 0, 1); PG8_STAGE(PG8_SA(0, 0), a2, voffA);
            PG8_BAR; PG8_WAIT_L(0); PG8_MMA(1, 0, At, B0); PG8_BAR; PG8_SCHED;
            PG8_STAGE(PG8_SB(0, 1), b2 + hstepB, voffB);
            PG8_WAIT_V(6); PG8_BAR; PG8_MMA(1, 1, At, B1); PG8_BAR;
            PG8_LDB(B0, 1, 0); PG8_SCHED; PG8_LDA(At, 1, 0); PG8_STAGE(PG8_SA(0, 1), a2 + hstepA, voffA);
            PG8_WAIT_L(8); PG8_BAR; PG8_WAIT_L(0); PG8_MMA(0, 0, At, B0); PG8_BAR; PG8_SCHED;
            PG8_LDB(B1, 1, 1); PG8_STAGE(PG8_SB(1, 0), b3, voffB);
            PG8_BAR; PG8_WAIT_L(0); PG8_MMA(0, 1, At, B1); PG8_BAR;
            PG8_LDA(At, 1, 1); PG8_STAGE(PG8_SA(1, 0), a3, voffA);
            PG8_BAR; PG8_WAIT_L(0); PG8_MMA(1, 0, At, B0); PG8_BAR; PG8_SCHED;
            PG8_STAGE(PG8_SB(1, 1), b3 + hstepB, voffB);
            PG8_WAIT_V(6); PG8_BAR; PG8_MMA(1, 1, At, B1); PG8_BAR;
            }
        }
        if constexpr (ALIGN_EPI) { if (wr == 0) PG8_BAR; }
        { int tz = threadIdx.x; asm volatile("" : "+v"(tz));
          const int wz = __builtin_amdgcn_readfirstlane(tz >> 6), lz = tz & 63; E(acc, cur, wz >> 2, wz & 3, lz & 15, lz >> 4); }
        if (!has_next) break;
#pragma unroll
        for (int a = 0; a < 2; ++a)
#pragma unroll
            for (int b = 0; b < 2; ++b)
#pragma unroll
                for (int m = 0; m < 4; ++m)
#pragma unroll
                    for (int n = 0; n < 2; ++n) acc[a][b][m][n] = (f32x4){0.f, 0.f, 0.f, 0.f};
        cur = nxt; cA = nA; cB = nB; ++ui; nt = PG8_NT(cur);
        if constexpr (ALIGN_EPI) { if (wr == 1) PG8_BAR; }
    }
    PG8_WAIT_V(0);
    if constexpr (!ALIGN_EPI) { if (wr == 0) PG8_BAR; }
    PG8_BAR;
#undef PG8_SA
#undef PG8_SB
#undef PG8_STAGE
#undef PG8_LDA
#undef PG8_LDB
#undef PG8_MMA
#undef PG8_WAIT_V
#undef PG8_WAIT_L
#undef PG8_BAR
#undef PG8_SCHED
#undef PG8_APTR
#undef PG8_BPTR
#undef PG8_KOFF
#undef PG8_NT
}

template <int ACT> struct EpiAct {
    static constexpr bool PERM = true;
    bf16_t* O; int ldc;
    __device__ __forceinline__ void operator()(const f32x4 (&acc)[2][2][4][2], const Unit& u, int wr, int wc, int fr, int fq) const {
        const int row0 = u.pm * BM + wr * 64 + fr, col0 = u.pn * BM + wc * 32 + 8 * fq;
#pragma unroll
        for (int ai = 0; ai < 2; ++ai)
#pragma unroll
            for (int m = 0; m < 4; ++m) { bf16_t* rowp = O + (size_t)(row0 + ai * HALF + m * 16) * ldc + col0;
#pragma unroll
                for (int bj = 0; bj < 2; ++bj) { f32x4 v0 = acc[ai][bj][m][0], v1 = acc[ai][bj][m][1];
                    if (ACT == 1) {
#pragma unroll
                        for (int j = 0; j < 4; ++j) { const float a = fmaxf(v0[j], 0.f), b = fmaxf(v1[j], 0.f); v0[j] = a * a; v1[j] = b * b; } }
                    u32x4 w; w.x = cvt_pk_bf16(v0[0], v0[1]); w.y = cvt_pk_bf16(v0[2], v0[3]); w.z = cvt_pk_bf16(v1[0], v1[1]); w.w = cvt_pk_bf16(v1[2], v1[3]);
                    *(u32x4*)(rowp + bj * HALF) = w; } }
    }
};
constexpr long long RN_DXN = (471ll - 399ll) << 20;
constexpr long long RN_DSLOT = (838ll - 399ll) << 20;
constexpr long long RN_DCNT = 131072ll - (399ll << 20);
constexpr int RN_LDS = 131072 + 4096;
template <bool XF32, int FUSE = 0  > struct EpiResidT {
    static constexpr bool PERM = true;
    bf16_t* X; const float* mods_l; int gidx; float* slab; const float* xin; const float* ng; int nsh_off; unsigned want; LAS unsigned char* lds;
    __device__ __forceinline__ void fuse_tail(f32x4 (&acc)[2][2][4][2], const float (&ssq)[2][4], const Unit& u, int wr, int wc, int fr, int fq, int mi, int row0, int col0) const {
        LAS float* P = (LAS float*)(lds + RN_LDS); LAS float* S = P + 1024; LAS unsigned* flag = (LAS unsigned*)(S + 256);
        const int wid = wr * 4 + wc, lane = fq * 16 + fr;
#pragma unroll
        for (int ai = 0; ai < 2; ++ai)
#pragma unroll
            for (int m = 0; m < 4; ++m) { float t = ssq[ai][m]; t += __shfl_xor(t, 16); t += __shfl_xor(t, 32);
                if (fq == 0) P[(ai * HALF + wr * 64 + m * 16 + fr) * 4 + wc] = t; }
        asm volatile("s_waitcnt lgkmcnt(0)" ::: "memory"); __builtin_amdgcn_s_barrier(); asm volatile("" ::: "memory");
        const int row = wid * 32 + (lane & 31);
        unsigned* slots = (unsigned*)((char*)X + RN_DSLOT) + ((size_t)(u.pm * BM + row) * 8);
        unsigned* pc = (unsigned*)((char*)X + RN_DCNT) + 64 * u.pm;
        if (lane < 32) { const f32x4 p = *(const LAS f32x4*)(P + row * 4); const float t = (p[0] + p[1]) + (p[2] + p[3]);
            __hip_atomic_store(slots + u.pn, __builtin_bit_cast(unsigned, t), __ATOMIC_RELAXED, __HIP_MEMORY_SCOPE_AGENT); }
        asm volatile("s_waitcnt vmcnt(0)" ::: "memory");
        if (lane == 0) __hip_atomic_fetch_add(pc, 1u, __ATOMIC_RELAXED, __HIP_MEMORY_SCOPE_AGENT);
        if (FUSE == 1 && !XF32) {
            int r0o = row0; asm volatile("" : "+v"(r0o)); bf16_t* xb = X + (size_t)r0o * D + col0;
#pragma unroll
            for (int ai = 0; ai < 2; ++ai)
#pragma unroll
                for (int m = 0; m < 4; ++m)
#pragma unroll
                    for (int bj = 0; bj < 2; ++bj) { const f32x4 v0 = acc[ai][bj][m][0], v1 = acc[ai][bj][m][1];
                        u32x4 w; w.x = cvt_pk_bf16(v0[0], v0[1]); w.y = cvt_pk_bf16(v0[2], v0[3]); w.z = cvt_pk_bf16(v1[0], v1[1]); w.w = cvt_pk_bf16(v1[2], v1[3]);
                        *(u32x4*)(xb + (size_t)(ai * HALF + m * 16) * D + bj * HALF) = w; }
        }
        if (wid == 0) { unsigned sp = 0u;
            while ((unsigned)__builtin_amdgcn_readfirstlane((int)__hip_atomic_load(pc, __ATOMIC_RELAXED, __HIP_MEMORY_SCOPE_AGENT)) < want) { __builtin_amdgcn_s_sleep(1); if (++sp > (1u << 18)) break; }
            __builtin_amdgcn_fence(__ATOMIC_ACQUIRE, "agent"); }
        asm volatile("s_waitcnt lgkmcnt(0)" ::: "memory"); __builtin_amdgcn_s_barrier(); asm volatile("" ::: "memory");
        if (lane < 32) { float t = 0.f;
#pragma unroll
            for (int k = 0; k < 8; ++k) t += __builtin_bit_cast(float, __hip_atomic_load(slots + k, __ATOMIC_RELAXED, __HIP_MEMORY_SCOPE_AGENT));
            S[row] = rsqrtf(t * (1.f / D) + 1e-6f); }
        asm volatile("s_waitcnt lgkmcnt(0)" ::: "memory"); __builtin_amdgcn_s_barrier(); asm volatile("" ::: "memory");
        if (FUSE == 2) {
            float* ob = slab + (size_t)row0 * D + col0;
#pragma unroll
            for (int bj = 0; bj < 2; ++bj) { const f32x4 G0 = *(const f32x4*)(ng + col0 + bj * HALF), G1 = *(const f32x4*)(ng + col0 + bj * HALF + 4);
#pragma unroll
                for (int ai = 0; ai < 2; ++ai)
#pragma unroll
                    for (int m = 0; m < 4; ++m) { const float rstd = S[ai * HALF + wr * 64 + m * 16 + fr];
                        *(f32x4*)(ob + (size_t)(ai * HALF + m * 16) * D + bj * HALF) = acc[ai][bj][m][0] * rstd * G0; *(f32x4*)(ob + (size_t)(ai * HALF + m * 16) * D + bj * HALF + 4) = acc[ai][bj][m][1] * rstd * G1; } }
            return;
        }
        bf16_t* XN = (bf16_t*)((char*)X + RN_DXN);
        const float* sh = mods_l + nsh_off + (size_t)mi * MODW + col0;
#pragma unroll
        for (int bj = 0; bj < 2; ++bj) { f32x4 GG[2], SS[2];
#pragma unroll
            for (int n = 0; n < 2; ++n) { GG[n] = *(const f32x4*)(ng + col0 + bj * HALF + 4 * n) * (*(const f32x4*)(sh + D + bj * HALF + 4 * n) + 1.f); SS[n] = *(const f32x4*)(sh + bj * HALF + 4 * n); }
#pragma unroll
            for (int ai = 0; ai < 2; ++ai)
#pragma unroll
                for (int m = 0; m < 4; ++m) { const float rstd = S[ai * HALF + wr * 64 + m * 16 + fr];
                    const f32x4 h0 = acc[ai][bj][m][0] * rstd * GG[0] + SS[0], h1 = acc[ai][bj][m][1] * rstd * GG[1] + SS[1];
                    u32x4 w; w.x = cvt_pk_bf16(h0[0], h0[1]); w.y = cvt_pk_bf16(h0[2], h0[3]); w.z = cvt_pk_bf16(h1[0], h1[1]); w.w = cvt_pk_bf16(h1[2], h1[3]);
                    *(u32x4*)(XN + (size_t)(row0 + ai * HALF + m * 16) * D + col0 + bj * HALF) = w; } }
    }
    __device__ __forceinline__ void operator()(f32x4 (&acc)[2][2][4][2], const Unit& u, int wr, int wc, int fr, int fq) const {
        if (u.sw) {
            bf16_t* base = (bf16_t*)slab + (size_t)(((u.pm - 32) * 8 + u.pn) * 8 + u.ks) * 65536 + (size_t)(wr * 64 + fr) * 256 + wc * 32 + 8 * fq;
#pragma unroll
            for (int ai = 0; ai < 2; ++ai)
#pragma unroll
                for (int m = 0; m < 4; ++m)
#pragma unroll
                    for (int bj = 0; bj < 2; ++bj) { const f32x4 v0 = acc[ai][bj][m][0], v1 = acc[ai][bj][m][1];
                        u32x4 w; w.x = cvt_pk_bf16(v0[0], v0[1]); w.y = cvt_pk_bf16(v0[2], v0[3]); w.z = cvt_pk_bf16(v1[0], v1[1]); w.w = cvt_pk_bf16(v1[2], v1[3]);
                        *(u32x4*)(base + (size_t)(ai * HALF + m * 16) * 256 + bj * HALF) = w; }
            return;
        }
        const int row0 = u.pm * BM + wr * 64 + fr, col0 = u.pn * BM + wc * 32 + 8 * fq;
        const int mi = u.pm < 32 ? (u.pm >> 3) : 4;
        const float* gt = mods_l + (size_t)mi * MODW + gidx * D + col0;
        f32x4 gv[2][2];
#pragma unroll
        for (int bj = 0; bj < 2; ++bj)
#pragma unroll
            for (int n = 0; n < 2; ++n) gv[bj][n] = *(const f32x4*)(gt + bj * HALF + 4 * n);
        float ssq[2][4];
#pragma unroll
        for (int ai = 0; ai < 2; ++ai)
#pragma unroll
            for (int m = 0; m < 4; ++m) ssq[ai][m] = 0.f;
        if (XF32) {
#pragma unroll
            for (int am = 0; am < 4; ++am) { const int ai = am >> 1, m0 = (am & 1) * 2;
                f32x4 xf[2][2][2];
#pragma unroll
                for (int mm = 0; mm < 2; ++mm)
#pragma unroll
                    for (int bj = 0; bj < 2; ++bj)
#pragma unroll
                        for (int n = 0; n < 2; ++n) xf[mm][bj][n] = *(const f32x4*)(xin + (size_t)(row0 + ai * HALF + (m0 + mm) * 16) * D + col0 + bj * HALF + 4 * n);
                __builtin_amdgcn_sched_barrier(0);
#pragma unroll
                for (int mm = 0; mm < 2; ++mm)
#pragma unroll
                    for (int bj = 0; bj < 2; ++bj) { const f32x4 v0 = xf[mm][bj][0] + gv[bj][0] * acc[ai][bj][m0 + mm][0], v1 = xf[mm][bj][1] + gv[bj][1] * acc[ai][bj][m0 + mm][1];
                        if (FUSE) { acc[ai][bj][m0 + mm][0] = v0; acc[ai][bj][m0 + mm][1] = v1; ssq[ai][m0 + mm] += ((v0[0] * v0[0] + v0[1] * v0[1]) + (v0[2] * v0[2] + v0[3] * v0[3])) + ((v1[0] * v1[0] + v1[1] * v1[1]) + (v1[2] * v1[2] + v1[3] * v1[3])); }
                        u32x4 w; w.x = cvt_pk_bf16(v0[0], v0[1]); w.y = cvt_pk_bf16(v0[2], v0[3]); w.z = cvt_pk_bf16(v1[0], v1[1]); w.w = cvt_pk_bf16(v1[2], v1[3]);
                        *(u32x4*)(X + (size_t)(row0 + ai * HALF + (m0 + mm) * 16) * D + col0 + bj * HALF) = w; }
                __builtin_amdgcn_sched_barrier(0);
            }
            if (FUSE) fuse_tail(acc, ssq, u, wr, wc, fr, fq, mi, row0, col0);
            return;
        }
#pragma unroll
        for (int ai = 0; ai < 2; ++ai) {
            u32x4 xo[4][2];
#pragma unroll
            for (int m = 0; m < 4; ++m)
#pragma unroll
                for (int bj = 0; bj < 2; ++bj) xo[m][bj] = *(const u32x4*)(X + (size_t)(row0 + ai * HALF + m * 16) * D + col0 + bj * HALF);
            __builtin_amdgcn_sched_barrier(0);
#pragma unroll
            for (int m = 0; m < 4; ++m)
#pragma unroll
                for (int bj = 0; bj < 2; ++bj) { const u32x4 x = xo[m][bj];
                    const f32x4 x0 = {bf_lo(x.x), bf_hi(x.x), bf_lo(x.y), bf_hi(x.y)}, x1 = {bf_lo(x.z), bf_hi(x.z), bf_lo(x.w), bf_hi(x.w)};
                    const f32x4 v0 = x0 + gv[bj][0] * acc[ai][bj][m][0], v1 = x1 + gv[bj][1] * acc[ai][bj][m][1];
                    if (FUSE) { acc[ai][bj][m][0] = v0; acc[ai][bj][m][1] = v1; ssq[ai][m] += ((v0[0] * v0[0] + v0[1] * v0[1]) + (v0[2] * v0[2] + v0[3] * v0[3])) + ((v1[0] * v1[0] + v1[1] * v1[1]) + (v1[2] * v1[2] + v1[3] * v1[3])); }
                    if (FUSE == 0) { u32x4 w; w.x = cvt_pk_bf16(v0[0], v0[1]); w.y = cvt_pk_bf16(v0[2], v0[3]); w.z = cvt_pk_bf16(v1[0], v1[1]); w.w = cvt_pk_bf16(v1[2], v1[3]);
                    *(u32x4*)(X + (size_t)(row0 + ai * HALF + m * 16) * D + col0 + bj * HALF) = w; } }
            __builtin_amdgcn_sched_barrier(0); asm volatile("" ::: "memory");
        }
        if (FUSE) fuse_tail(acc, ssq, u, wr, wc, fr, fq, mi, row0, col0);
    }
};
struct EpiQKV {
    static constexpr bool PERM = true;
    bf16_t* Q; bf16_t* KT; bf16_t* VT; float qscale;
    __device__ __forceinline__ void operator()(const f32x4 (&acc)[2][2][4][2], const Unit& u, int wr, int wc, int fr, int fq) const {
#pragma unroll
        for (int ai = 0; ai < 2; ++ai)
#pragma unroll
            for (int m = 0; m < 4; ++m)
#pragma unroll
                for (int bj = 0; bj < 2; ++bj) {
                    const int r = u.pm * BM + ai * HALF + wr * 64 + m * 16 + fr;
                    const int c = u.pn * BM + bj * HALF + wc * 32 + 8 * fq;
                    bf16_t* dst; float sc = 1.f;
                    if (!u.sw) {
                        if (u.pn < 8) { dst = Q + (size_t)r * D + c; sc = qscale; }
                        else { const int cc = c - D, h = cc >> 7, ch = (cc & 127) >> 3;
                            dst = KT + ((size_t)((r >> 3) * NH + h)) * 1024 + (ch >> 2) * 256 + ((r >> 2) & 1) * 128 + (r & 3) * 32 + (ch & 3) * 8; }
                    } else { const int h = r >> 7, d = r & 127;
                        dst = VT + ((size_t)(((c >> 3) * NH + h) * 8 + (d >> 4))) * 128 + (d & 15) * 8; }
                    const f32x4 v0 = acc[ai][bj][m][0] * sc, v1 = acc[ai][bj][m][1] * sc;
                    u32x4 w; w.x = cvt_pk_bf16(v0[0], v0[1]); w.y = cvt_pk_bf16(v0[2], v0[3]); w.z = cvt_pk_bf16(v1[0], v1[1]); w.w = cvt_pk_bf16(v1[2], v1[3]);
                    *(u32x4*)dst = w; }
    }
};
struct EpiGates {
    static constexpr bool PERM = true;
    const bf16_t* UC; unsigned* LB; const float* ba; const float* bx; const float* cA;
    __device__ __forceinline__ void operator()(const f32x4 (&acc)[2][2][4][2], const Unit& u, int wr, int wc, int fr, int fq) const {
        const int blk = u.pn >> 2, dir = (u.pn >> 1) & 1, half = u.pn & 1;
        const int row0 = u.pm * BM + wr * 64 + fr;
        unsigned* lb_d = LB + (size_t)dir * M * LW;
        const int ch0 = blk * 256 + half * 128 + wc * 32 + 8 * fq;
        unsigned pba[4], pbx[4], pca[4];
#pragma unroll
        for (int n = 0; n < 2; ++n) { const f32x4 t0 = *(const f32x4*)(ba + dir * LW + ch0 + 4 * n), t1 = *(const f32x4*)(bx + dir * LW + ch0 + 4 * n), t2 = *(const f32x4*)(cA + dir * LW + ch0 + 4 * n);
            pca[2 * n] = pk2(t2[0], t2[1]); pca[2 * n + 1] = pk2(t2[2], t2[3]);
            constexpr float NL = -1.4426950408889634f;
            pba[2 * n] = pk2(NL * t0[0], NL * t0[1]); pba[2 * n + 1] = pk2(NL * t0[2], NL * t0[3]); pbx[2 * n] = pk2(NL * t1[0], NL * t1[1]); pbx[2 * n + 1] = pk2(NL * t1[2], NL * t1[3]); }
        u32x4 ucw[2][2];
#define GATES_UCLOAD(buf, am_) do { _Pragma("unroll") for (int mm = 0; mm < 2; ++mm) ucw[buf][mm] = *(const u32x4*)(UC + (size_t)(row0 + ((am_) >> 1) * HALF + (((am_) & 1) * 2 + mm) * 16) * LW + ch0); } while (0)
        GATES_UCLOAD(0, 0);
#pragma unroll
        for (int am = 0; am < 4; ++am) { const int ai = am >> 1, m0 = (am & 1) * 2;
            if (am + 1 < 4) GATES_UCLOAD((am + 1) & 1, am + 1);
            __builtin_amdgcn_sched_barrier(0);
#pragma unroll
            for (int mm = 0; mm < 2; ++mm) { const int m = m0 + mm; const size_t ro = (size_t)(row0 + ai * HALF + m * 16) * LW + ch0;
                const unsigned uw[4] = {ucw[am & 1][mm].x, ucw[am & 1][mm].y, ucw[am & 1][mm].z, ucw[am & 1][mm].w};
                unsigned wv[8];
#pragma unroll
                for (int n = 0; n < 2; ++n) {
#pragma unroll
                    for (int j = 0; j < 4; ++j) { const int pi = 2 * n + (j >> 1);
                        const float ucv = (j & 1) ? bf_hi(uw[pi]) : bf_lo(uw[pi]), vb_a = (j & 1) ? bf_hi(pba[pi]) : bf_lo(pba[pi]), vb_x = (j & 1) ? bf_hi(pbx[pi]) : bf_lo(pbx[pi]);
                        const float rr = fast_rcp(1.f + fast_exp2(fmaf(acc[ai][0][m][n][j], -1.4426950408889634f, vb_a))), ig = fast_rcp(1.f + fast_exp2(fmaf(acc[ai][1][m][n][j], -1.4426950408889634f, vb_x)));
                        wv[4 * n + j] = cvt_pk_bf16(rr * ((j & 1) ? bf_hi(pca[pi]) : bf_lo(pca[pi])), ig * ucv); } }
                *(u32x4*)(lb_d + ro) = (u32x4){wv[0], wv[1], wv[2], wv[3]}; *(u32x4*)(lb_d + ro + 4) = (u32x4){wv[4], wv[5], wv[6], wv[7]}; }
            __builtin_amdgcn_sched_barrier(0);
        }
#undef GATES_UCLOAD
    }
};
}

#define XB_TMO      128
#define XB_XCNT(j)  (256  + 64 * (j))
#define XB_XSUB(j)  (1280 + 64 * (j))
#define XB_XGEN(j)  (2304 + 64 * (j))
#define XB_TOP      3328
#define XB_TOPGEN   3392
#define XCD_BAR_WORDS 3456
#define XB_SPIN_CAP (1u << 18)
__device__ __forceinline__ unsigned xb_ld(unsigned* p)              { return __hip_atomic_load(p, __ATOMIC_RELAXED, __HIP_MEMORY_SCOPE_AGENT); }
__device__ __forceinline__ unsigned xb_add(unsigned* p, unsigned v) { return __hip_atomic_fetch_add(p, v, __ATOMIC_RELAXED, __HIP_MEMORY_SCOPE_AGENT); }
__device__ __forceinline__ unsigned xb_xcc_id() { return (unsigned)__builtin_amdgcn_s_getreg((3 << 11) | 20) & 0xFu; }
#define XB_SPIN(cond, bar) do { unsigned _sp = 0; while (cond) { __builtin_amdgcn_s_sleep(1); \
    if ((++_sp & 255u) == 0u) { if (xb_ld(&(bar)[XB_TMO])) break; if (_sp > XB_SPIN_CAP) { atomicAdd(&(bar)[XB_TMO], 1u); break; } } } } while (0)
struct XcdBarrier { unsigned* bar; unsigned x; volatile LAS unsigned* st; };
__device__ __forceinline__ XcdBarrier xcd_barrier_post(unsigned* bar, volatile LAS unsigned* st) {
    XcdBarrier b; b.bar = bar; b.x = xb_xcc_id(); b.st = st;
    if (threadIdx.x == 0) (void)xb_add(&bar[XB_XCNT(b.x)], 1u);
    return b;
}
__device__ __forceinline__ void xcd_barrier_complete(unsigned* bar, unsigned x, unsigned& nloc, unsigned& nx) {
    const unsigned G = gridDim.x * gridDim.y * gridDim.z;
    unsigned sum, cnt, mine, sp = 0u;
    for (;;) {
        sum = 0u; cnt = 0u; mine = 0u;
#pragma unroll
        for (unsigned j = 0; j < 16; ++j) { const unsigned c = xb_ld(&bar[XB_XCNT(j)]); sum += c; cnt += (c > 0u) ? 1u : 0u; mine = (j == x) ? c : mine; }
        if (sum == G) break;
        __builtin_amdgcn_s_sleep(1);
        if ((++sp & 255u) == 0u) { if (xb_ld(&bar[XB_TMO])) break; if (sp > XB_SPIN_CAP) { atomicAdd(&bar[XB_TMO], 1u); break; } }
    }
    nloc = mine > 0u ? mine : 1u; nx = cnt > 0u ? cnt : 1u;
}
__device__ __forceinline__ void xcd_barrier(const XcdBarrier& b) {
    asm volatile("s_waitcnt vmcnt(0)" ::: "memory");
    __syncthreads();
    if (threadIdx.x == 0) {
        unsigned* bar = b.bar;
        __builtin_amdgcn_s_waitcnt(0);
        unsigned nloc = b.st[0], nx = b.st[1];
        if (nloc == 0u) { xcd_barrier_complete(bar, b.x, nloc, nx); b.st[0] = nloc; b.st[1] = nx; }
        const unsigned old = xb_add(&bar[XB_XSUB(b.x)], 1u);
        const unsigned gen = old / nloc;
        if (old + 1u == (gen + 1u) * nloc) {
            __builtin_amdgcn_fence(__ATOMIC_RELEASE, "agent");
            asm volatile("s_waitcnt vmcnt(0)" ::: "memory");
            const unsigned og = xb_add(&bar[XB_TOP], 1u);
            const unsigned tg = og / nx;
            if (og + 1u == (tg + 1u) * nx) xb_add(&bar[XB_TOPGEN], 1u);
            else XB_SPIN(xb_ld(&bar[XB_TOPGEN]) == tg, bar);
            __builtin_amdgcn_fence(__ATOMIC_ACQUIRE, "agent");
            xb_add(&bar[XB_XGEN(b.x)], 1u);
            asm volatile("s_waitcnt vmcnt(0)" ::: "memory");
        } else {
            XB_SPIN(xb_ld(&bar[XB_XGEN(b.x)]) == gen, bar);
            __builtin_amdgcn_fence(__ATOMIC_ACQUIRE, "agent");
            asm volatile("s_waitcnt vmcnt(0)" ::: "memory");
        }
    }
    __syncthreads();
}

constexpr size_t MiB = 1u << 20;
constexpr size_t WS_CTL = 0, CTL_ZERO_BYTES = 1 * MiB;
constexpr size_t WS_MODS = 1 * MiB;
constexpr size_t WS_WIN = 2 * MiB;
constexpr size_t WS_WG = 46 * MiB;
constexpr size_t WS_WOUT = 57 * MiB;
constexpr size_t WS_WQKV = 79 * MiB;
constexpr size_t WS_WO = 127 * MiB;
constexpr size_t WS_W1 = 143 * MiB;
constexpr size_t WS_W2 = 271 * MiB;
constexpr size_t WS_X = 399 * MiB;
constexpr size_t WS_XN = 471 * MiB;
constexpr size_t WS_BIG = 507 * MiB;
constexpr size_t WS_O = 651 * MiB;
constexpr size_t WS_CA = 687 * MiB;
constexpr size_t WS_UC = 688 * MiB;
constexpr size_t WS_LA = 738 * MiB;
constexpr size_t WS_BB = 838 * MiB;
constexpr size_t WS_Z = 938 * MiB;
constexpr size_t WS_AGGA = 988 * MiB, WS_AGGH = 995 * MiB, WS_CARRY = 1002 * MiB;
constexpr size_t WS_SLAB = 1009 * MiB;
constexpr size_t WS_FAST_END = 1073 * MiB;
constexpr size_t WS_NV = 688 * MiB;
static_assert((long long)WS_XN - (long long)WS_X == pg8::RN_DXN && (long long)WS_BB - (long long)WS_X == pg8::RN_DSLOT && (long long)WS_CTL + 131072 - (long long)WS_X == pg8::RN_DCNT && CTL_ZERO_BYTES >= 131072 + 32 * 256, "fused-norm exchange: slots (256 KiB at WS_BB, otherwise unused), panel counters in CTL");
constexpr int CW_BAR = 4096;
constexpr int CW_SPLIT = 16384;

constexpr int NWAVES = 8, NTHREADS = 512;
constexpr int LDS_BYTES = 147456;
constexpr int LDS_MISC = 131072;
constexpr int PH_PROLOGUE = 0, PH_NORM0 = 1, PH_LAYER0 = 2, PH_PER_LAYER = 12, PH_END = PH_LAYER0 + PH_PER_LAYER * DEPTH;

struct Args {
    const float* in[23]; float* out; unsigned char* ws; int ph_lo, ph_hi;
};

__device__ __forceinline__ float wave_sum(float v) {
#pragma unroll
    for (int o = 1; o < 64; o <<= 1) v += __shfl_xor(v, o);
    return v;
}
__device__ __forceinline__ void transpose_item(const float* W, int K, int N, bf16_t* WT, int k0, int n0, int dst_row0, int lane) {
    const int kb = lane & 7, nl = lane >> 3;
    const float* src = W + (size_t)(k0 + 8 * kb) * N + n0 + 4 * nl;
    f32x4 v[8];
#pragma unroll
    for (int i = 0; i < 8; ++i) v[i] = __builtin_nontemporal_load((const f32x4*)(src + (size_t)i * N));
    bf16_t* dst = WT + (size_t)(dst_row0 + 4 * nl) * K + k0 + 8 * kb;
#pragma unroll
    for (int j = 0; j < 4; ++j) { u32x4 o; o.x = pk2(v[0][j], v[1][j]); o.y = pk2(v[2][j], v[3][j]); o.z = pk2(v[4][j], v[5][j]); o.w = pk2(v[6][j], v[7][j]);
        *(u32x4*)(dst + (size_t)j * K) = o; }
}
__device__ __forceinline__ void transpose_group(int r, const float* src, int K, int N, bf16_t* dst, int lane) {
    const int nblk = N / 32, per = (K / 64) * nblk; const int mat = r / per, q = r % per, kb = q / nblk, nb = q % nblk;
    transpose_item(src + (size_t)mat * K * N, K, N, dst + (size_t)mat * N * K, 64 * kb, 32 * nb, 32 * nb, lane);
}


__device__ __forceinline__ unsigned char* tabp(volatile LAS unsigned* ptab, int i) {
    unsigned base = (unsigned)(size_t)ptab; asm volatile("" : "+v"(base));
    const u32x2 w = *(volatile LAS u32x2*)(base + 8u * (unsigned)i);
    return (unsigned char*)(GAS unsigned char*)(((unsigned long long)(unsigned)__builtin_amdgcn_readfirstlane((int)w.y) << 32) | (unsigned)__builtin_amdgcn_readfirstlane((int)w.x));
}
constexpr int C_W = (D / 64) * (FF / 32), C_IN = (D / 64) * (2 * LW / 32), C_OUT = (LW / 64) * (D / 32), C_QKV = (D / 64) * (3 * D / 32), C_O = (D / 64) * (D / 32), C_G = 2 * NLB * 2 * 32;
struct ConvAddr { const float* src; bf16_t* dst; int N, K; };
__device__ __forceinline__ ConvAddr conv_addr(volatile LAS unsigned* ptab, int kind, int l, int r, int lane) {
    unsigned char* ws = tabp(ptab, 24); const int kbl = lane & 7, nl = lane >> 3; ConvAddr a;
    if (kind == 6) { const int matl = r >> 5, q = r & 31, kb = q >> 3, nb = q & 7;
        const int gsel = matl & 1, db = matl >> 1, blk = db % NLB, d = db / NLB;
        const float* s0 = (const float*)tabp(ptab, gsel ? 16 : 14) + (size_t)((l * 2 + d) * NLB + blk) * LB * LB;
        const int n0 = 32 * nb, half = n0 >> 7, chn = n0 & 127, drow = blk * 1024 + ((d * 2 + half) * 2 + gsel) * 128 + chn;
        a.N = LB; a.K = LB; a.src = s0 + (size_t)(64 * kb + 8 * kbl) * LB + n0 + 4 * nl;
        a.dst = (bf16_t*)(ws + WS_WG) + (size_t)l * (NLB * 1024) * LB + (size_t)(drow + 4 * nl) * LB + 64 * kb + 8 * kbl;
        return a; }
    int K, N, inp; size_t wso;
    switch (kind) { case 0: K = D; N = FF; inp = 8; wso = WS_W1; break; case 1: K = FF; N = D; inp = 9; wso = WS_W2; break; case 2: K = D; N = 2 * LW; inp = 10; wso = WS_WIN; break;
                    case 3: K = LW; N = D; inp = 18; wso = WS_WOUT; break; case 4: K = D; N = 3 * D; inp = 19; wso = WS_WQKV; break; default: K = D; N = D; inp = 21; wso = WS_WO; break; }
    const int nblk = N / 32, kb = r / nblk, nb = r % nblk;
    a.N = N; a.K = K; a.src = (const float*)tabp(ptab, inp) + (size_t)l * K * N + (size_t)(64 * kb + 8 * kbl) * N + 32 * nb + 4 * nl;
    a.dst = (bf16_t*)(ws + wso) + (size_t)l * N * K + (size_t)(32 * nb + 4 * nl) * K + 64 * kb + 8 * kbl;
    return a;
}
__device__ __forceinline__ void conv_load(const ConvAddr& a, f32x4 (&v)[8]) {
#pragma unroll
    for (int i = 0; i < 8; ++i) v[i] = __builtin_nontemporal_load((const f32x4*)(a.src + (size_t)i * a.N));
}
__device__ __forceinline__ void conv_store(const ConvAddr& a, const f32x4 (&v)[8]) {
#pragma unroll
    for (int j = 0; j < 4; ++j) { u32x4 o; o.x = pk2(v[0][j], v[1][j]); o.y = pk2(v[2][j], v[3][j]); o.z = pk2(v[4][j], v[5][j]); o.w = pk2(v[6][j], v[7][j]);
        *(u32x4*)(a.dst + (size_t)j * a.K) = o; }
}
#define CSEG(kind, l, cnt) if (!fnd_ && r < (cnt)) { ck_ = (kind); cl_ = (l); fnd_ = true; } else if (!fnd_) r -= (cnt)
#define CSEGO(kind, l, off, cnt) if (!fnd_ && r < (cnt)) { ck_ = (kind); cl_ = (l); r += (off); fnd_ = true; } else if (!fnd_) r -= (cnt)
#define CONV_RUN(it0, st, nit, SEGS) do { for (int it_ = (it0); it_ < (nit); it_ += 2 * (st)) { ConvAddr ca_, cb_; f32x4 va_[8], vb_[8]; const bool two_ = it_ + (st) < (nit); \
        { int r = it_, ck_ = 0, cl_ = 0; bool fnd_ = false; SEGS; ca_ = conv_addr(ptab, ck_, cl_, r, lane); } conv_load(ca_, va_); \
        { int r = two_ ? it_ + (st) : it_, ck_ = 0, cl_ = 0; bool fnd_ = false; SEGS; cb_ = conv_addr(ptab, ck_, cl_, r, lane); } conv_load(cb_, vb_); \
        __builtin_amdgcn_sched_barrier(0); conv_store(ca_, va_); if (two_) conv_store(cb_, vb_); } } while (0)
__device__ __forceinline__ void ada_fill_ssil(volatile LAS unsigned* ptab, LAS unsigned char* lds, int tid) {
    const float* c = (const float*)tabp(ptab, 1); const float* c_ctx = (const float*)tabp(ptab, 3); LAS float* ssil = (LAS float*)lds;
    for (int i = tid; i < 5 * D; i += NTHREADS) { const int m = i / D, k = i % D; const float v = m < 4 ? c[m * D + k] : c_ctx[k]; ssil[i] = v / (1.f + expf(-v)); }
    __syncthreads();
}
constexpr int ADA_IT = 96;
template <int COLS>
__device__ __forceinline__ void ada_wg_item_t(volatile LAS unsigned* ptab, LAS unsigned char* lds, int layer, int col0, int tid) {
    int lane = tid & 63; asm volatile("" : "+v"(lane)); const int wave = __builtin_amdgcn_readfirstlane(tid >> 6);
    const float* ada_w = (const float*)tabp(ptab, 4); const float* ada_b = (const float*)tabp(ptab, 5); float* mods = (float*)(tabp(ptab, 24) + WS_MODS);
    LAS float* ssil = (LAS float*)lds; LAS float* red = (LAS float*)(lds + 40960);
    constexpr int LPR = COLS / 4, RPI = 64 / LPR;
    const int kr = lane / LPR, c4 = lane % LPR;
    const float* W = ada_w + ((size_t)layer * D + wave * 256 + 16 * kr) * MODW + col0 + 4 * c4;
    f32x4 a0 = {0.f, 0.f, 0.f, 0.f}, a1 = a0, a2 = a0, a3 = a0, a4 = a0;
    const LAS float* sp = ssil + wave * 256 + 16 * kr;
    for (int k = 0; k < 256; k += 16 * RPI) {
        f32x4 wv[16];
#pragma unroll
        for (int kk = 0; kk < 16; ++kk) wv[kk] = __builtin_nontemporal_load((const f32x4*)(W + (size_t)(k + kk) * MODW));
#pragma unroll
        for (int hh = 0; hh < 4; ++hh) { const int k4 = k + 4 * hh;
            const f32x4 s0 = *(const LAS f32x4*)(sp + k4), s1 = *(const LAS f32x4*)(sp + D + k4), s2 = *(const LAS f32x4*)(sp + 2 * D + k4), s3 = *(const LAS f32x4*)(sp + 3 * D + k4), s4 = *(const LAS f32x4*)(sp + 4 * D + k4);
#pragma unroll
            for (int kk = 0; kk < 4; ++kk) { const f32x4 w4 = wv[4 * hh + kk]; a0 += w4 * s0[kk]; a1 += w4 * s1[kk]; a2 += w4 * s2[kk]; a3 += w4 * s3[kk]; a4 += w4 * s4[kk]; } }
    }
    { LAS f32x4* rw = (LAS f32x4*)(red + (wave * RPI + kr) * 5 * COLS) + c4;
      rw[0] = a0; rw[LPR] = a1; rw[2 * LPR] = a2; rw[3 * LPR] = a3; rw[4 * LPR] = a4; }
    __syncthreads();
    for (int i = tid; i < 5 * COLS; i += NTHREADS) { const int m = i / COLS, l = i % COLS; float s = 0.f;
#pragma unroll
        for (int w2 = 0; w2 < 8 * RPI; ++w2) s += red[w2 * 5 * COLS + m * COLS + l];
        mods[((size_t)layer * 5 + m) * MODW + col0 + l] = s + ada_b[(size_t)layer * MODW + col0 + l]; }
    __syncthreads();
}
__device__ __forceinline__ void ada_wg_item(volatile LAS unsigned* ptab, LAS unsigned char* lds, int it, int tid) { ada_wg_item_t<128>(ptab, lds, it / ADA_IT, (it % ADA_IT) * 128, tid); }

#define FILLER(U, ADA_FIRST, NIT, SEGS) do { int Gl = G; asm volatile("" : "+s"(Gl)); const int nfull = (U) % Gl; \
    if (nfull == 0 || bxp >= nfull) { const int rank = nfull ? bxp - nfull : bxp, nidle = nfull ? Gl - nfull : Gl, nada = ((ADA_FIRST) >= 0 && nidle > ADA_IT) ? ADA_IT : 0; \
        int tid = threadIdx.x; asm volatile("" : "+v"(tid)); const int lane = tid & 63, wave = __builtin_amdgcn_readfirstlane(tid >> 6); \
        if ((ADA_FIRST) >= 0 && nada == 0) { ada_fill_ssil(ptab, lds, tid); for (int it_ = rank; it_ < ADA_IT; it_ += nidle) ada_wg_item(ptab, lds, (ADA_FIRST) + it_, tid); }     \
        if (rank < nada) { ada_fill_ssil(ptab, lds, tid); ada_wg_item(ptab, lds, (ADA_FIRST) + rank, tid); } \
        else CONV_RUN((rank - nada) * NWAVES + wave, (nidle - nada) * NWAVES, NIT, SEGS); } } while (0)

#define FILLER2(K, ADA_FIRST, NIT, SEGS) FILLER2N(K, ADA_FIRST, ADA_IT, NIT, SEGS)
#define FILLER2N(K, ADA_FIRST, ADA_CNT, NIT, SEGS) do { int Gl = G; asm volatile("" : "+s"(Gl)); const int cc_ = __builtin_amdgcn_readfirstlane(*(volatile const LAS int*)(lds + pg8::CC_TAB_OFF + 4 * (K))); \
    if (cc_ >= Gl || bxp >= cc_) { const int rank = cc_ >= Gl ? bxp : bxp - cc_, nidle = cc_ >= Gl ? Gl : Gl - cc_; \
        int tid = threadIdx.x; asm volatile("" : "+v"(tid)); const int lane = tid & 63, wave = __builtin_amdgcn_readfirstlane(tid >> 6); \
        if ((ADA_FIRST) >= 0) { ada_fill_ssil(ptab, lds, tid); for (int it_ = rank; it_ < (ADA_CNT); it_ += nidle) ada_wg_item(ptab, lds, (ADA_FIRST) + it_, tid); } \
        CONV_RUN(rank * NWAVES + wave, nidle * NWAVES, NIT, SEGS); } } while (0)

__device__ __forceinline__ void norm_load(const float* xrow, f32x4 (&v)[8], int lane) {
    const f32x4* xr = (const f32x4*)xrow + lane;
#pragma unroll
    for (int j = 0; j < 8; ++j) v[j] = xr[64 * j];
}
__device__ __forceinline__ void norm_load(const bf16_t* xrow, f32x4 (&v)[8], int lane) {
    const u32x2* xr = (const u32x2*)xrow + lane; u32x2 r[8];
#pragma unroll
    for (int j = 0; j < 8; ++j) r[j] = xr[64 * j];
#pragma unroll
    for (int j = 0; j < 8; ++j) v[j] = (f32x4){bf_lo(r[j].x), bf_hi(r[j].x), bf_lo(r[j].y), bf_hi(r[j].y)};
}
template <int MODE>
__device__ __forceinline__ void norm_vecs(const float* g, const float* sh, const float* sc, f32x4 (&GG)[8], f32x4 (&SS)[8], int lane) {
#pragma unroll
    for (int j = 0; j < 8; ++j) { GG[j] = ((const f32x4*)g)[lane + 64 * j];
        if (MODE == 0) { GG[j] = GG[j] * (((const f32x4*)sc)[lane + 64 * j] + 1.f); SS[j] = ((const f32x4*)sh)[lane + 64 * j]; } }
}
template <int MODE>
__device__ __forceinline__ void norm_apply(f32x4 (&v)[8], bf16_t* xcopy, const f32x4 (&GG)[8], const f32x4 (&SS)[8], bf16_t* obf, float* of32, int lane, const float* slabrow = nullptr, const float* gate = nullptr) {
    float ss = 0.f;
    if (slabrow) {
#pragma unroll
        for (int jh = 0; jh < 2; ++jh) { u32x2 p[4][8];
#pragma unroll
            for (int jj = 0; jj < 4; ++jj) { const int j = jh * 4 + jj; const u32x2* sp = (const u32x2*)((const bf16_t*)slabrow + (size_t)j * 8 * 65536) + lane;
#pragma unroll
                for (int s = 0; s < 8; ++s) p[jj][s] = sp[(size_t)s * 16384]; }
            __builtin_amdgcn_sched_barrier(0);
#pragma unroll
            for (int jj = 0; jj < 4; ++jj) { const int j = jh * 4 + jj; const f32x4 gt = ((const f32x4*)gate)[lane + 64 * j];
                f32x4 a = {bf_lo(p[jj][0].x), bf_hi(p[jj][0].x), bf_lo(p[jj][0].y), bf_hi(p[jj][0].y)};
#pragma unroll
                for (int s = 1; s < 8; ++s) a += (f32x4){bf_lo(p[jj][s].x), bf_hi(p[jj][s].x), bf_lo(p[jj][s].y), bf_hi(p[jj][s].y)};
                v[j] += gt * a; }
            __builtin_amdgcn_sched_barrier(0); } }
#pragma unroll
    for (int j = 0; j < 8; ++j) ss += (v[j].x * v[j].x + v[j].y * v[j].y) + (v[j].z * v[j].z + v[j].w * v[j].w);
    const float rstd = rsqrtf(wave_sum(ss) * (1.f / D) + 1e-6f);
    if (xcopy) {
#pragma unroll
        for (int j = 0; j < 8; ++j) { u32x2 w; w.x = pk2(v[j].x, v[j].y); w.y = pk2(v[j].z, v[j].w); ((u32x2*)xcopy)[lane + 64 * j] = w; } }
#pragma unroll
    for (int j = 0; j < 8; ++j) { const int c4 = lane + 64 * j;
        f32x4 h = v[j] * rstd * GG[j];
        if (MODE == 0) { h = h + SS[j]; u32x2 w; w.x = pk2(h.x, h.y); w.y = pk2(h.z, h.w); ((u32x2*)obf)[c4] = w; }
        else ((f32x4*)of32)[c4] = h; }
}
#define NORM_LATENT(VECS, ROWSRC, APPLY) do { const int rpw_ = (ML + NGW - 1) / NGW; const int r0_ = gw * rpw_, r1_ = (r0_ + rpw_ < ML) ? r0_ + rpw_ : ML; \
    if (r0_ < r1_) { f32x4 GG[8], SS[8], vA[8], vB[8]; int mc_ = r0_ / SEQ; VECS(mc_); norm_load(ROWSRC(r0_), vA, lane); \
        for (int r_ = r0_; r_ < r1_; r_ += 2) { \
            { const int rn_ = (r_ + 1 < r1_) ? r_ + 1 : r_; norm_load(ROWSRC(rn_), vB, lane); } \
            if (r_ / SEQ != mc_) { mc_ = r_ / SEQ; VECS(mc_); } \
            APPLY(vA, r_); \
            if (r_ + 1 < r1_) { { const int rn_ = (r_ + 2 < r1_) ? r_ + 2 : r_ + 1; norm_load(ROWSRC(rn_), vA, lane); } \
                if ((r_ + 1) / SEQ != mc_) { mc_ = (r_ + 1) / SEQ; VECS(mc_); } \
                APPLY(vB, r_ + 1); } } } } while (0)

template <bool LOCAL>
__device__ __forceinline__ void attn_unit(const bf16_t* Q, const bf16_t* KT, const bf16_t* VT, bf16_t* O, LAS unsigned char* lds, int b, int h, int r, int w, int tq, int lane) {
    const int g = lane >> 4, q = lane & 15;
    const int qrow = LOCAL ? (b * SEQ + r * GRID_W + 16 * w + q) : (ML + b * CTX + 16 * tq + q);
    bf16x8 bq[4];
    { const bf16_t* qp = Q + (size_t)qrow * D + h * HD + 8 * g;
#pragma unroll
      for (int ks = 0; ks < 4; ++ks) bq[ks] = *(const bf16x8*)(qp + 32 * ks); }
    constexpr int NP = LOCAL ? 16 : 8, CP = LOCAL ? 8 : 0;
    f32x4 s[2 * NP];
    int rs = 0, ws = 0;
    if (LOCAL) { rs = r - 4; rs = rs < 0 ? 0 : (rs > 24 ? 24 : rs); ws = 16 * w - 8; ws = ws < 0 ? 0 : (ws > 32 ? 32 : ws); }
    const int rgl = b * SEQ + rs * GRID_W + ws;
    if (LOCAL) {
        const bf16_t* kloc = KT + ((size_t)(((rgl >> 3) + (q >> 2)) * NH + h)) * 1024 + (q & 3) * 32 + g * 8;
        bf16x8 ka[2][8];
#define ATT_KLOAD(buf, p) do { const bf16_t* kp_ = kloc + (size_t)((p) * 8 * NH) * 1024; \
        _Pragma("unroll") for (int f = 0; f < 2; ++f) _Pragma("unroll") for (int ks = 0; ks < 4; ++ks) ka[buf][f * 4 + ks] = *(const bf16x8*)(kp_ + f * 128 + ks * 256); } while (0)
        ATT_KLOAD(0, 0);
#pragma unroll
        for (int p = 0; p < 8; ++p) {
            __builtin_amdgcn_s_barrier();
            if (p + 1 < 8) ATT_KLOAD((p + 1) & 1, p + 1);
            __builtin_amdgcn_sched_barrier(0);
#pragma unroll
            for (int f = 0; f < 2; ++f) { f32x4 a = {0.f, 0.f, 0.f, 0.f};
#pragma unroll
                for (int ks = 0; ks < 4; ++ks) a = __builtin_amdgcn_mfma_f32_16x16x32_bf16(ka[p & 1][f * 4 + ks], bq[ks], a, 0, 0, 0);
                s[2 * p + f] = a; }
            __builtin_amdgcn_sched_barrier(0);
        }
#undef ATT_KLOAD
    }
    {
        const LAS unsigned char* kl = lds + (q >> 2) * 2048 + (((q & 3) * 4 + g) ^ ((q >> 2) & 2)) * 16;
#pragma unroll
        for (int p = 0; p < 8; ++p)
#pragma unroll
            for (int f = 0; f < 2; ++f) { f32x4 a = {0.f, 0.f, 0.f, 0.f};
#pragma unroll
                for (int ks = 0; ks < 4; ++ks) a = __builtin_amdgcn_mfma_f32_16x16x32_bf16(*(const LAS bf16x8*)(kl + p * 8192 + ks * 512 + f * 256), bq[ks], a, 0, 0, 0);
                s[2 * (CP + p) + f] = a; }
    }
    if (LOCAL) {
        const int c = 16 * w + q; int cs = c - 8; cs = cs < 0 ? 0 : (cs > 48 ? 48 : cs);
        const LAS float* rp = (const LAS float*)(lds + LDS_MISC + 1024);
#pragma unroll
        for (int p = 0; p < 8; ++p) { const int ro = (rs + p - r + 7) * 31;
#pragma unroll
            for (int f = 0; f < 2; ++f)
#pragma unroll
                for (int j = 0; j < 4; ++j) { const int kc = ws + 8 * g + 4 * f + j; const bool valid = (kc >= cs) && (kc < cs + 16);
                    int rel = kc - c + 15; rel = rel < 0 ? 0 : (rel > 30 ? 30 : rel);
                    const float bias = rp[ro + rel];
                    s[p * 2 + f][j] = valid ? s[p * 2 + f][j] + bias : -INFINITY; } }
    }
    float mx = -INFINITY;
#pragma unroll
    for (int i = 0; i < 2 * NP; ++i) mx = fmaxf(mx, fmaxf(fmaxf(s[i][0], s[i][1]), fmaxf(s[i][2], s[i][3])));
    mx = fmaxf(mx, __shfl_xor(mx, 16)); mx = fmaxf(mx, __shfl_xor(mx, 32));
    float sum = 0.f; const float mxl = mx * 1.4426950408889634f;
    bf16x8 pb[NP];
#pragma unroll
    for (int p = 0; p < NP; ++p) { float e[8];
#pragma unroll
        for (int f = 0; f < 2; ++f)
#pragma unroll
            for (int j = 0; j < 4; ++j) { e[4 * f + j] = fast_exp2(fmaf(s[2 * p + f][j], 1.4426950408889634f, -mxl)); sum += e[4 * f + j]; }
        u32x4 pw; pw.x = cvt_pk_bf16(e[0], e[1]); pw.y = cvt_pk_bf16(e[2], e[3]); pw.z = cvt_pk_bf16(e[4], e[5]); pw.w = cvt_pk_bf16(e[6], e[7]);
        pb[p] = __builtin_bit_cast(bf16x8, pw); }
    sum += __shfl_xor(sum, 16); sum += __shfl_xor(sum, 32);
    f32x4 o[8];
#pragma unroll
    for (int df = 0; df < 8; ++df) o[df] = (f32x4){0.f, 0.f, 0.f, 0.f};
    if (LOCAL) {
        const bf16_t* vloc = VT + ((size_t)(((rgl >> 3) + g) * NH + h)) * 1024 + q * 8;
        bf16x8 va[2][8];
#define ATT_VLOAD(buf, p) do { const bf16_t* vp_ = vloc + (size_t)((p) * 8 * NH) * 1024; \
        _Pragma("unroll") for (int df = 0; df < 8; ++df) va[buf][df] = *(const bf16x8*)(vp_ + df * 128); } while (0)
        ATT_VLOAD(0, 0);
#pragma unroll
        for (int p = 0; p < 8; ++p) {
            __builtin_amdgcn_s_barrier();
            if (p + 1 < 8) ATT_VLOAD((p + 1) & 1, p + 1);
            __builtin_amdgcn_sched_barrier(0);
#pragma unroll
            for (int df = 0; df < 8; ++df) o[df] = __builtin_amdgcn_mfma_f32_16x16x32_bf16(va[p & 1][df], pb[p], o[df], 0, 0, 0);
            __builtin_amdgcn_sched_barrier(0);
        }
#undef ATT_VLOAD
    }
    {
        const LAS unsigned char* vl = lds + 65536 + g * 2048 + q * 16;
#pragma unroll
        for (int p = 0; p < 8; ++p)
#pragma unroll
            for (int df = 0; df < 8; ++df) o[df] = __builtin_amdgcn_mfma_f32_16x16x32_bf16(*(const LAS bf16x8*)(vl + p * 8192 + df * 256), pb[CP + p], o[df], 0, 0, 0);
    }
    const float inv = 1.f / sum;
    bf16_t* op = O + (size_t)qrow * D + h * HD + 4 * g;
#pragma unroll
    for (int df = 0; df < 8; ++df) { u32x2 wv; wv.x = cvt_pk_bf16(o[df][0] * inv, o[df][1] * inv); wv.y = cvt_pk_bf16(o[df][2] * inv, o[df][3] * inv); *(u32x2*)(op + 16 * df) = wv; }
}

#define LRU_STEP(h, l, x) do { const float a_ = fast_exp2(l); h = fmaf(a_, h, __builtin_amdgcn_sqrtf(fmaxf(fmaf(-a_, a_, 1.f), 0.f)) * (x)); } while (0)
__global__ void __launch_bounds__(NTHREADS, 2) mega(Args args) {
    extern __shared__ __attribute__((aligned(16))) unsigned char lds_raw[];
    LAS unsigned char* lds = (LAS unsigned char*)lds_raw;
    const int G = gridDim.x; const int bx = blockIdx.x; const int vcu = ((G & 7) == 0) ? (bx & 7) * (G >> 3) + (bx >> 3) : bx;
    const int NGW = G * NWAVES;
    const int lo = args.ph_lo, hi = args.ph_hi;
    volatile LAS unsigned* ptab = (volatile LAS unsigned*)(lds + LDS_MISC + 64);
    { const int tid = threadIdx.x;
    for (int u = tid; u < (LDS_BYTES - LDS_MISC) / 4; u += NTHREADS) ((LAS unsigned*)(lds + LDS_MISC))[u] = 0u;
    __syncthreads();
    if (tid < 25) { const unsigned long long pv = tid < 23 ? (unsigned long long)args.in[tid] : (tid == 23 ? (unsigned long long)args.out : (unsigned long long)args.ws);
        ptab[2 * tid] = (unsigned)pv; ptab[2 * tid + 1] = (unsigned)(pv >> 32); }
    if (tid == 32) { volatile LAS int* cct = (volatile LAS int*)(lds + pg8::CC_TAB_OFF); static_assert(pg8::CC_TAB_OFF == LDS_MISC + 512, "cc table");
        cct[1] = pg8::gemm_cc(36 * (2 * LW / 256), G); cct[2] = pg8::gemm_cc(36 * (2 * D / 256) + (D / 256) * 36, G); cct[3] = pg8::gemm_cc(36 * NLB * 4, G); cct[4] = pg8::gemm_cc(36 * (FF / 256), G); }
    __syncthreads(); }
    unsigned char* const ws0 = args.ws;
    XcdBarrier bar; bar.bar = (unsigned*)(ws0 + WS_CTL) + CW_BAR; bar.x = 0; bar.st = nullptr;
    const bool multi = (hi - lo) > 1;
    if (multi) bar = xcd_barrier_post((unsigned*)(ws0 + WS_CTL) + CW_BAR, (volatile LAS unsigned*)(lds + LDS_MISC + 32));
    bool need_bar = false;
#define IN(k) (lo <= (k) && (k) < hi)
#define TABP(i) tabp(ptab, (i))
#define INP(i) ((const float*)TABP(i))
#define WSF(off) ((float*)(wsl + (off)))
#define WSB(off) ((bf16_t*)(wsl + (off)))
#define PHASE_BEGIN() if (need_bar) xcd_barrier(bar); need_bar = true; int tid = threadIdx.x; asm volatile("" : "+v"(tid)); const int lane = tid & 63, wave = __builtin_amdgcn_readfirstlane(tid >> 6), gw = vcu * NWAVES + wave; (void)lane; (void)gw; unsigned char* const wsl = TABP(24); (void)wsl; int bxp = bx; asm volatile("" : "+s"(bxp)); (void)bxp

    if (IN(PH_PROLOGUE)) {
        PHASE_BEGIN();
        for (int rep = 0; rep < REP_PRO; ++rep) {
        __syncthreads();
        ada_fill_ssil(ptab, lds, tid);
        constexpr int ADA0 = 64;
        { const float* lam = INP(13); float* CAw = WSF(WS_CA);
          for (int i = gw * 64 + lane; i < 2 * 2 * LW; i += NGW * 64) CAw[i] = -8.f * log1pf(expf(-lam[i])) * 1.4426950408889634f; }
        constexpr int NITEMS = C_IN;
#define SEGS_P CSEG(2, 0, C_IN)
        if (G > 2 * ADA0) { if (vcu < ADA0) ada_wg_item_t<64>(ptab, lds, 0, vcu * 64, tid); else CONV_RUN((vcu - ADA0) * NWAVES + wave, (G - ADA0) * NWAVES, NITEMS, SEGS_P); }
        else { for (int it_ = vcu; it_ < ADA0; it_ += G) ada_wg_item_t<64>(ptab, lds, 0, it_ * 64, tid); CONV_RUN(vcu * NWAVES + wave, G * NWAVES, NITEMS, SEGS_P); }
#undef SEGS_P
        }
    }
    if (IN(PH_NORM0)) {
        PHASE_BEGIN();
        const float* x = INP(0); const float* ctx = INP(2); const float* norm1_g = INP(6); const float* mods = WSF(WS_MODS); bf16_t* X = WSB(WS_X); bf16_t* XN = WSB(WS_XN);
#define VECS0(m) norm_vecs<0>(norm1_g, mods + (size_t)(m) * MODW, mods + (size_t)(m) * MODW + D, GG, SS, lane)
#define SRC0(r) (x + (size_t)(r) * D)
#define APP0(v, r) norm_apply<0>(v, nullptr, GG, SS, XN + (size_t)(r) * D, nullptr, lane)
        for (int rep = 0; rep < REP_NORM; ++rep) {
            NORM_LATENT(VECS0, SRC0, APP0);
            { f32x4 GG[8], SS[8]; VECS0(4);
              for (int row = ML + gw; row < M; row += NGW) { f32x4 v[8]; norm_load(ctx + (size_t)(row - ML) * D, v, lane); norm_apply<0>(v, X + (size_t)row * D, GG, SS, XN + (size_t)row * D, nullptr, lane); } } }
#undef VECS0
#undef SRC0
#undef APP0
    }
    for (int L = 0; L < DEPTH; ++L) {
        const int base = PH_LAYER0 + PH_PER_LAYER * L; const bool lru = !(L & 1); const int j = L >> 1; const bool lastL = (L == DEPTH - 1);
        const int nMrows = lastL ? 32 : 36;
        if (IN(base + 0)) {
            if (threadIdx.x == 0 && lru) { const int U_ = 36 * (2 * LW / 256), R_ = (U_ + G - 1) / G + (L == 0 ? 1 : 0); int c_ = ((U_ + R_ - 1) / R_ + 7) & ~7; if ((G & 7) || c_ > G) c_ = G;
                ((volatile LAS int*)(lds + pg8::CC_TAB_OFF))[1] = c_; }
            PHASE_BEGIN();
            if (lru) {
                pg8::Gemm g{WSB(WS_XN), WSB(WS_WIN) + (size_t)j * (2 * LW) * D, D, D, D, -1, nullptr, nullptr, 0}; pg8::StaticOrder S; S.init(36, 2 * LW / 256, G, bxp);
                pg8::EpiAct<0> E{WSB(WS_BIG), 2 * LW};
                pg8::gemm_phase<pg8::EpiAct<0>, true, true, 1>(lds, g, S, E);
#define SEGS_A CSEG(6, 0, C_G); CSEG(3, 0, C_OUT); CSEG(0, 0, C_W); CSEG(1, 0, C_W); CSEG(4, 0, C_QKV); CSEG(5, 0, C_O); CSEG(0, 1, C_W)
#define SEGS_E CSEG(1, 2, C_W); CSEG(4, 1, C_QKV); CSEG(5, 1, C_O)
                if (L == 0) FILLER2N(1, 32, 160, C_G + C_OUT + 3 * C_W + C_QKV + C_O, SEGS_A);
                if (L == 2) FILLER2(1, -1, C_W + C_QKV + C_O, SEGS_E);
#undef SEGS_A
#undef SEGS_E
            } else {
                const bf16_t* wq = WSB(WS_WQKV) + (size_t)j * (3 * D) * D; const bf16_t* XN = WSB(WS_XN);
                pg8::Gemm g{XN, wq, D, D, D, -1, wq + (size_t)(2 * D) * D, XN, 0}; pg8::StaticOrder S; S.init(36, 2 * D / 256, G, bxp, D / 256, 36);
                pg8::EpiQKV E{WSB(WS_BIG), WSB(WS_BIG + 36 * MiB), WSB(WS_BIG + 72 * MiB), 0.08838834764831845f};
                pg8::gemm_phase<pg8::EpiQKV, true, true, 2>(lds, g, S, E);
#define SEGS_C CSEG(3, 1, C_OUT); CSEG(6, 1, C_G); CSEGO(1, 1, 0, C_W / 2)
#define SEGS_F CSEG(1, 3, C_W)
                if (L == 1) FILLER2(2, 3 * ADA_IT, C_OUT + C_G + C_W / 2, SEGS_C);
                if (L == 3) FILLER2(2, -1, C_W, SEGS_F);
#undef SEGS_C
#undef SEGS_F
            }
        }
        if (IN(base + 1)) {
            PHASE_BEGIN();
            if (lru) {
                const float* cw = INP(11) + (size_t)j * 4 * LW; const float* cb = INP(12) + (size_t)j * LW; const bf16_t* GU = WSB(WS_BIG); bf16_t* UC = WSB(WS_UC);
                for (int rep = 0; rep < REP_CONV; ++rep)
                for (int it = gw; it < 288 * NLB; it += NGW) {
                    const int strip = it / NLB, cg = it % NLB, ch = cg * 256 + 4 * lane;
                    int seg0, seglen, t0; if (strip < 256) { seg0 = (strip >> 6) * SEQ; seglen = SEQ; t0 = (strip & 63) * 32; } else { const int s2 = strip - 256; seg0 = ML + (s2 >> 3) * CTX; seglen = CTX; t0 = (s2 & 7) * 32; }
                    const f32x4 w0 = *(const f32x4*)(cw + ch), w1 = *(const f32x4*)(cw + LW + ch), w2 = *(const f32x4*)(cw + 2 * LW + ch), w3 = *(const f32x4*)(cw + 3 * LW + ch), bv = *(const f32x4*)(cb + ch);
                    u32x2 uw[35];
#pragma unroll
                    for (int i = 0; i < 35; ++i) { const int t = t0 - 2 + i; const int tc = t < 0 ? 0 : (t >= seglen ? seglen - 1 : t); uw[i] = *(const u32x2*)(GU + (size_t)(seg0 + tc) * (2 * LW) + LW + ch); }
                    __builtin_amdgcn_sched_barrier(0);
                    auto cvu = [&](int i) -> f32x4 { const int t = t0 - 2 + i; const float z = (t < 0 || t >= seglen) ? 0.f : 1.f; return (f32x4){bf_lo(uw[i].x) * z, bf_hi(uw[i].x) * z, bf_lo(uw[i].y) * z, bf_hi(uw[i].y) * z}; };
                    f32x4 um2 = cvu(0), um1 = cvu(1), u0 = cvu(2);
#pragma unroll
                    for (int t = 0; t < 32; ++t) { const f32x4 up1 = cvu(t + 3);
                        const f32x4 y = w0 * um2 + w1 * um1 + w2 * u0 + w3 * up1 + bv;
                        u32x2 wv; wv.x = pk2(y.x, y.y); wv.y = pk2(y.z, y.w); *(u32x2*)(UC + (size_t)(seg0 + t0 + t) * LW + ch) = wv;
                        um2 = um1; um1 = u0; u0 = up1; }
                }
            } else {
                const bf16_t* Qb = WSB(WS_BIG); const bf16_t* KTp = WSB(WS_BIG + 36 * MiB); const bf16_t* VTp = WSB(WS_BIG + 72 * MiB); bf16_t* Ob = WSB(WS_O);
                const float* rpg = INP(20) + (size_t)j * NH * 465;
                for (int rep = 0; rep < REP_ATTN; ++rep)
                for (int it = vcu; it < BATCH * NH * 4; it += G) { const int qr = it & 3, h = (it >> 2) & 15, b = it >> 6;
                    __syncthreads();
                    { const int oc0 = (ML + b * CTX) >> 3;
                      for (int ci = tid; ci < 4096; ci += NTHREADS) { const int o = ci >> 7, wq = ci & 127;
                          const u32x4 kv = *(const u32x4*)(KTp + ((size_t)((oc0 + o) * NH + h)) * 1024 + wq * 8);
                          *(LAS u32x4*)(lds + o * 2048 + (wq & ~15) * 16 + ((wq & 15) ^ (o & 2)) * 16) = kv;
                          const u32x4 vv = *(const u32x4*)(VTp + ((size_t)((oc0 + o) * NH + h)) * 1024 + wq * 8);
                          *(LAS u32x4*)(lds + 65536 + o * 2048 + wq * 16) = vv; }
                      LAS float* rp = (LAS float*)(lds + LDS_MISC + 1024);
                      for (int i = tid; i < 465; i += NTHREADS) rp[i] = rpg[h * 465 + i]; }
                    __syncthreads();
#pragma unroll 1
                    for (int rd = 0; rd < 4; ++rd) attn_unit<true>(Qb, KTp, VTp, Ob, lds, b, h, 8 * qr + 2 * rd + (wave >> 2), wave & 3, 0, lane);
                    if (!lastL && wave < 4) attn_unit<false>(Qb, KTp, VTp, Ob, lds, b, h, 0, 0, 4 * qr + wave, lane);
                }
                __syncthreads();
            }
        }
        if (lru) {
            if (IN(base + 2)) {
                PHASE_BEGIN();
                const bf16_t* UC = WSB(WS_UC);
                pg8::Gemm g{UC, WSB(WS_WG) + (size_t)j * (NLB * 1024) * LB, LW, LB, LB, 2, nullptr, nullptr, 0}; pg8::StaticOrder S; S.init(36, NLB * 4, G, bxp);
                pg8::EpiGates E{UC, (unsigned*)(wsl + WS_LA), INP(15) + (size_t)j * 2 * LW, INP(17) + (size_t)j * 2 * LW, WSF(WS_CA) + (size_t)j * 2 * LW};
                for (int rep = 0; rep < REP_GATES; ++rep) pg8::gemm_phase<pg8::EpiGates, false, true>(lds, g, S, E);
#define SEGS_H0 CSEG(5, 0, C_O)
#define SEGS_H1 CSEG(5, 1, C_O)
#undef SEGS_H0
#undef SEGS_H1
            }
            if (IN(base + 3)) {
                PHASE_BEGIN();
                const unsigned* LB = (const unsigned*)(wsl + WS_LA); float* AGGA = WSF(WS_AGGA); float* AGGH = WSF(WS_AGGH);
                for (int rep = 0; rep < REP_S1; ++rep)
                for (int it = gw; it < 2 * BATCH * 72 * 22; it += NGW) {
                    const int cg = it % 22, r1 = it / 22, q = r1 % 72, r2 = r1 / 72, b = r2 & 3, dir = r2 >> 2;
                    const int ch = cg * 128 + 2 * lane;
                    const int rbase = q < 8 ? ML + b * CTX + 32 * q : b * SEQ + 32 * (q - 8);
                    const unsigned* lp = LB + ((size_t)dir * M + rbase) * LW + ch;
                    float sl0 = 0.f, sl1 = 0.f, h0 = 0.f, h1 = 0.f;
                    u32x2 lb[32];
#pragma unroll
                    for (int t = 0; t < 32; ++t) lb[t] = *(const u32x2*)(lp + (size_t)t * LW);
                    __builtin_amdgcn_sched_barrier(0);
                    if (dir == 0) {
#pragma unroll
                        for (int t = 0; t < 32; ++t) { const float l0 = bf_lo(lb[t].x), l1 = bf_lo(lb[t].y); LRU_STEP(h0, l0, bf_hi(lb[t].x)); LRU_STEP(h1, l1, bf_hi(lb[t].y)); sl0 += l0; sl1 += l1; }
                    } else {
#pragma unroll
                        for (int t = 31; t >= 0; --t) { const float l0 = bf_lo(lb[t].x), l1 = bf_lo(lb[t].y); LRU_STEP(h0, l0, bf_hi(lb[t].x)); LRU_STEP(h1, l1, bf_hi(lb[t].y)); sl0 += l0; sl1 += l1; }
                    }
                    const size_t o = ((size_t)(dir * BATCH + b) * 72 + q) * LW + ch;
                    *(f32x2*)(AGGA + o) = (f32x2){fast_exp2(sl0), fast_exp2(sl1)}; *(f32x2*)(AGGH + o) = (f32x2){h0, h1};
                }
            }
            if (IN(base + 4)) {
                PHASE_BEGIN();
                const float* AGGA = WSF(WS_AGGA); const float* AGGH = WSF(WS_AGGH); float* CARRY = WSF(WS_CARRY);
                for (int rep = 0; rep < REP_S2; ++rep)
                for (int i = (wave * G + vcu) * 64 + lane; i < 2 * BATCH * LW; i += NGW * 64) {
                    const int ch = i % LW, db = i / LW, dir = db >> 2;
                    const size_t o = (size_t)db * 72 * LW + ch; float h = 0.f;
                    for (int bt = 0; bt < 2; ++bt) { float av[36], hv[36];
#pragma unroll
                        for (int k = 0; k < 36; ++k) { const int st = bt * 36 + k, q = dir ? (st < 8 ? 7 - st : 79 - st) : st; av[k] = AGGA[o + (size_t)q * LW]; hv[k] = AGGH[o + (size_t)q * LW]; }
#pragma unroll
                        for (int k = 0; k < 36; ++k) { const int st = bt * 36 + k, q = dir ? (st < 8 ? 7 - st : 79 - st) : st; CARRY[o + (size_t)q * LW] = h; h = av[k] * h + hv[k]; } }
                }
            }
            if (IN(base + 5)) {
                PHASE_BEGIN();
                const unsigned* LB = (const unsigned*)(wsl + WS_LA); const float* CARRY = WSF(WS_CARRY); const bf16_t* GU = WSB(WS_BIG); bf16_t* Zb = WSB(WS_Z);
                for (int rep = 0; rep < REP_S3; ++rep)
                for (int it = gw; it < BATCH * 72 * 22; it += NGW) {
                    const int cg = it % 22, r1 = it / 22, q = r1 % 72, b = r1 / 72;
                    const int ch = cg * 128 + 2 * lane;
                    const int rbase = q < 8 ? ML + b * CTX + 32 * q : b * SEQ + 32 * (q - 8);
                    const size_t ro = (size_t)rbase * LW + ch;
                    const size_t c0 = ((size_t)(0 * BATCH + b) * 72 + q) * LW + ch, c1 = ((size_t)(1 * BATCH + b) * 72 + q) * LW + ch;
                    float hf0[32], hf1[32];
                    { u32x2 lb[32]; const f32x2 hc = *(const f32x2*)(CARRY + c0);
#pragma unroll
                      for (int t = 0; t < 32; ++t) lb[t] = *(const u32x2*)(LB + ro + (size_t)t * LW);
                      __builtin_amdgcn_sched_barrier(0);
                      float h0 = hc.x, h1 = hc.y;
#pragma unroll
                      for (int t = 0; t < 32; ++t) { LRU_STEP(h0, bf_lo(lb[t].x), bf_hi(lb[t].x)); LRU_STEP(h1, bf_lo(lb[t].y), bf_hi(lb[t].y)); hf0[t] = h0; hf1[t] = h1; } }
                    { u32x2 lb[32]; unsigned gwv[32]; const f32x2 hc = *(const f32x2*)(CARRY + c1);
                      const unsigned* l1p = LB + (size_t)M * LW + ro;
#pragma unroll
                      for (int t = 0; t < 32; ++t) { lb[t] = *(const u32x2*)(l1p + (size_t)t * LW); gwv[t] = *(const unsigned*)(GU + (size_t)(rbase + t) * (2 * LW) + ch); }
                      __builtin_amdgcn_sched_barrier(0);
                      float h0 = hc.x, h1 = hc.y;
#pragma unroll
                      for (int t = 31; t >= 0; --t) { LRU_STEP(h0, bf_lo(lb[t].x), bf_hi(lb[t].x)); LRU_STEP(h1, bf_lo(lb[t].y), bf_hi(lb[t].y));
                          const float g0 = bf_lo(gwv[t]), g1 = bf_hi(gwv[t]);
                          const float z0 = g0 * fast_sigmoid(1.5957691216057308f * (g0 + 0.044715f * g0 * g0 * g0)) * (hf0[t] + h0);
                          const float z1 = g1 * fast_sigmoid(1.5957691216057308f * (g1 + 0.044715f * g1 * g1 * g1)) * (hf1[t] + h1);
                          *(unsigned*)(Zb + ro + (size_t)t * LW) = pk2(z0, z1); } }
                }
            }
        }
        if (IN(base + 6)) {
            PHASE_BEGIN();
            const bf16_t* Ao = lru ? WSB(WS_Z) : WSB(WS_O); const bf16_t* Bo = lru ? WSB(WS_WOUT) + (size_t)j * D * LW : WSB(WS_WO) + (size_t)j * D * D; const int Ko = lru ? LW : D;
            pg8::Gemm g{Ao, Bo, Ko, Ko, Ko, -1, Ao, Bo, 1};
            pg8::StaticOrder S; if (lastL) S.init(32, D / 256, G, bxp); else if (G == 256) S.init(32, D / 256, -G, bxp + 256, 4, D / 256, 1);
            else S.init(32, D / 256, G, bxp, 4, D / 256, 1);
            if (L == 0) { pg8::EpiResidT<true, 1> E{WSB(WS_X), WSF(WS_MODS) + (size_t)L * 5 * MODW, 2, WSF(WS_SLAB), INP(0), INP(7) + (size_t)L * D, 3 * D, 64u * (2 * L + 1), lds};
                pg8::gemm_phase<pg8::EpiResidT<true, 1>, true, true>(lds, g, S, E); }
            else { pg8::EpiResidT<false, 1> E{WSB(WS_X), WSF(WS_MODS) + (size_t)L * 5 * MODW, 2, WSF(WS_SLAB), nullptr, INP(7) + (size_t)L * D, 3 * D, 64u * (2 * L + 1), lds};
                pg8::gemm_phase<pg8::EpiResidT<false, 1>, true, true>(lds, g, S, E); }
        }
        if (IN(base + 7) && !lastL) {
            PHASE_BEGIN();
            const float* ml = WSF(WS_MODS) + (size_t)L * 5 * MODW; bf16_t* X = WSB(WS_X); bf16_t* XN = WSB(WS_XN); const float* g2 = INP(7) + (size_t)L * D;
            const float* slab = WSF(WS_SLAB);
#define VECS7(m) norm_vecs<0>(g2, ml + (size_t)(m) * MODW + 3 * D, ml + (size_t)(m) * MODW + 4 * D, GG, SS, lane)
#define SRC7(r) (X + (size_t)(r) * D)
#define APP7(v, r) norm_apply<0>(v, nullptr, GG, SS, XN + (size_t)(r) * D, nullptr, lane)
            if (!lastL) { f32x4 GG[8], SS[8]; VECS7(4); const float* mm = ml + (size_t)4 * MODW;
                for (int row = ML + gw; row < M; row += NGW) { f32x4 v[8]; norm_load(X + (size_t)row * D, v, lane);
                    norm_apply<0>(v, X + (size_t)row * D, GG, SS, XN + (size_t)row * D, nullptr, lane,
                                  (const float*)((const bf16_t*)slab + (size_t)((row - ML) >> 8) * 64 * 65536 + (size_t)(row & 255) * 256), mm + 2 * D); } }
#undef VECS7
#undef SRC7
#undef APP7
        }
        if (IN(base + 8)) {
            if (threadIdx.x == 0) ((volatile LAS int*)(lds + pg8::CC_TAB_OFF))[4] = lastL ? G : pg8::gemm_cc(36 * (FF / 256), G);
            PHASE_BEGIN();
            pg8::Gemm g{WSB(WS_XN), WSB(WS_W1) + (size_t)L * FF * D, D, D, D, -1, nullptr, nullptr, 0}; pg8::StaticOrder S; S.init(nMrows, FF / 256, G, bxp);
            pg8::EpiAct<1> E{WSB(WS_BIG), FF};
            pg8::gemm_phase<pg8::EpiAct<1>, true, true, 4>(lds, g, S, E);
#define SEGS_B CSEG(2, 1, C_IN)
#define SEGS_D CSEG(0, 2, C_W); CSEGO(1, 1, C_W / 2, C_W / 2)
#define SEGS_G CSEG(0, 3, C_W)
            if (L == 0) FILLER2(4, 2 * ADA_IT, C_IN, SEGS_B);
            if (L == 1) FILLER2(4, -1, C_W + C_W / 2, SEGS_D);
            if (L == 2) FILLER2(4, -1, C_W, SEGS_G);
#undef SEGS_B
#undef SEGS_D
#undef SEGS_G
        }
        if (IN(base + 9)) {
            PHASE_BEGIN();
            const bf16_t* Ao = WSB(WS_BIG); const bf16_t* Bo = WSB(WS_W2) + (size_t)L * D * FF;
            pg8::Gemm g{Ao, Bo, FF, FF, FF, -1, Ao, Bo, 1};
            pg8::StaticOrder S; if (lastL) S.init(32, D / 256, G, bxp); else if (G == 256) S.init(32, D / 256, -G, bxp + 256, 4, D / 256, 1);
            else S.init(32, D / 256, G, bxp, 4, D / 256, 1);
            if (lastL) { pg8::EpiResidT<false, 2> E{WSB(WS_X), WSF(WS_MODS) + (size_t)L * 5 * MODW, 5, (float*)TABP(23), nullptr, INP(22), 0, 64u * (2 * L + 2), lds};
                pg8::gemm_phase<pg8::EpiResidT<false, 2>, true, true>(lds, g, S, E); }
            else { pg8::EpiResidT<false, 1> E{WSB(WS_X), WSF(WS_MODS) + (size_t)L * 5 * MODW, 5, WSF(WS_SLAB), nullptr, INP(6) + (size_t)(L + 1) * D, 5 * MODW, 64u * (2 * L + 2), lds};
                pg8::gemm_phase<pg8::EpiResidT<false, 1>, true, true>(lds, g, S, E); }
        }
        if (IN(base + 10) && !lastL) {
            PHASE_BEGIN();
            bf16_t* X = WSB(WS_X);
#define SRC10(r) (X + (size_t)(r) * D)
            { const float* mn = WSF(WS_MODS) + (size_t)(L + 1) * 5 * MODW; bf16_t* XN = WSB(WS_XN); const float* g1n = INP(6) + (size_t)(L + 1) * D;
                const float* slab = WSF(WS_SLAB); const float* gate5 = WSF(WS_MODS) + ((size_t)L * 5 + 4) * MODW + 5 * D;
#define VECS10B(m) norm_vecs<0>(g1n, mn + (size_t)(m) * MODW, mn + (size_t)(m) * MODW + D, GG, SS, lane)
#define APP10B(v, r) norm_apply<0>(v, nullptr, GG, SS, XN + (size_t)(r) * D, nullptr, lane)
                { f32x4 GG[8], SS[8]; VECS10B(4);
                  for (int row = ML + gw; row < M; row += NGW) { f32x4 v[8]; norm_load(X + (size_t)row * D, v, lane);
                      norm_apply<0>(v, X + (size_t)row * D, GG, SS, XN + (size_t)row * D, nullptr, lane,
                                    (const float*)((const bf16_t*)slab + (size_t)((row - ML) >> 8) * 64 * 65536 + (size_t)(row & 255) * 256), gate5); } }
#undef VECS10B
#undef APP10B
            }
#undef SRC10
        }
    }
#undef IN
#undef PHASE_BEGIN
}

static inline dim3 g1(size_t n) { return dim3((unsigned)((n + 255) / 256)); }

extern "C" void kernel_launch(void* const* d_in, const int* in_sizes, int n_in, void* d_out, int out_size, void* d_ws, size_t ws_size, hipStream_t stream) {
    static int grid = 0;
    if (grid == 0) {
        int dev = 0, cus = 0;
        if (hipGetDevice(&dev) != hipSuccess || hipDeviceGetAttribute(&cus, hipDeviceAttributeMultiprocessorCount, dev) != hipSuccess) { grid = -1; return; }
        if (hipFuncSetAttribute((const void*)mega, hipFuncAttributeMaxDynamicSharedMemorySize, LDS_BYTES) != hipSuccess) { fprintf(stderr, "hipFuncSetAttribute failed\n"); grid = -1; return; }
        int per_cu = 0; (void)hipOccupancyMaxActiveBlocksPerMultiprocessor(&per_cu, (const void*)mega, NTHREADS, LDS_BYTES); (void)hipGetLastError();
        grid = cus;
    }
    if (grid < 0) return;
    const float* norm1_g = (const float*)d_in[6]; const float* norm2_g = (const float*)d_in[7];
    const float* lru_w_in = (const float*)d_in[10]; const float* lru_conv_w = (const float*)d_in[11];
    const float* lru_conv_b = (const float*)d_in[12]; const float* lru_lambda = (const float*)d_in[13]; const float* lru_wa = (const float*)d_in[14]; const float* lru_ba = (const float*)d_in[15];
    const float* lru_wx = (const float*)d_in[16]; const float* lru_bx = (const float*)d_in[17]; const float* lru_w_out = (const float*)d_in[18]; const float* na_w_qkv = (const float*)d_in[19];
    const float* na_rpb = (const float*)d_in[20]; const float* na_w_o = (const float*)d_in[21];
    (void)norm2_g;
    char* ws = (char*)d_ws;
    (void)hipMemsetAsync(ws + WS_CTL, 0, CTL_ZERO_BYTES, stream);
    Args a{};
    for (int i = 0; i < 23; ++i) a.in[i] = (const float*)d_in[i];
    a.out = (float*)d_out; a.ws = (unsigned char*)d_ws;
    auto run = [&](int lo, int hi) { a.ph_lo = lo; a.ph_hi = hi; hipLaunchKernelGGL(mega, dim3(grid), dim3(NTHREADS), LDS_BYTES, stream, a); };
#if ONE_LAUNCH
    if (WS_FAST_END > ws_size) { fprintf(stderr, "ws too small\n"); return; }
    run(0, PH_END);
#else
    size_t off = (FAST_LRU ? WS_FAST_END : WS_NV);
    auto alloc = [&](size_t bytes) { float* p = (float*)(ws + off); off += (bytes + 255) & ~(size_t)255; return p; };
    float* H = alloc((size_t)M * D * 4); float* T1 = alloc((size_t)M * D * 4);
    float* BIGF = alloc((size_t)M * 3 * D * 4);
    float* UCf = alloc((size_t)M * LW * 4); float* RA = alloc((size_t)M * LW * 4); float* RX = alloc((size_t)M * LW * 4); float* Y = alloc((size_t)M * LW * 4);
    if (!(FAST_LRU && FAST_NA)) { if (off > ws_size) { fprintf(stderr, "ws too small: need %zu have %zu\n", off, ws_size); return; } }
    else if (WS_FAST_END > ws_size) return;
    float* mods = (float*)(ws + WS_MODS); float* X = (float*)(ws + WS_X);
    run(PH_PROLOGUE, PH_PROLOGUE + 1);
    run(PH_NORM0, PH_NORM0 + 1);
    for (int L = 0; L < DEPTH; ++L) {
        const int base = PH_LAYER0 + PH_PER_LAYER * L; const bool lru = !(L & 1); const int j = L / 2;
        const float* ml = mods + (size_t)L * 5 * MODW;
        if (lru) {
            if (FAST_LRU) { for (int p = 0; p <= 6; ++p) run(base + p, base + p + 1); }
            else {
                nv::k_norm_mod<<<M, 256, 0, stream>>>(X, norm1_g + (size_t)L * D, ml, 0, H, D);
                float* GUf = BIGF;
                nv::k_sgemm<<<dim3(2 * LW / 128, M / 128, 1), 256, 0, stream>>>(H, D, 0, lru_w_in + (size_t)j * D * 2 * LW, 2 * LW, 0, GUf, 2 * LW, 0, D);
                nv::k_conv<<<g1((size_t)M * LW), 256, 0, stream>>>(GUf, lru_conv_w + (size_t)j * 4 * LW, lru_conv_b + (size_t)j * LW, UCf);
                for (int d = 0; d < 2; ++d) {
                    const size_t wo = ((size_t)j * 2 + d) * NLB * LB * LB, bo = ((size_t)j * 2 + d) * LW;
                    nv::k_sgemm<<<dim3(LB / 128, M / 128, NLB), 256, 0, stream>>>(UCf, LW, LB, lru_wa + wo, LB, (size_t)LB * LB, RA, LW, LB, LB);
                    nv::k_sgemm<<<dim3(LB / 128, M / 128, NLB), 256, 0, stream>>>(UCf, LW, LB, lru_wx + wo, LB, (size_t)LB * LB, RX, LW, LB, LB);
                    nv::k_lru_coef<<<g1((size_t)M * LW), 256, 0, stream>>>(RA, RX, UCf, lru_ba + bo, lru_bx + bo, lru_lambda + bo);
                    nv::k_scan_dir<<<g1(BATCH * LW), 256, 0, stream>>>(RA, RX, Y, d);
                }
                nv::k_gate_mul<<<g1((size_t)M * LW), 256, 0, stream>>>(GUf, Y, UCf);
                nv::k_sgemm<<<dim3(D / 128, M / 128, 1), 256, 0, stream>>>(UCf, LW, 0, lru_w_out + (size_t)j * LW * D, D, 0, T1, D, 0, LW);
                nv::k_resid<<<g1((size_t)M * D), 256, 0, stream>>>(X, T1, ml, 2, M);
            }
        } else {
            if (FAST_NA) { run(base + 0, base + 1); run(base + 1, base + 2); run(base + 6, base + 7); }
            else {
                nv::k_norm_mod<<<M, 256, 0, stream>>>(X, norm1_g + (size_t)L * D, ml, 0, H, D);
                float* QKV = BIGF;
                nv::k_sgemm<<<dim3(3 * D / 128, M / 128, 1), 256, 0, stream>>>(H, D, 0, na_w_qkv + (size_t)j * D * 3 * D, 3 * D, 0, QKV, 3 * D, 0, D);
                nv::k_attn<<<M * NH / 4, 256, 0, stream>>>(QKV, na_rpb + (size_t)j * NH * 15 * 31, H);
                nv::k_sgemm<<<dim3(D / 128, M / 128, 1), 256, 0, stream>>>(H, D, 0, na_w_o + (size_t)j * D * D, D, 0, T1, D, 0, D);
                nv::k_resid<<<g1((size_t)M * D), 256, 0, stream>>>(X, T1, ml, 2, M);
            }
        }
        run(base + 7, base + 8); run(base + 8, base + 9); run(base + 9, base + 10); run(base + 10, base + 11);
    }
#endif
}
```

```cpp
#include <hip/hip_runtime.h>
#include <cstdint>
#include <cstdio>

#ifndef FAST_MLP
#define FAST_MLP 1
#endif
#ifndef FAST_NA
#define FAST_NA 1
#endif
#ifndef FAST_LRU
#define FAST_LRU 1
#endif
#ifndef REP_PRO
#define REP_PRO 1
#endif
#ifndef REP_NORM
#define REP_NORM 1
#endif
#ifndef REP_ATTN
#define REP_ATTN 1
#endif
#ifndef REP_SCAN
#define REP_SCAN 1
#endif
#ifndef REP_CONV
#define REP_CONV 1
#endif
#ifndef REP_S1
#define REP_S1 1
#endif
#ifndef REP_S2
#define REP_S2 1
#endif
#ifndef REP_S3
#define REP_S3 1
#endif
#ifndef REP_IN
#define REP_IN 1
#endif
#ifndef REP_GATES
#define REP_GATES 1
#endif
#ifndef REP_MLP1
#define REP_MLP1 1
#endif
#ifndef REP_OUT
#define REP_OUT 1
#endif
#ifndef REP_MLP2
#define REP_MLP2 1
#endif
#ifndef REP_GEMM
#define REP_GEMM 1
#endif
#ifndef ONE_LAUNCH
#define ONE_LAUNCH 1
#endif

namespace cfg {
constexpr int D = 2048, BATCH = 4, SEQ = 2048, DEPTH = 4, GRID_W = 64, CTX = 256, NH = 16, HD = 128;
constexpr int LW = 2816, NLB = 11, LB = 256, FF = 8192, NMOD = 6;
constexpr int ML = BATCH * SEQ, MC = BATCH * CTX, M = ML + MC;
constexpr int MODW = NMOD * D;
}
using namespace cfg;

#define LAS __attribute__((address_space(3)))
#define GAS __attribute__((address_space(1)))
typedef unsigned short bf16_t;
typedef short bf16x8 __attribute__((ext_vector_type(8)));
typedef float f32x4 __attribute__((ext_vector_type(4)));
typedef float f32x2 __attribute__((ext_vector_type(2)));
typedef unsigned u32x4 __attribute__((ext_vector_type(4)));
typedef unsigned u32x2 __attribute__((ext_vector_type(2)));

__device__ __forceinline__ float sigmoidf_(float x) { return 1.f / (1.f + expf(-x)); }
__device__ __forceinline__ float siluf_(float x) { return x * sigmoidf_(x); }
__device__ __forceinline__ float gelu_tanh(float x) { return 0.5f * x * (1.f + tanhf(0.7978845608028654f * (x + 0.044715f * x * x * x))); }
__device__ __forceinline__ int row_mod(int row) { return row < ML ? row / SEQ : 4; }
__device__ __forceinline__ unsigned f2bf(float f) { unsigned u = __builtin_bit_cast(unsigned, f); return (u + 0x7fffu + ((u >> 16) & 1u)) >> 16; }
__device__ __forceinline__ unsigned pk2(float lo, float hi) { return f2bf(lo) | (f2bf(hi) << 16); }
__device__ __forceinline__ float bf_lo(unsigned w) { return __builtin_bit_cast(float, w << 16); }
__device__ __forceinline__ float bf_hi(unsigned w) { return __builtin_bit_cast(float, w & 0xffff0000u); }
__device__ __forceinline__ unsigned cvt_pk_bf16(float lo, float hi) { unsigned r; asm volatile("v_cvt_pk_bf16_f32 %0, %1, %2" : "=v"(r) : "v"(lo), "v"(hi)); return r; }
__device__ __forceinline__ float fast_exp2(float x) { return __builtin_amdgcn_exp2f(x); }
__device__ __forceinline__ float fast_rcp(float x) { return __builtin_amdgcn_rcpf(x); }
__device__ __forceinline__ float fast_sigmoid(float x) { return fast_rcp(1.f + fast_exp2(-1.4426950408889634f * x)); }

namespace nv {
__global__ void k_norm_mod(const float* X, const float* g, const float* mods_l, int sh_idx, float* H, int ldh) {
    const int row = blockIdx.x, tid = threadIdx.x;
    const float* xr = X + (size_t)row * D;
    float v[8], ss = 0.f;
#pragma unroll
    for (int j = 0; j < 8; ++j) { v[j] = xr[tid + 256 * j]; ss += v[j] * v[j]; }
    __shared__ float red[256];
    red[tid] = ss; __syncthreads();
    for (int o = 128; o > 0; o >>= 1) { if (tid < o) red[tid] += red[tid + o]; __syncthreads(); }
    const float rstd = rsqrtf(red[0] / D + 1e-6f);
    const int m = row_mod(row);
#pragma unroll
    for (int j = 0; j < 8; ++j) {
        const int col = tid + 256 * j; float h = v[j] * rstd * g[col];
        if (sh_idx >= 0) { const float sh = mods_l[(size_t)m * MODW + sh_idx * D + col], sc = mods_l[(size_t)m * MODW + (sh_idx + 1) * D + col]; h = h * (1.f + sc) + sh; }
        H[(size_t)row * ldh + col] = h;
    }
}
__global__ __launch_bounds__(256) void k_sgemm(const float* A, int lda, size_t sA, const float* B, int ldb, size_t sB, float* C, int ldc, size_t sC, int K) {
    __shared__ float As[16][128 + 4], Bs[16][128 + 4];
    A += blockIdx.z * sA; B += blockIdx.z * sB; C += blockIdx.z * sC;
    const int tid = threadIdx.x, tx = tid & 15, ty = tid >> 4;
    const int m0 = blockIdx.y * 128, n0 = blockIdx.x * 128;
    float acc[8][8];
#pragma unroll
    for (int i = 0; i < 8; ++i)
#pragma unroll
        for (int j = 0; j < 8; ++j) acc[i][j] = 0.f;
    for (int k0 = 0; k0 < K; k0 += 16) {
#pragma unroll
        for (int i = 0; i < 2; ++i) {
            const int r = (tid >> 2) + 64 * i, kq = (tid & 3) * 4;
            const float4 a = *(const float4*)(A + (size_t)(m0 + r) * lda + k0 + kq);
            As[kq + 0][r] = a.x; As[kq + 1][r] = a.y; As[kq + 2][r] = a.z; As[kq + 3][r] = a.w;
            const int kk = (tid >> 5) + 8 * i, nq = (tid & 31) * 4;
            const float4 b = *(const float4*)(B + (size_t)(k0 + kk) * ldb + n0 + nq);
            *(float4*)&Bs[kk][nq] = b;
        }
        __syncthreads();
#pragma unroll
        for (int k = 0; k < 16; ++k) {
            float a[8], b[8];
            *(float4*)&a[0] = *(const float4*)&As[k][ty * 4]; *(float4*)&a[4] = *(const float4*)&As[k][64 + ty * 4];
            *(float4*)&b[0] = *(const float4*)&Bs[k][tx * 4]; *(float4*)&b[4] = *(const float4*)&Bs[k][64 + tx * 4];
#pragma unroll
            for (int i = 0; i < 8; ++i)
#pragma unroll
                for (int j = 0; j < 8; ++j) acc[i][j] += a[i] * b[j];
        }
        __syncthreads();
    }
#pragma unroll
    for (int i = 0; i < 8; ++i) {
        const int r = m0 + (i < 4 ? ty * 4 + i : 64 + ty * 4 + i - 4);
        *(float4*)(C + (size_t)r * ldc + n0 + tx * 4) = make_float4(acc[i][0], acc[i][1], acc[i][2], acc[i][3]);
        *(float4*)(C + (size_t)r * ldc + n0 + 64 + tx * 4) = make_float4(acc[i][4], acc[i][5], acc[i][6], acc[i][7]);
    }
}
__global__ void k_resid(float* X, const float* O, const float* mods_l, int g_idx, int rows) {
    const size_t i = (size_t)blockIdx.x * 256 + threadIdx.x; if (i >= (size_t)rows * D) return;
    const int row = i / D, col = i % D, m = row_mod(row);
    X[i] += mods_l[(size_t)m * MODW + g_idx * D + col] * O[i];
}
__global__ void k_sqrelu(float* A, size_t n) { const size_t i = (size_t)blockIdx.x * 256 + threadIdx.x; if (i < n) { const float v = fmaxf(A[i], 0.f); A[i] = v * v; } }
__global__ void k_conv(const float* GU, const float* cw, const float* cb, float* UC) {
    const size_t i = (size_t)blockIdx.x * 256 + threadIdx.x; if (i >= (size_t)M * LW) return;
    const int row = i / LW, c = i % LW;
    int seg0, seglen; if (row < ML) { seg0 = (row / SEQ) * SEQ; seglen = SEQ; } else { seg0 = ML + ((row - ML) / CTX) * CTX; seglen = CTX; }
    const int t = row - seg0; float s = cb[c];
    for (int j = 0; j < 4; ++j) { const int tt = t + j - 2; if (tt >= 0 && tt < seglen) s += cw[j * LW + c] * GU[(size_t)(seg0 + tt) * (2 * LW) + LW + c]; }
    UC[i] = s;
}
__global__ void k_lru_coef(float* RA, float* RX, const float* UC, const float* ba, const float* bx, const float* lam) {
    const size_t i = (size_t)blockIdx.x * 256 + threadIdx.x; if (i >= (size_t)M * LW) return;
    const int c = i % LW;
    const float r = sigmoidf_(RA[i] + ba[c]), ig = sigmoidf_(RX[i] + bx[c]);
    const float sp = log1pf(expf(-lam[c]));
    const float log_a = -8.f * r * sp;
    RA[i] = expf(log_a);
    RX[i] = sqrtf(-expm1f(2.f * log_a)) * (ig * UC[i]);
}
__global__ void k_scan_dir(const float* A, const float* Bc, float* Y, int dir) {
    const int idx = blockIdx.x * 256 + threadIdx.x; if (idx >= BATCH * LW) return;
    const int b = idx / LW, c = idx % LW;
    float h = 0.f;
    if (dir == 0) {
        for (int t = 0; t < CTX; ++t) { const size_t o = (size_t)(ML + b * CTX + t) * LW + c; h = A[o] * h + Bc[o]; Y[o] = h; }
        for (int t = 0; t < SEQ; ++t) { const size_t o = (size_t)(b * SEQ + t) * LW + c; h = A[o] * h + Bc[o]; Y[o] = h; }
    } else {
        for (int t = CTX - 1; t >= 0; --t) { const size_t o = (size_t)(ML + b * CTX + t) * LW + c; h = A[o] * h + Bc[o]; Y[o] += h; }
        for (int t = SEQ - 1; t >= 0; --t) { const size_t o = (size_t)(b * SEQ + t) * LW + c; h = A[o] * h + Bc[o]; Y[o] += h; }
    }
}
__global__ void k_gate_mul(const float* GU, const float* Y, float* Z) {
    const size_t i = (size_t)blockIdx.x * 256 + threadIdx.x; if (i >= (size_t)M * LW) return;
    const int row = i / LW, c = i % LW;
    Z[i] = gelu_tanh(GU[(size_t)row * (2 * LW) + c]) * Y[i];
}
__global__ __launch_bounds__(256) void k_attn(const float* QKV, const float* rpb_l, float* O) {
    __shared__ float qs[4][HD], ps[4][384];
    const int w = threadIdx.x >> 6, lane = threadIdx.x & 63;
    const int gw = blockIdx.x * 4 + w; const int row = gw / NH, h = gw % NH;
    const bool lat = row < ML;
    const int b = lat ? row / SEQ : (row - ML) / CTX;
    const int t = lat ? row % SEQ : 0, r = t / GRID_W, c = t % GRID_W;
    int rs = r - 4; rs = rs < 0 ? 0 : (rs > 24 ? 24 : rs);
    int cs = c - 8; cs = cs < 0 ? 0 : (cs > 48 ? 48 : cs);
    const float scale = 0.08838834764831845f;
    qs[w][lane] = QKV[(size_t)row * (3 * D) + h * HD + lane]; qs[w][lane + 64] = QKV[(size_t)row * (3 * D) + h * HD + lane + 64];
    __syncthreads();
    float s[6]; float mx = -1e30f;
#pragma unroll
    for (int i = 0; i < 6; ++i) {
        const int j = lane + 64 * i; int krow; float bias = 0.f; bool valid = true;
        if (j < 128) { const int a = j >> 4, kk = j & 15; krow = b * SEQ + (rs + a) * GRID_W + cs + kk; bias = rpb_l[(h * 15 + (rs + a - r + 7)) * 31 + (cs + kk - c + 15)]; valid = lat; }
        else krow = ML + b * CTX + (j - 128);
        float d = 0.f;
        if (valid) { const float* kp = QKV + (size_t)krow * (3 * D) + D + h * HD; for (int e = 0; e < HD; ++e) d += qs[w][e] * kp[e]; d = d * scale + bias; } else d = -1e30f;
        s[i] = d; mx = fmaxf(mx, d);
    }
    for (int o = 32; o > 0; o >>= 1) mx = fmaxf(mx, __shfl_xor(mx, o));
    float sum = 0.f;
#pragma unroll
    for (int i = 0; i < 6; ++i) { const float p = (s[i] <= -1e29f) ? 0.f : expf(s[i] - mx); s[i] = p; sum += p; }
    for (int o = 32; o > 0; o >>= 1) sum += __shfl_xor(sum, o);
    const float inv = 1.f / sum;
#pragma unroll
    for (int i = 0; i < 6; ++i) ps[w][lane + 64 * i] = s[i] * inv;
    __syncthreads();
    float o0 = 0.f, o1 = 0.f;
    for (int j = lat ? 0 : 128; j < 384; ++j) {
        int krow; if (j < 128) { const int a = j >> 4, kk = j & 15; krow = b * SEQ + (rs + a) * GRID_W + cs + kk; } else krow = ML + b * CTX + (j - 128);
        const float* vp = QKV + (size_t)krow * (3 * D) + 2 * D + h * HD; const float p = ps[w][j];
        o0 += p * vp[lane]; o1 += p * vp[lane + 64];
    }
    O[(size_t)row * D + h * HD + lane] = o0; O[(size_t)row * D + h * HD + lane + 64] = o1;
}
}

namespace pg8 {
constexpr int BM = 256, BK = 64, HALF = 128, HTB = HALF * BK * 2, STAGE_BYTES = 8 * HTB, NXCD = 8, WGM = 4;
__host__ __device__ __forceinline__ int lds_byte(int r, int c) { const int st = (r >> 4) * 2 + (c >> 5), rr = r & 15, cc = c & 31, ob = rr * 64 + cc * 2; return st * 1024 + (ob ^ (((ob >> 9) & 1) << 5)); }
__host__ __device__ __forceinline__ void stage_rc(int b, int& R, int& C) { const int st = b / 1024, sb = b % 1024, swz = sb ^ (((sb >> 9) & 1) << 5); R = (st >> 1) * 16 + swz / 64; C = (st & 1) * 32 + (swz % 64) / 2; }
__host__ __device__ __forceinline__ int perm32(int rho) { const int n = rho >> 4, i = rho & 15; return 8 * (i >> 2) + 4 * n + (i & 3); }
struct Unit { int pm, pn, sw, ks; };
struct Gemm { const bf16_t* A; const bf16_t* Bt; int lda, ldb, K, apn_shift; const bf16_t* A2; const bf16_t* Bt2; int ksplit; };
__device__ __forceinline__ int gemm_cc(int U, int G) { if (G & 7) return G; const int R = (U + G - 1) / G; int c = (U + R - 1) / R; c = (c + 7) & ~7; return c > G ? G : c; }
constexpr int CC_TAB_OFF = 131072 + 512;
struct StaticOrder {
    int nM, nN, nwg, G, c, nM2, nN2, nwg2, split;
    __device__ void init(int nM_, int nN_, int G_, int c_, int nM2_ = 0, int nN2_ = 0, int split_ = 0) { nM = nM_; nN = nN_; nwg = nM * nN; G = G_; c = c_; nM2 = nM2_; nN2 = nN2_; split = split_; nwg2 = split_ ? nM2 * nN2 * 8 : nM2 * nN2; }
    __device__ static void map(int wgid, int nM, int nN, int nwg, Unit& u) {
        { const int q = nwg / NXCD, r = nwg % NXCD, xcd = wgid % NXCD, off = wgid / NXCD; wgid = (xcd < r ? xcd * (q + 1) : r * (q + 1) + (xcd - r) * q) + off; }
        const int nig = WGM * nN, gid = wgid / nig, fm = gid * WGM, gsz = (nM - fm) < WGM ? (nM - fm) : WGM;
        u.pm = fm + ((wgid % nig) % gsz); u.pn = (wgid % nig) / gsz;
    }
    __device__ bool next(int i, Unit& u, const LAS unsigned char* lds, int cck) const {
        int Gs = G, cs = c; if (cck) { Gs = __builtin_amdgcn_readfirstlane(*(volatile const LAS int*)(lds + CC_TAB_OFF + 4 * cck)); cs = c < Gs ? c : (1 << 28); }
        const long L = (long)i * Gs + cs; if ((unsigned long)L >= (unsigned long)(nwg + nwg2)) return false;
        u.ks = 0;
        if (L < nwg) { map((int)L, nM, nN, nwg, u); u.sw = 0; }
        else if (!split) { map((int)L - nwg, nM2, nN2, nwg2, u); u.sw = 1; }
        else { const int L2 = (int)L - nwg; int tile, ks;
            if (nwg2 == 256) { const int x = L2 & 7, jj = L2 >> 3; tile = x * 4 + (jj >> 3); ks = jj & 7; } else { tile = L2 >> 3; ks = L2 & 7; }
            u.pm = nM + tile / nN2; u.pn = tile % nN2; u.sw = 1; u.ks = ks; }
        return true;
    }
};
template <class Epi, bool ALIGN_EPI, bool SP2, int CCK = 0>
__device__ __forceinline__ void gemm_phase(LAS unsigned char* lds, const Gemm g, const StaticOrder& S, const Epi& E) {
    int tid = threadIdx.x; asm volatile("" : "+v"(tid));
    const int wid = __builtin_amdgcn_readfirstlane(tid >> 6), lane = tid & 63, wr = wid >> 2, wc = wid & 3, fr = lane & 15, fq = lane >> 4;
    const int KT = g.K / BK, spl_e = (KT / 8) & ~1, spl_x = (KT - 8 * spl_e) / 2;
    unsigned voffA[2], voffB[2];
#pragma unroll
    for (int i = 0; i < 2; ++i) { int R, C; stage_rc(tid * 16 + i * 8192, R, C); const int Rb = Epi::PERM ? ((R & ~31) + perm32(R & 31)) : R;
        voffA[i] = (unsigned)(R * g.lda + C) * 2u; voffB[i] = (unsigned)(Rb * g.ldb + C) * 2u; }
    const size_t kstep = (size_t)(BK * 2);
    const size_t hstepA = (size_t)HALF * g.lda * 2, tstepA = 2 * hstepA, hstepB = (size_t)HALF * g.ldb * 2, tstepB = 2 * hstepB;
    const unsigned ldsw = (unsigned)wid * 1024u;
    const int aoff = lds_byte(wr * 64 + fr, fq * 8), boff = lds_byte(wc * 32 + fr, fq * 8);
#define PG8_SA(b, h) (((b) * 2 + (h)) * HTB)
#define PG8_SB(b, h) ((4 + (b) * 2 + (h)) * HTB)
#define PG8_STAGE(bufoff, gbase, voff) do { _Pragma("unroll") for (int _i = 0; _i < 2; ++_i) \
        __builtin_amdgcn_global_load_lds((const unsigned*)((const char*)(gbase) + (voff)[_i]), (LAS unsigned*)(lds + (bufoff) + ldsw + _i * 8192), 16, 0, 0); } while (0)
#define PG8_LDA(dst, b, h) do { _Pragma("unroll") for (int m = 0; m < 4; ++m) _Pragma("unroll") for (int k = 0; k < 2; ++k) dst[m][k] = *(const LAS bf16x8*)(lds + PG8_SA(b, h) + aoff + m * 2048 + k * 1024); } while (0)
#define PG8_LDB(dst, b, h) do { _Pragma("unroll") for (int n = 0; n < 2; ++n) _Pragma("unroll") for (int k = 0; k < 2; ++k) dst[n][k] = *(const LAS bf16x8*)(lds + PG8_SB(b, h) + boff + n * 2048 + k * 1024); } while (0)
#define PG8_MMA(ai, bj, At, Bt) do { __builtin_amdgcn_s_setprio(1); _Pragma("unroll") for (int m = 0; m < 4; ++m) _Pragma("unroll") for (int n = 0; n < 2; ++n) _Pragma("unroll") for (int k = 0; k < 2; ++k) \
        acc[ai][bj][m][n] = __builtin_amdgcn_mfma_f32_16x16x32_bf16(Bt[n][k], At[m][k], acc[ai][bj][m][n], 0, 0, 0); __builtin_amdgcn_s_setprio(0); } while (0)
#define PG8_WAIT_V(n) asm volatile("s_waitcnt vmcnt(" #n ")" ::: "memory")
#define PG8_WAIT_L(n) asm volatile("s_waitcnt lgkmcnt(" #n ")" ::: "memory")
#define PG8_BAR __builtin_amdgcn_s_barrier()
#define PG8_SCHED __builtin_amdgcn_sched_barrier(0)
#define PG8_KOFF(u) ((g.ksplit && (u).sw) ? (size_t)(spl_e * (u).ks + 2 * ((u).ks < spl_x ? (u).ks : spl_x)) * kstep : (size_t)0)
#define PG8_NT(u) ((g.ksplit && (u).sw) ? spl_e + ((u).ks < spl_x ? 2 : 0) : KT)
#define PG8_APTR(u) ((const char*)((u).sw ? g.A2 : g.A) + (size_t)(u).pm * tstepA + (g.apn_shift >= 0 ? (size_t)((u).pn >> g.apn_shift) * 512 : (size_t)0) + PG8_KOFF(u))
#define PG8_BPTR(u) ((const char*)((u).sw ? g.Bt2 : g.Bt) + (size_t)(u).pn * tstepB + PG8_KOFF(u))
    Unit cur, nxt; int ui = 0;
    if (!S.next(0, cur, lds, CCK)) return;
    f32x4 acc[2][2][4][2];
#pragma unroll
    for (int a = 0; a < 2; ++a)
#pragma unroll
        for (int b = 0; b < 2; ++b)
#pragma unroll
            for (int m = 0; m < 4; ++m)
#pragma unroll
                for (int n = 0; n < 2; ++n) acc[a][b][m][n] = (f32x4){0.f, 0.f, 0.f, 0.f};
    bf16x8 At[4][2], B0[2][2], B1[2][2];
    const char* cA = PG8_APTR(cur); const char* cB = PG8_BPTR(cur); int nt = PG8_NT(cur);
    if constexpr (SP2) {
        PG8_STAGE(PG8_SB(0, 0), cB, voffB); PG8_STAGE(PG8_SB(0, 1), cB + hstepB, voffB); PG8_STAGE(PG8_SA(0, 0), cA, voffA); PG8_STAGE(PG8_SA(0, 1), cA + hstepA, voffA);
        if (wr == 1) PG8_BAR;
        PG8_WAIT_V(2); PG8_BAR;
        PG8_STAGE(PG8_SB(1, 0), cB + kstep, voffB); PG8_STAGE(PG8_SA(1, 0), cA + kstep, voffA); PG8_STAGE(PG8_SB(1, 1), cB + hstepB + kstep, voffB);
        PG8_WAIT_V(6); PG8_BAR;
    } else {
        PG8_STAGE(PG8_SB(0, 0), cB, voffB); PG8_STAGE(PG8_SA(0, 0), cA, voffA); PG8_STAGE(PG8_SB(0, 1), cB + hstepB, voffB); PG8_STAGE(PG8_SA(0, 1), cA + hstepA, voffA);
        if (wr == 1) PG8_BAR;
        PG8_WAIT_V(4); PG8_BAR;
        PG8_STAGE(PG8_SB(1, 0), cB + kstep, voffB); PG8_STAGE(PG8_SA(1, 0), cA + kstep, voffA); PG8_STAGE(PG8_SB(1, 1), cB + hstepB + kstep, voffB);
        PG8_WAIT_V(6); PG8_BAR;
    }
    for (;;) {
        const bool has_next = S.next(ui + 1, nxt, lds, CCK);
        const char* nA = has_next ? PG8_APTR(nxt) : cA; const char* nB = has_next ? PG8_BPTR(nxt) : cB;
        for (int t = 0; t < nt; t += 2) {
            const bool last = (t == nt - 2);
            const char* a1 = cA + (size_t)(t + 1) * kstep;
            const char* a2 = last ? nA : cA + (size_t)(t + 2) * kstep; const char* b2 = last ? nB : cB + (size_t)(t + 2) * kstep;
            const char* a3 = a2 + kstep; const char* b3 = b2 + kstep;
            if constexpr (SP2) {
            PG8_LDB(B0, 0, 0); PG8_LDB(B1, 0, 1); PG8_SCHED; PG8_LDA(At, 0, 0); PG8_STAGE(PG8_SA(1, 1), a1 + hstepA, voffA);
            PG8_WAIT_V(8); PG8_WAIT_L(0); PG8_BAR; PG8_MMA(0, 0, At, B0); PG8_MMA(0, 1, At, B1); PG8_BAR; PG8_SCHED;
            PG8_LDA(At, 0, 1); PG8_STAGE(PG8_SB(0, 0), b2, voffB); PG8_STAGE(PG8_SB(0, 1), b2 + hstepB, voffB); PG8_STAGE(PG8_SA(0, 0), a2, voffA);
            PG8_WAIT_V(8); PG8_WAIT_L(0); PG8_BAR; PG8_MMA(1, 0, At, B0); PG8_MMA(1, 1, At, B1); PG8_BAR; PG8_SCHED;
            PG8_LDB(B0, 1, 0); PG8_LDB(B1, 1, 1); PG8_SCHED; PG8_LDA(At, 1, 0); PG8_STAGE(PG8_SA(0, 1), a2 + hstepA, voffA);
            PG8_WAIT_V(8); PG8_WAIT_L(0); PG8_BAR; PG8_MMA(0, 0, At, B0); PG8_MMA(0, 1, At, B1); PG8_BAR; PG8_SCHED;
            PG8_LDA(At, 1, 1); PG8_STAGE(PG8_SB(1, 0), b3, voffB); PG8_STAGE(PG8_SB(1, 1), b3 + hstepB, voffB); PG8_STAGE(PG8_SA(1, 0), a3, voffA);
            PG8_WAIT_V(8); PG8_WAIT_L(0); PG8_BAR; PG8_MMA(1, 0, At, B0); PG8_MMA(1, 1, At, B1); PG8_BAR; PG8_SCHED;
            } else {
            PG8_LDB(B0, 0, 0); PG8_SCHED; PG8_LDA(At, 0, 0); PG8_STAGE(PG8_SA(1, 1), a1 + hstepA, voffA);
            PG8_WAIT_L(8); PG8_BAR; PG8_WAIT_L(0); PG8_MMA(0, 0, At, B0); PG8_BAR; PG8_SCHED;
            PG8_LDB(B1, 0, 1); PG8_STAGE(PG8_SB(0, 0), b2, voffB);
            PG8_BAR; PG8_WAIT_L(0); PG8_MMA(0, 1, At, B1); PG8_BAR;
            PG8_LDA(At, 0, 1); PG8_STAGE(PG8_SA(0, 0), a2, voffA);
            PG8_BAR; PG8_WAIT_L(0); PG8_MMA(1, 0, At, B0); PG8_BAR; PG8_SCHED;
            PG8_STAGE(PG8_SB(0, 1), b2 + hstepB, voffB);
            PG8_WAIT_V(6); PG8_BAR; PG8_MMA(1, 1, At, B1); PG8_BAR;
            PG8_LDB(B0, 1, 0); PG8_SCHED; PG8_LDA(At, 1, 0); PG8_STAGE(PG8_SA(0, 1), a2 + hstepA, voffA);
            PG8_WAIT_L(8); PG8_BAR; PG8_WAIT_L(0); PG8_MMA(0, 0, At, B0); PG8_BAR; PG8_SCHED;
            PG8_LDB(B1, 1, 1); PG8_STAGE(PG8_SB(1, 0), b3, voffB);
            PG8_BAR; PG8_WAIT_L(0); PG8_MMA(0, 1, At, B1); PG8_BAR;
            PG8_LDA(At, 1, 1); PG8_STAGE(PG8_SA(1, 0), a3, voffA);
            PG8_BAR; PG8_WAIT_L(0); PG8_MMA(1, 0, At, B0); PG8_BAR; PG8_SCHED;
            PG8_STAGE(PG8_SB(1, 1), b3 + hstepB, voffB);
            PG8_WAIT_V(6); PG8_BAR; PG8_MMA(1, 1, At, B1); PG8_BAR;
            }
        }
        if constexpr (ALIGN_EPI) { if (wr == 0) PG8_BAR; }
        { int tz = threadIdx.x; asm volatile("" : "+v"(tz));
          const int wz = __builtin_amdgcn_readfirstlane(tz >> 6), lz = tz & 63; E(acc, cur, wz >> 2, wz & 3, lz & 15, lz >> 4); }
        if (!has_next) break;
#pragma unroll
        for (int a = 0; a < 2; ++a)
#pragma unroll
            for (int b = 0; b < 2; ++b)
#pragma unroll
                for (int m = 0; m < 4; ++m)
#pragma unroll
                    for (int n = 0; n < 2; ++n) acc[a][b][m][n] = (f32x4){0.f, 0.f, 0.f, 0.f};
        cur = nxt; cA = nA; cB = nB; ++ui; nt = PG8_NT(cur);
        if constexpr (ALIGN_EPI) { if (wr == 1) PG8_BAR; }
    }
    PG8_WAIT_V(0);
    if constexpr (!ALIGN_EPI) { if (wr == 0) PG8_BAR; }
    PG8_BAR;
#undef PG8_SA
#undef PG8_SB
#undef PG8_STAGE
#undef PG8_LDA
#undef PG8_LDB
#undef PG8_MMA
#undef PG8_WAIT_V
#undef PG8_WAIT_L
#undef PG8_BAR
#undef PG8_SCHED
#undef PG8_APTR
#undef PG8_BPTR
#undef PG8_KOFF
#undef PG8_NT
}

template <int ACT> struct EpiAct {
    static constexpr bool PERM = true;
    bf16_t* O; int ldc;
    __device__ __forceinline__ void operator()(const f32x4 (&acc)[2][2][4][2], const Unit& u, int wr, int wc, int fr, int fq) const {
        const int row0 = u.pm * BM + wr * 64 + fr, col0 = u.pn * BM + wc * 32 + 8 * fq;
#pragma unroll
        for (int ai = 0; ai < 2; ++ai)
#pragma unroll
            for (int m = 0; m < 4; ++m) { bf16_t* rowp = O + (size_t)(row0 + ai * HALF + m * 16) * ldc + col0;
#pragma unroll
                for (int bj = 0; bj < 2; ++bj) { f32x4 v0 = acc[ai][bj][m][0], v1 = acc[ai][bj][m][1];
                    if (ACT == 1) {
#pragma unroll
                        for (int j = 0; j < 4; ++j) { const float a = fmaxf(v0[j], 0.f), b = fmaxf(v1[j], 0.f); v0[j] = a * a; v1[j] = b * b; } }
                    u32x4 w; w.x = cvt_pk_bf16(v0[0], v0[1]); w.y = cvt_pk_bf16(v0[2], v0[3]); w.z = cvt_pk_bf16(v1[0], v1[1]); w.w = cvt_pk_bf16(v1[2], v1[3]);
                    *(u32x4*)(rowp + bj * HALF) = w; } }
    }
};
constexpr long long RN_DXN = (471ll - 399ll) << 20;
constexpr long long RN_DSLOT = (838ll - 399ll) << 20;
constexpr long long RN_DCNT = 131072ll - (399ll << 20);
constexpr int RN_LDS = 131072 + 4096;
template <bool XF32, int FUSE = 0  > struct EpiResidT {
    static constexpr bool PERM = true;
    bf16_t* X; const float* mods_l; int gidx; float* slab; const float* xin; const float* ng; int nsh_off; unsigned want; LAS unsigned char* lds;
    __device__ __forceinline__ void fuse_tail(f32x4 (&acc)[2][2][4][2], const float (&ssq)[2][4], const Unit& u, int wr, int wc, int fr, int fq, int mi, int row0, int col0) const {
        LAS float* P = (LAS float*)(lds + RN_LDS); LAS float* S = P + 1024; LAS unsigned* flag = (LAS unsigned*)(S + 256);
        const int wid = wr * 4 + wc, lane = fq * 16 + fr;
#pragma unroll
        for (int ai = 0; ai < 2; ++ai)
#pragma unroll
            for (int m = 0; m < 4; ++m) { float t = ssq[ai][m]; t += __shfl_xor(t, 16); t += __shfl_xor(t, 32);
                if (fq == 0) P[(ai * HALF + wr * 64 + m * 16 + fr) * 4 + wc] = t; }
        asm volatile("s_waitcnt lgkmcnt(0)" ::: "memory"); __builtin_amdgcn_s_barrier(); asm volatile("" ::: "memory");
        const int row = wid * 32 + (lane & 31);
        unsigned* slots = (unsigned*)((char*)X + RN_DSLOT) + ((size_t)(u.pm * BM + row) * 8);
        unsigned* pc = (unsigned*)((char*)X + RN_DCNT) + 64 * u.pm;
        if (lane < 32) { const f32x4 p = *(const LAS f32x4*)(P + row * 4); const float t = (p[0] + p[1]) + (p[2] + p[3]);
            __hip_atomic_store(slots + u.pn, __builtin_bit_cast(unsigned, t), __ATOMIC_RELAXED, __HIP_MEMORY_SCOPE_AGENT); }
        asm volatile("s_waitcnt vmcnt(0)" ::: "memory");
        if (lane == 0) __hip_atomic_fetch_add(pc, 1u, __ATOMIC_RELAXED, __HIP_MEMORY_SCOPE_AGENT);
        if (FUSE == 1 && !XF32) {
            int r0o = row0; asm volatile("" : "+v"(r0o)); bf16_t* xb = X + (size_t)r0o * D + col0;
#pragma unroll
            for (int ai = 0; ai < 2; ++ai)
#pragma unroll
                for (int m = 0; m < 4; ++m)
#pragma unroll
                    for (int bj = 0; bj < 2; ++bj) { const f32x4 v0 = acc[ai][bj][m][0], v1 = acc[ai][bj][m][1];
                        u32x4 w; w.x = cvt_pk_bf16(v0[0], v0[1]); w.y = cvt_pk_bf16(v0[2], v0[3]); w.z = cvt_pk_bf16(v1[0], v1[1]); w.w = cvt_pk_bf16(v1[2], v1[3]);
                        *(u32x4*)(xb + (size_t)(ai * HALF + m * 16) * D + bj * HALF) = w; }
        }
        if (wid == 0) { unsigned sp = 0u;
            while ((unsigned)__builtin_amdgcn_readfirstlane((int)__hip_atomic_load(pc, __ATOMIC_RELAXED, __HIP_MEMORY_SCOPE_AGENT)) < want) { __builtin_amdgcn_s_sleep(1); if (++sp > (1u << 18)) break; }
            __builtin_amdgcn_fence(__ATOMIC_ACQUIRE, "agent"); }
        asm volatile("s_waitcnt lgkmcnt(0)" ::: "memory"); __builtin_amdgcn_s_barrier(); asm volatile("" ::: "memory");
        if (lane < 32) { float t = 0.f;
#pragma unroll
            for (int k = 0; k < 8; ++k) t += __builtin_bit_cast(float, __hip_atomic_load(slots + k, __ATOMIC_RELAXED, __HIP_MEMORY_SCOPE_AGENT));
            S[row] = rsqrtf(t * (1.f / D) + 1e-6f); }
        asm volatile("s_waitcnt lgkmcnt(0)" ::: "memory"); __builtin_amdgcn_s_barrier(); asm volatile("" ::: "memory");
        if (FUSE == 2) {
            float* ob = slab + (size_t)row0 * D + col0;
#pragma unroll
            for (int bj = 0; bj < 2; ++bj) { const f32x4 G0 = *(const f32x4*)(ng + col0 + bj * HALF), G1 = *(const f32x4*)(ng + col0 + bj * HALF + 4);
#pragma unroll
                for (int ai = 0; ai < 2; ++ai)
#pragma unroll
                    for (int m = 0; m < 4; ++m) { const float rstd = S[ai * HALF + wr * 64 + m * 16 + fr];
                        *(f32x4*)(ob + (size_t)(ai * HALF + m * 16) * D + bj * HALF) = acc[ai][bj][m][0] * rstd * G0; *(f32x4*)(ob + (size_t)(ai * HALF + m * 16) * D + bj * HALF + 4) = acc[ai][bj][m][1] * rstd * G1; } }
            return;
        }
        bf16_t* XN = (bf16_t*)((char*)X + RN_DXN);
        const float* sh = mods_l + nsh_off + (size_t)mi * MODW + col0;
#pragma unroll
        for (int bj = 0; bj < 2; ++bj) { f32x4 GG[2], SS[2];
#pragma unroll
            for (int n = 0; n < 2; ++n) { GG[n] = *(const f32x4*)(ng + col0 + bj * HALF + 4 * n) * (*(const f32x4*)(sh + D + bj * HALF + 4 * n) + 1.f); SS[n] = *(const f32x4*)(sh + bj * HALF + 4 * n); }
#pragma unroll
            for (int ai = 0; ai < 2; ++ai)
#pragma unroll
                for (int m = 0; m < 4; ++m) { const float rstd = S[ai * HALF + wr * 64 + m * 16 + fr];
                    const f32x4 h0 = acc[ai][bj][m][0] * rstd * GG[0] + SS[0], h1 = acc[ai][bj][m][1] * rstd * GG[1] + SS[1];
                    u32x4 w; w.x = cvt_pk_bf16(h0[0], h0[1]); w.y = cvt_pk_bf16(h0[2], h0[3]); w.z = cvt_pk_bf16(h1[0], h1[1]); w.w = cvt_pk_bf16(h1[2], h1[3]);
                    *(u32x4*)(XN + (size_t)(row0 + ai * HALF + m * 16) * D + col0 + bj * HALF) = w; } }
    }
    __device__ __forceinline__ void operator()(f32x4 (&acc)[2][2][4][2], const Unit& u, int wr, int wc, int fr, int fq) const {
        if (u.sw) {
            bf16_t* base = (bf16_t*)slab + (size_t)(((u.pm - 32) * 8 + u.pn) * 8 + u.ks) * 65536 + (size_t)(wr * 64 + fr) * 256 + wc * 32 + 8 * fq;
#pragma unroll
            for (int ai = 0; ai < 2; ++ai)
#pragma unroll
                for (int m = 0; m < 4; ++m)
#pragma unroll
                    for (int bj = 0; bj < 2; ++bj) { const f32x4 v0 = acc[ai][bj][m][0], v1 = acc[ai][bj][m][1];
                        u32x4 w; w.x = cvt_pk_bf16(v0[0], v0[1]); w.y = cvt_pk_bf16(v0[2], v0[3]); w.z = cvt_pk_bf16(v1[0], v1[1]); w.w = cvt_pk_bf16(v1[2], v1[3]);
                        *(u32x4*)(base + (size_t)(ai * HALF + m * 16) * 256 + bj * HALF) = w; }
            return;
        }
        const int row0 = u.pm * BM + wr * 64 + fr, col0 = u.pn * BM + wc * 32 + 8 * fq;
        const int mi = u.pm < 32 ? (u.pm >> 3) : 4;
        const float* gt = mods_l + (size_t)mi * MODW + gidx * D + col0;
        f32x4 gv[2][2];
#pragma unroll
        for (int bj = 0; bj < 2; ++bj)
#pragma unroll
            for (int n = 0; n < 2; ++n) gv[bj][n] = *(const f32x4*)(gt + bj * HALF + 4 * n);
        float ssq[2][4];
#pragma unroll
        for (int ai = 0; ai < 2; ++ai)
#pragma unroll
            for (int m = 0; m < 4; ++m) ssq[ai][m] = 0.f;
        if (XF32) {
#pragma unroll
            for (int am = 0; am < 4; ++am) { const int ai = am >> 1, m0 = (am & 1) * 2;
                f32x4 xf[2][2][2];
#pragma unroll
                for (int mm = 0; mm < 2; ++mm)
#pragma unroll
                    for (int bj = 0; bj < 2; ++bj)
#pragma unroll
                        for (int n = 0; n < 2; ++n) xf[mm][bj][n] = *(const f32x4*)(xin + (size_t)(row0 + ai * HALF + (m0 + mm) * 16) * D + col0 + bj * HALF + 4 * n);
                __builtin_amdgcn_sched_barrier(0);
#pragma unroll
                for (int mm = 0; mm < 2; ++mm)
#pragma unroll
                    for (int bj = 0; bj < 2; ++bj) { const f32x4 v0 = xf[mm][bj][0] + gv[bj][0] * acc[ai][bj][m0 + mm][0], v1 = xf[mm][bj][1] + gv[bj][1] * acc[ai][bj][m0 + mm][1];
                        if (FUSE) { acc[ai][bj][m0 + mm][0] = v0; acc[ai][bj][m0 + mm][1] = v1; ssq[ai][m0 + mm] += ((v0[0] * v0[0] + v0[1] * v0[1]) + (v0[2] * v0[2] + v0[3] * v0[3])) + ((v1[0] * v1[0] + v1[1] * v1[1]) + (v1[2] * v1[2] + v1[3] * v1[3])); }
                        u32x4 w; w.x = cvt_pk_bf16(v0[0], v0[1]); w.y = cvt_pk_bf16(v0[2], v0[3]); w.z = cvt_pk_bf16(v1[0], v1[1]); w.w = cvt_pk_bf16(v1[2], v1[3]);
                        *(u32x4*)(X + (size_t)(row0 + ai * HALF + (m0 + mm) * 16) * D + col0 + bj * HALF) = w; }
                __builtin_amdgcn_sched_barrier(0);
            }
            if (FUSE) fuse_tail(acc, ssq, u, wr, wc, fr, fq, mi, row0, col0);
            return;
        }
#pragma unroll
        for (int ai = 0; ai < 2; ++ai) {
            u32x4 xo[4][2];
#pragma unroll
            for (int m = 0; m < 4; ++m)
#pragma unroll
                for (int bj = 0; bj < 2; ++bj) xo[m][bj] = *(const u32x4*)(X + (size_t)(row0 + ai * HALF + m * 16) * D + col0 + bj * HALF);
            __builtin_amdgcn_sched_barrier(0);
#pragma unroll
            for (int m = 0; m < 4; ++m)
#pragma unroll
                for (int bj = 0; bj < 2; ++bj) { const u32x4 x = xo[m][bj];
                    const f32x4 x0 = {bf_lo(x.x), bf_hi(x.x), bf_lo(x.y), bf_hi(x.y)}, x1 = {bf_lo(x.z), bf_hi(x.z), bf_lo(x.w), bf_hi(x.w)};
                    const f32x4 v0 = x0 + gv[bj][0] * acc[ai][bj][m][0], v1 = x1 + gv[bj][1] * acc[ai][bj][m][1];
                    if (FUSE) { acc[ai][bj][m][0] = v0; acc[ai][bj][m][1] = v1; ssq[ai][m] += ((v0[0] * v0[0] + v0[1] * v0[1]) + (v0[2] * v0[2] + v0[3] * v0[3])) + ((v1[0] * v1[0] + v1[1] * v1[1]) + (v1[2] * v1[2] + v1[3] * v1[3])); }
                    if (FUSE == 0) { u32x4 w; w.x = cvt_pk_bf16(v0[0], v0[1]); w.y = cvt_pk_bf16(v0[2], v0[3]); w.z = cvt_pk_bf16(v1[0], v1[1]); w.w = cvt_pk_bf16(v1[2], v1[3]);
                    *(u32x4*)(X + (size_t)(row0 + ai * HALF + m * 16) * D + col0 + bj * HALF) = w; } }
            __builtin_amdgcn_sched_barrier(0); asm volatile("" ::: "memory");
        }
        if (FUSE) fuse_tail(acc, ssq, u, wr, wc, fr, fq, mi, row0, col0);
    }
};
struct EpiQKV {
    static constexpr bool PERM = true;
    bf16_t* Q; bf16_t* KT; bf16_t* VT; float qscale;
    __device__ __forceinline__ void operator()(const f32x4 (&acc)[2][2][4][2], const Unit& u, int wr, int wc, int fr, int fq) const {
#pragma unroll
        for (int ai = 0; ai < 2; ++ai)
#pragma unroll
            for (int m = 0; m < 4; ++m)
#pragma unroll
                for (int bj = 0; bj < 2; ++bj) {
                    const int r = u.pm * BM + ai * HALF + wr * 64 + m * 16 + fr;
                    const int c = u.pn * BM + bj * HALF + wc * 32 + 8 * fq;
                    bf16_t* dst; float sc = 1.f;
                    if (!u.sw) {
                        if (u.pn < 8) { dst = Q + (size_t)r * D + c; sc = qscale; }
                        else { const int cc = c - D, h = cc >> 7, ch = (cc & 127) >> 3;
                            dst = KT + ((size_t)((r >> 3) * NH + h)) * 1024 + (ch >> 2) * 256 + ((r >> 2) & 1) * 128 + (r & 3) * 32 + (ch & 3) * 8; }
                    } else { const int h = r >> 7, d = r & 127;
                        dst = VT + ((size_t)(((c >> 3) * NH + h) * 8 + (d >> 4))) * 128 + (d & 15) * 8; }
                    const f32x4 v0 = acc[ai][bj][m][0] * sc, v1 = acc[ai][bj][m][1] * sc;
                    u32x4 w; w.x = cvt_pk_bf16(v0[0], v0[1]); w.y = cvt_pk_bf16(v0[2], v0[3]); w.z = cvt_pk_bf16(v1[0], v1[1]); w.w = cvt_pk_bf16(v1[2], v1[3]);
                    *(u32x4*)dst = w; }
    }
};
struct EpiGates {
    static constexpr bool PERM = true;
    const bf16_t* UC; unsigned* LB; const float* ba; const float* bx; const float* cA;
    __device__ __forceinline__ void operator()(const f32x4 (&acc)[2][2][4][2], const Unit& u, int wr, int wc, int fr, int fq) const {
        const int blk = u.pn >> 2, dir = (u.pn >> 1) & 1, half = u.pn & 1;
        const int row0 = u.pm * BM + wr * 64 + fr;
        unsigned* lb_d = LB + (size_t)dir * M * LW;
        const int ch0 = blk * 256 + half * 128 + wc * 32 + 8 * fq;
        unsigned pba[4], pbx[4], pca[4];
#pragma unroll
        for (int n = 0; n < 2; ++n) { const f32x4 t0 = *(const f32x4*)(ba + dir * LW + ch0 + 4 * n), t1 = *(const f32x4*)(bx + dir * LW + ch0 + 4 * n), t2 = *(const f32x4*)(cA + dir * LW + ch0 + 4 * n);
            pca[2 * n] = pk2(t2[0], t2[1]); pca[2 * n + 1] = pk2(t2[2], t2[3]);
            constexpr float NL = -1.4426950408889634f;
            pba[2 * n] = pk2(NL * t0[0], NL * t0[1]); pba[2 * n + 1] = pk2(NL * t0[2], NL * t0[3]); pbx[2 * n] = pk2(NL * t1[0], NL * t1[1]); pbx[2 * n + 1] = pk2(NL * t1[2], NL * t1[3]); }
        u32x4 ucw[2][2];
#define GATES_UCLOAD(buf, am_) do { _Pragma("unroll") for (int mm = 0; mm < 2; ++mm) ucw[buf][mm] = *(const u32x4*)(UC + (size_t)(row0 + ((am_) >> 1) * HALF + (((am_) & 1) * 2 + mm) * 16) * LW + ch0); } while (0)
        GATES_UCLOAD(0, 0);
#pragma unroll
        for (int am = 0; am < 4; ++am) { const int ai = am >> 1, m0 = (am & 1) * 2;
            if (am + 1 < 4) GATES_UCLOAD((am + 1) & 1, am + 1);
            __builtin_amdgcn_sched_barrier(0);
#pragma unroll
            for (int mm = 0; mm < 2; ++mm) { const int m = m0 + mm; const size_t ro = (size_t)(row0 + ai * HALF + m * 16) * LW + ch0;
                const unsigned uw[4] = {ucw[am & 1][mm].x, ucw[am & 1][mm].y, ucw[am & 1][mm].z, ucw[am & 1][mm].w};
                unsigned wv[8];
#pragma unroll
                for (int n = 0; n < 2; ++n) {
#pragma unroll
                    for (int j = 0; j < 4; ++j) { const int pi = 2 * n + (j >> 1);
                        const float ucv = (j & 1) ? bf_hi(uw[pi]) : bf_lo(uw[pi]), vb_a = (j & 1) ? bf_hi(pba[pi]) : bf_lo(pba[pi]), vb_x = (j & 1) ? bf_hi(pbx[pi]) : bf_lo(pbx[pi]);
                        const float rr = fast_rcp(1.f + fast_exp2(fmaf(acc[ai][0][m][n][j], -1.4426950408889634f, vb_a))), ig = fast_rcp(1.f + fast_exp2(fmaf(acc[ai][1][m][n][j], -1.4426950408889634f, vb_x)));
                        wv[4 * n + j] = cvt_pk_bf16(rr * ((j & 1) ? bf_hi(pca[pi]) : bf_lo(pca[pi])), ig * ucv); } }
                *(u32x4*)(lb_d + ro) = (u32x4){wv[0], wv[1], wv[2], wv[3]}; *(u32x4*)(lb_d + ro + 4) = (u32x4){wv[4], wv[5], wv[6], wv[7]}; }
            __builtin_amdgcn_sched_barrier(0);
        }
#undef GATES_UCLOAD
    }
};
}

#define XB_TMO      128
#define XB_XCNT(j)  (256  + 64 * (j))
#define XB_XSUB(j)  (1280 + 64 * (j))
#define XB_XGEN(j)  (2304 + 64 * (j))
#define XB_TOP      3328
#define XB_TOPGEN   3392
#define XCD_BAR_WORDS 3456
#define XB_SPIN_CAP (1u << 18)
__device__ __forceinline__ unsigned xb_ld(unsigned* p)              { return __hip_atomic_load(p, __ATOMIC_RELAXED, __HIP_MEMORY_SCOPE_AGENT); }
__device__ __forceinline__ unsigned xb_add(unsigned* p, unsigned v) { return __hip_atomic_fetch_add(p, v, __ATOMIC_RELAXED, __HIP_MEMORY_SCOPE_AGENT); }
__device__ __forceinline__ unsigned xb_xcc_id() { return (unsigned)__builtin_amdgcn_s_getreg((3 << 11) | 20) & 0xFu; }
#define XB_SPIN(cond, bar) do { unsigned _sp = 0; while (cond) { __builtin_amdgcn_s_sleep(1); \
    if ((++_sp & 255u) == 0u) { if (xb_ld(&(bar)[XB_TMO])) break; if (_sp > XB_SPIN_CAP) { atomicAdd(&(bar)[XB_TMO], 1u); break; } } } } while (0)
struct XcdBarrier { unsigned* bar; unsigned x; volatile LAS unsigned* st; };
__device__ __forceinline__ XcdBarrier xcd_barrier_post(unsigned* bar, volatile LAS unsigned* st) {
    XcdBarrier b; b.bar = bar; b.x = xb_xcc_id(); b.st = st;
    if (threadIdx.x == 0) (void)xb_add(&bar[XB_XCNT(b.x)], 1u);
    return b;
}
__device__ __forceinline__ void xcd_barrier_complete(unsigned* bar, unsigned x, unsigned& nloc, unsigned& nx) {
    const unsigned G = gridDim.x * gridDim.y * gridDim.z;
    unsigned sum, cnt, mine, sp = 0u;
    for (;;) {
        sum = 0u; cnt = 0u; mine = 0u;
#pragma unroll
        for (unsigned j = 0; j < 16; ++j) { const unsigned c = xb_ld(&bar[XB_XCNT(j)]); sum += c; cnt += (c > 0u) ? 1u : 0u; mine = (j == x) ? c : mine; }
        if (sum == G) break;
        __builtin_amdgcn_s_sleep(1);
        if ((++sp & 255u) == 0u) { if (xb_ld(&bar[XB_TMO])) break; if (sp > XB_SPIN_CAP) { atomicAdd(&bar[XB_TMO], 1u); break; } }
    }
    nloc = mine > 0u ? mine : 1u; nx = cnt > 0u ? cnt : 1u;
}
__device__ __forceinline__ void xcd_barrier(const XcdBarrier& b) {
    asm volatile("s_waitcnt vmcnt(0)" ::: "memory");
    __syncthreads();
    if (threadIdx.x == 0) {
        unsigned* bar = b.bar;
        __builtin_amdgcn_s_waitcnt(0);
        unsigned nloc = b.st[0], nx = b.st[1];
        if (nloc == 0u) { xcd_barrier_complete(bar, b.x, nloc, nx); b.st[0] = nloc; b.st[1] = nx; }
        const unsigned old = xb_add(&bar[XB_XSUB(b.x)], 1u);
        const unsigned gen = old / nloc;
        if (old + 1u == (gen + 1u) * nloc) {
            __builtin_amdgcn_fence(__ATOMIC_RELEASE, "agent");
            asm volatile("s_waitcnt vmcnt(0)" ::: "memory");
            const unsigned og = xb_add(&bar[XB_TOP], 1u);
            const unsigned tg = og / nx;
            if (og + 1u == (tg + 1u) * nx) xb_add(&bar[XB_TOPGEN], 1u);
            else XB_SPIN(xb_ld(&bar[XB_TOPGEN]) == tg, bar);
            __builtin_amdgcn_fence(__ATOMIC_ACQUIRE, "agent");
            xb_add(&bar[XB_XGEN(b.x)], 1u);
            asm volatile("s_waitcnt vmcnt(0)" ::: "memory");
        } else {
            XB_SPIN(xb_ld(&bar[XB_XGEN(b.x)]) == gen, bar);
            __builtin_amdgcn_fence(__ATOMIC_ACQUIRE, "agent");
            asm volatile("s_waitcnt vmcnt(0)" ::: "memory");
        }
    }
    __syncthreads();
}

constexpr size_t MiB = 1u << 20;
constexpr size_t WS_CTL = 0, CTL_ZERO_BYTES = 1 * MiB;
constexpr size_t WS_MODS = 1 * MiB;
constexpr size_t WS_WIN = 2 * MiB;
constexpr size_t WS_WG = 46 * MiB;
constexpr size_t WS_WOUT = 57 * MiB;
constexpr size_t WS_WQKV = 79 * MiB;
constexpr size_t WS_WO = 127 * MiB;
constexpr size_t WS_W1 = 143 * MiB;
constexpr size_t WS_W2 = 271 * MiB;
constexpr size_t WS_X = 399 * MiB;
constexpr size_t WS_XN = 471 * MiB;
constexpr size_t WS_BIG = 507 * MiB;
constexpr size_t WS_O = 651 * MiB;
constexpr size_t WS_CA = 687 * MiB;
constexpr size_t WS_UC = 688 * MiB;
constexpr size_t WS_LA = 738 * MiB;
constexpr size_t WS_BB = 838 * MiB;
constexpr size_t WS_Z = 938 * MiB;
constexpr size_t WS_AGGA = 988 * MiB, WS_AGGH = 995 * MiB, WS_CARRY = 1002 * MiB;
constexpr size_t WS_SLAB = 1009 * MiB;
constexpr size_t WS_FAST_END = 1073 * MiB;
constexpr size_t WS_NV = 688 * MiB;
static_assert((long long)WS_XN - (long long)WS_X == pg8::RN_DXN && (long long)WS_BB - (long long)WS_X == pg8::RN_DSLOT && (long long)WS_CTL + 131072 - (long long)WS_X == pg8::RN_DCNT && CTL_ZERO_BYTES >= 131072 + 32 * 256, "fused-norm exchange: slots (256 KiB at WS_BB, otherwise unused), panel counters in CTL");
constexpr int CW_BAR = 4096;
constexpr int CW_SPLIT = 16384;

constexpr int NWAVES = 8, NTHREADS = 512;
constexpr int LDS_BYTES = 147456;
constexpr int LDS_MISC = 131072;
constexpr int PH_PROLOGUE = 0, PH_NORM0 = 1, PH_LAYER0 = 2, PH_PER_LAYER = 12, PH_END = PH_LAYER0 + PH_PER_LAYER * DEPTH;

struct Args {
    const float* in[23]; float* out; unsigned char* ws; int ph_lo, ph_hi;
};

__device__ __forceinline__ float wave_sum(float v) {
#pragma unroll
    for (int o = 1; o < 64; o <<= 1) v += __shfl_xor(v, o);
    return v;
}
__device__ __forceinline__ void transpose_item(const float* W, int K, int N, bf16_t* WT, int k0, int n0, int dst_row0, int lane) {
    const int kb = lane & 7, nl = lane >> 3;
    const float* src = W + (size_t)(k0 + 8 * kb) * N + n0 + 4 * nl;
    f32x4 v[8];
#pragma unroll
    for (int i = 0; i < 8; ++i) v[i] = __builtin_nontemporal_load((const f32x4*)(src + (size_t)i * N));
    bf16_t* dst = WT + (size_t)(dst_row0 + 4 * nl) * K + k0 + 8 * kb;
#pragma unroll
    for (int j = 0; j < 4; ++j) { u32x4 o; o.x = pk2(v[0][j], v[1][j]); o.y = pk2(v[2][j], v[3][j]); o.z = pk2(v[4][j], v[5][j]); o.w = pk2(v[6][j], v[7][j]);
        *(u32x4*)(dst + (size_t)j * K) = o; }
}
__device__ __forceinline__ void transpose_group(int r, const float* src, int K, int N, bf16_t* dst, int lane) {
    const int nblk = N / 32, per = (K / 64) * nblk; const int mat = r / per, q = r % per, kb = q / nblk, nb = q % nblk;
    transpose_item(src + (size_t)mat * K * N, K, N, dst + (size_t)mat * N * K, 64 * kb, 32 * nb, 32 * nb, lane);
}


__device__ __forceinline__ unsigned char* tabp(volatile LAS unsigned* ptab, int i) {
    unsigned base = (unsigned)(size_t)ptab; asm volatile("" : "+v"(base));
    const u32x2 w = *(volatile LAS u32x2*)(base + 8u * (unsigned)i);
    return (unsigned char*)(GAS unsigned char*)(((unsigned long long)(unsigned)__builtin_amdgcn_readfirstlane((int)w.y) << 32) | (unsigned)__builtin_amdgcn_readfirstlane((int)w.x));
}
constexpr int C_W = (D / 64) * (FF / 32), C_IN = (D / 64) * (2 * LW / 32), C_OUT = (LW / 64) * (D / 32), C_QKV = (D / 64) * (3 * D / 32), C_O = (D / 64) * (D / 32), C_G = 2 * NLB * 2 * 32;
struct ConvAddr { const float* src; bf16_t* dst; int N, K; };
__device__ __forceinline__ ConvAddr conv_addr(volatile LAS unsigned* ptab, int kind, int l, int r, int lane) {
    unsigned char* ws = tabp(ptab, 24); const int kbl = lane & 7, nl = lane >> 3; ConvAddr a;
    if (kind == 6) { const int matl = r >> 5, q = r & 31, kb = q >> 3, nb = q & 7;
        const int gsel = matl & 1, db = matl >> 1, blk = db % NLB, d = db / NLB;
        const float* s0 = (const float*)tabp(ptab, gsel ? 16 : 14) + (size_t)((l * 2 + d) * NLB + blk) * LB * LB;
        const int n0 = 32 * nb, half = n0 >> 7, chn = n0 & 127, drow = blk * 1024 + ((d * 2 + half) * 2 + gsel) * 128 + chn;
        a.N = LB; a.K = LB; a.src = s0 + (size_t)(64 * kb + 8 * kbl) * LB + n0 + 4 * nl;
        a.dst = (bf16_t*)(ws + WS_WG) + (size_t)l * (NLB * 1024) * LB + (size_t)(drow + 4 * nl) * LB + 64 * kb + 8 * kbl;
        return a; }
    int K, N, inp; size_t wso;
    switch (kind) { case 0: K = D; N = FF; inp = 8; wso = WS_W1; break; case 1: K = FF; N = D; inp = 9; wso = WS_W2; break; case 2: K = D; N = 2 * LW; inp = 10; wso = WS_WIN; break;
                    case 3: K = LW; N = D; inp = 18; wso = WS_WOUT; break; case 4: K = D; N = 3 * D; inp = 19; wso = WS_WQKV; break; default: K = D; N = D; inp = 21; wso = WS_WO; break; }
    const int nblk = N / 32, kb = r / nblk, nb = r % nblk;
    a.N = N; a.K = K; a.src = (const float*)tabp(ptab, inp) + (size_t)l * K * N + (size_t)(64 * kb + 8 * kbl) * N + 32 * nb + 4 * nl;
    a.dst = (bf16_t*)(ws + wso) + (size_t)l * N * K + (size_t)(32 * nb + 4 * nl) * K + 64 * kb + 8 * kbl;
    return a;
}
__device__ __forceinline__ void conv_load(const ConvAddr& a, f32x4 (&v)[8]) {
#pragma unroll
    for (int i = 0; i < 8; ++i) v[i] = __builtin_nontemporal_load((const f32x4*)(a.src + (size_t)i * a.N));
}
__device__ __forceinline__ void conv_store(const ConvAddr& a, const f32x4 (&v)[8]) {
#pragma unroll
    for (int j = 0; j < 4; ++j) { u32x4 o; o.x = pk2(v[0][j], v[1][j]); o.y = pk2(v[2][j], v[3][j]); o.z = pk2(v[4][j], v[5][j]); o.w = pk2(v[6][j], v[7][j]);
        *(u32x4*)(a.dst + (size_t)j * a.K) = o; }
}
#define CSEG(kind, l, cnt) if (!fnd_ && r < (cnt)) { ck_ = (kind); cl_ = (l); fnd_ = true; } else if (!fnd_) r -= (cnt)
#define CSEGO(kind, l, off, cnt) if (!fnd_ && r < (cnt)) { ck_ = (kind); cl_ = (l); r += (off); fnd_ = true; } else if (!fnd_) r -= (cnt)
#define CONV_RUN(it0, st, nit, SEGS) do { for (int it_ = (it0); it_ < (nit); it_ += 2 * (st)) { ConvAddr ca_, cb_; f32x4 va_[8], vb_[8]; const bool two_ = it_ + (st) < (nit); \
        { int r = it_, ck_ = 0, cl_ = 0; bool fnd_ = false; SEGS; ca_ = conv_addr(ptab, ck_, cl_, r, lane); } conv_load(ca_, va_); \
        { int r = two_ ? it_ + (st) : it_, ck_ = 0, cl_ = 0; bool fnd_ = false; SEGS; cb_ = conv_addr(ptab, ck_, cl_, r, lane); } conv_load(cb_, vb_); \
        __builtin_amdgcn_sched_barrier(0); conv_store(ca_, va_); if (two_) conv_store(cb_, vb_); } } while (0)
__device__ __forceinline__ void ada_fill_ssil(volatile LAS unsigned* ptab, LAS unsigned char* lds, int tid) {
    const float* c = (const float*)tabp(ptab, 1); const float* c_ctx = (const float*)tabp(ptab, 3); LAS float* ssil = (LAS float*)lds;
    for (int i = tid; i < 5 * D; i += NTHREADS) { const int m = i / D, k = i % D; const float v = m < 4 ? c[m * D + k] : c_ctx[k]; ssil[i] = v / (1.f + expf(-v)); }
    __syncthreads();
}
constexpr int ADA_IT = 96;
template <int COLS>
__device__ __forceinline__ void ada_wg_item_t(volatile LAS unsigned* ptab, LAS unsigned char* lds, int layer, int col0, int tid) {
    int lane = tid & 63; asm volatile("" : "+v"(lane)); const int wave = __builtin_amdgcn_readfirstlane(tid >> 6);
    const float* ada_w = (const float*)tabp(ptab, 4); const float* ada_b = (const float*)tabp(ptab, 5); float* mods = (float*)(tabp(ptab, 24) + WS_MODS);
    LAS float* ssil = (LAS float*)lds; LAS float* red = (LAS float*)(lds + 40960);
    constexpr int LPR = COLS / 4, RPI = 64 / LPR;
    const int kr = lane / LPR, c4 = lane % LPR;
    const float* W = ada_w + ((size_t)layer * D + wave * 256 + 16 * kr) * MODW + col0 + 4 * c4;
    f32x4 a0 = {0.f, 0.f, 0.f, 0.f}, a1 = a0, a2 = a0, a3 = a0, a4 = a0;
    const LAS float* sp = ssil + wave * 256 + 16 * kr;
    for (int k = 0; k < 256; k += 16 * RPI) {
        f32x4 wv[16];
#pragma unroll
        for (int kk = 0; kk < 16; ++kk) wv[kk] = __builtin_nontemporal_load((const f32x4*)(W + (size_t)(k + kk) * MODW));
#pragma unroll
        for (int hh = 0; hh < 4; ++hh) { const int k4 = k + 4 * hh;
            const f32x4 s0 = *(const LAS f32x4*)(sp + k4), s1 = *(const LAS f32x4*)(sp + D + k4), s2 = *(const LAS f32x4*)(sp + 2 * D + k4), s3 = *(const LAS f32x4*)(sp + 3 * D + k4), s4 = *(const LAS f32x4*)(sp + 4 * D + k4);
#pragma unroll
            for (int kk = 0; kk < 4; ++kk) { const f32x4 w4 = wv[4 * hh + kk]; a0 += w4 * s0[kk]; a1 += w4 * s1[kk]; a2 += w4 * s2[kk]; a3 += w4 * s3[kk]; a4 += w4 * s4[kk]; } }
    }
    { LAS f32x4* rw = (LAS f32x4*)(red + (wave * RPI + kr) * 5 * COLS) + c4;
      rw[0] = a0; rw[LPR] = a1; rw[2 * LPR] = a2; rw[3 * LPR] = a3; rw[4 * LPR] = a4; }
    __syncthreads();
    for (int i = tid; i < 5 * COLS; i += NTHREADS) { const int m = i / COLS, l = i % COLS; float s = 0.f;
#pragma unroll
        for (int w2 = 0; w2 < 8 * RPI; ++w2) s += red[w2 * 5 * COLS + m * COLS + l];
        mods[((size_t)layer * 5 + m) * MODW + col0 + l] = s + ada_b[(size_t)layer * MODW + col0 + l]; }
    __syncthreads();
}
__device__ __forceinline__ void ada_wg_item(volatile LAS unsigned* ptab, LAS unsigned char* lds, int it, int tid) { ada_wg_item_t<128>(ptab, lds, it / ADA_IT, (it % ADA_IT) * 128, tid); }

#define FILLER(U, ADA_FIRST, NIT, SEGS) do { int Gl = G; asm volatile("" : "+s"(Gl)); const int nfull = (U) % Gl; \
    if (nfull == 0 || bxp >= nfull) { const int rank = nfull ? bxp - nfull : bxp, nidle = nfull ? Gl - nfull : Gl, nada = ((ADA_FIRST) >= 0 && nidle > ADA_IT) ? ADA_IT : 0; \
        int tid = threadIdx.x; asm volatile("" : "+v"(tid)); const int lane = tid & 63, wave = __builtin_amdgcn_readfirstlane(tid >> 6); \
        if ((ADA_FIRST) >= 0 && nada == 0) { ada_fill_ssil(ptab, lds, tid); for (int it_ = rank; it_ < ADA_IT; it_ += nidle) ada_wg_item(ptab, lds, (ADA_FIRST) + it_, tid); }     \
        if (rank < nada) { ada_fill_ssil(ptab, lds, tid); ada_wg_item(ptab, lds, (ADA_FIRST) + rank, tid); } \
        else CONV_RUN((rank - nada) * NWAVES + wave, (nidle - nada) * NWAVES, NIT, SEGS); } } while (0)

#define FILLER2(K, ADA_FIRST, NIT, SEGS) FILLER2N(K, ADA_FIRST, ADA_IT, NIT, SEGS)
#define FILLER2N(K, ADA_FIRST, ADA_CNT, NIT, SEGS) do { int Gl = G; asm volatile("" : "+s"(Gl)); const int cc_ = __builtin_amdgcn_readfirstlane(*(volatile const LAS int*)(lds + pg8::CC_TAB_OFF + 4 * (K))); \
    if (cc_ >= Gl || bxp >= cc_) { const int rank = cc_ >= Gl ? bxp : bxp - cc_, nidle = cc_ >= Gl ? Gl : Gl - cc_; \
        int tid = threadIdx.x; asm volatile("" : "+v"(tid)); const int lane = tid & 63, wave = __builtin_amdgcn_readfirstlane(tid >> 6); \
        if ((ADA_FIRST) >= 0) { ada_fill_ssil(ptab, lds, tid); for (int it_ = rank; it_ < (ADA_CNT); it_ += nidle) ada_wg_item(ptab, lds, (ADA_FIRST) + it_, tid); } \
        CONV_RUN(rank * NWAVES + wave, nidle * NWAVES, NIT, SEGS); } } while (0)

__device__ __forceinline__ void norm_load(const float* xrow, f32x4 (&v)[8], int lane) {
    const f32x4* xr = (const f32x4*)xrow + lane;
#pragma unroll
    for (int j = 0; j < 8; ++j) v[j] = xr[64 * j];
}
__device__ __forceinline__ void norm_load(const bf16_t* xrow, f32x4 (&v)[8], int lane) {
    const u32x2* xr = (const u32x2*)xrow + lane; u32x2 r[8];
#pragma unroll
    for (int j = 0; j < 8; ++j) r[j] = xr[64 * j];
#pragma unroll
    for (int j = 0; j < 8; ++j) v[j] = (f32x4){bf_lo(r[j].x), bf_hi(r[j].x), bf_lo(r[j].y), bf_hi(r[j].y)};
}
template <int MODE>
__device__ __forceinline__ void norm_vecs(const float* g, const float* sh, const float* sc, f32x4 (&GG)[8], f32x4 (&SS)[8], int lane) {
#pragma unroll
    for (int j = 0; j < 8; ++j) { GG[j] = ((const f32x4*)g)[lane + 64 * j];
        if (MODE == 0) { GG[j] = GG[j] * (((const f32x4*)sc)[lane + 64 * j] + 1.f); SS[j] = ((const f32x4*)sh)[lane + 64 * j]; } }
}
template <int MODE>
__device__ __forceinline__ void norm_apply(f32x4 (&v)[8], bf16_t* xcopy, const f32x4 (&GG)[8], const f32x4 (&SS)[8], bf16_t* obf, float* of32, int lane, const float* slabrow = nullptr, const float* gate = nullptr) {
    float ss = 0.f;
    if (slabrow) {
#pragma unroll
        for (int jh = 0; jh < 2; ++jh) { u32x2 p[4][8];
#pragma unroll
            for (int jj = 0; jj < 4; ++jj) { const int j = jh * 4 + jj; const u32x2* sp = (const u32x2*)((const bf16_t*)slabrow + (size_t)j * 8 * 65536) + lane;
#pragma unroll
                for (int s = 0; s < 8; ++s) p[jj][s] = sp[(size_t)s * 16384]; }
            __builtin_amdgcn_sched_barrier(0);
#pragma unroll
            for (int jj = 0; jj < 4; ++jj) { const int j = jh * 4 + jj; const f32x4 gt = ((const f32x4*)gate)[lane + 64 * j];
                f32x4 a = {bf_lo(p[jj][0].x), bf_hi(p[jj][0].x), bf_lo(p[jj][0].y), bf_hi(p[jj][0].y)};
#pragma unroll
                for (int s = 1; s < 8; ++s) a += (f32x4){bf_lo(p[jj][s].x), bf_hi(p[jj][s].x), bf_lo(p[jj][s].y), bf_hi(p[jj][s].y)};
                v[j] += gt * a; }
            __builtin_amdgcn_sched_barrier(0); } }
#pragma unroll
    for (int j = 0; j < 8; ++j) ss += (v[j].x * v[j].x + v[j].y * v[j].y) + (v[j].z * v[j].z + v[j].w * v[j].w);
    const float rstd = rsqrtf(wave_sum(ss) * (1.f / D) + 1e-6f);
    if (xcopy) {
#pragma unroll
        for (int j = 0; j < 8; ++j) { u32x2 w; w.x = pk2(v[j].x, v[j].y); w.y = pk2(v[j].z, v[j].w); ((u32x2*)xcopy)[lane + 64 * j] = w; } }
#pragma unroll
    for (int j = 0; j < 8; ++j) { const int c4 = lane + 64 * j;
        f32x4 h = v[j] * rstd * GG[j];
        if (MODE == 0) { h = h + SS[j]; u32x2 w; w.x = pk2(h.x, h.y); w.y = pk2(h.z, h.w); ((u32x2*)obf)[c4] = w; }
        else ((f32x4*)of32)[c4] = h; }
}
#define NORM_LATENT(VECS, ROWSRC, APPLY) do { const int rpw_ = (ML + NGW - 1) / NGW; const int r0_ = gw * rpw_, r1_ = (r0_ + rpw_ < ML) ? r0_ + rpw_ : ML; \
    if (r0_ < r1_) { f32x4 GG[8], SS[8], vA[8], vB[8]; int mc_ = r0_ / SEQ; VECS(mc_); norm_load(ROWSRC(r0_), vA, lane); \
        for (int r_ = r0_; r_ < r1_; r_ += 2) { \
            { const int rn_ = (r_ + 1 < r1_) ? r_ + 1 : r_; norm_load(ROWSRC(rn_), vB, lane); } \
            if (r_ / SEQ != mc_) { mc_ = r_ / SEQ; VECS(mc_); } \
            APPLY(vA, r_); \
            if (r_ + 1 < r1_) { { const int rn_ = (r_ + 2 < r1_) ? r_ + 2 : r_ + 1; norm_load(ROWSRC(rn_), vA, lane); } \
                if ((r_ + 1) / SEQ != mc_) { mc_ = (r_ + 1) / SEQ; VECS(mc_); } \
                APPLY(vB, r_ + 1); } } } } while (0)

template <bool LOCAL>
__device__ __forceinline__ void attn_unit(const bf16_t* Q, const bf16_t* KT, const bf16_t* VT, bf16_t* O, LAS unsigned char* lds, int b, int h, int r, int w, int tq, int lane) {
    const int g = lane >> 4, q = lane & 15;
    const int qrow = LOCAL ? (b * SEQ + r * GRID_W + 16 * w + q) : (ML + b * CTX + 16 * tq + q);
    bf16x8 bq[4];
    { const bf16_t* qp = Q + (size_t)qrow * D + h * HD + 8 * g;
#pragma unroll
      for (int ks = 0; ks < 4; ++ks) bq[ks] = *(const bf16x8*)(qp + 32 * ks); }
    constexpr int NP = LOCAL ? 16 : 8, CP = LOCAL ? 8 : 0;
    f32x4 s[2 * NP];
    int rs = 0, ws = 0;
    if (LOCAL) { rs = r - 4; rs = rs < 0 ? 0 : (rs > 24 ? 24 : rs); ws = 16 * w - 8; ws = ws < 0 ? 0 : (ws > 32 ? 32 : ws); }
    const int rgl = b * SEQ + rs * GRID_W + ws;
    if (LOCAL) {
        const bf16_t* kloc = KT + ((size_t)(((rgl >> 3) + (q >> 2)) * NH + h)) * 1024 + (q & 3) * 32 + g * 8;
        bf16x8 ka[2][8];
#define ATT_KLOAD(buf, p) do { const bf16_t* kp_ = kloc + (size_t)((p) * 8 * NH) * 1024; \
        _Pragma("unroll") for (int f = 0; f < 2; ++f) _Pragma("unroll") for (int ks = 0; ks < 4; ++ks) ka[buf][f * 4 + ks] = *(const bf16x8*)(kp_ + f * 128 + ks * 256); } while (0)
        ATT_KLOAD(0, 0);
#pragma unroll
        for (int p = 0; p < 8; ++p) {
            __builtin_amdgcn_s_barrier();
            if (p + 1 < 8) ATT_KLOAD((p + 1) & 1, p + 1);
            __builtin_amdgcn_sched_barrier(0);
#pragma unroll
            for (int f = 0; f < 2; ++f) { f32x4 a = {0.f, 0.f, 0.f, 0.f};
#pragma unroll
                for (int ks = 0; ks < 4; ++ks) a = __builtin_amdgcn_mfma_f32_16x16x32_bf16(ka[p & 1][f * 4 + ks], bq[ks], a, 0, 0, 0);
                s[2 * p + f] = a; }
            __builtin_amdgcn_sched_barrier(0);
        }
#undef ATT_KLOAD
    }
    {
        const LAS unsigned char* kl = lds + (q >> 2) * 2048 + (((q & 3) * 4 + g) ^ ((q >> 2) & 2)) * 16;
#pragma unroll
        for (int p = 0; p < 8; ++p)
#pragma unroll
            for (int f = 0; f < 2; ++f) { f32x4 a = {0.f, 0.f, 0.f, 0.f};
#pragma unroll
                for (int ks = 0; ks < 4; ++ks) a = __builtin_amdgcn_mfma_f32_16x16x32_bf16(*(const LAS bf16x8*)(kl + p * 8192 + ks * 512 + f * 256), bq[ks], a, 0, 0, 0);
                s[2 * (CP + p) + f] = a; }
    }
    if (LOCAL) {
        const int c = 16 * w + q; int cs = c - 8; cs = cs < 0 ? 0 : (cs > 48 ? 48 : cs);
        const LAS float* rp = (const LAS float*)(lds + LDS_MISC + 1024);
#pragma unroll
        for (int p = 0; p < 8; ++p) { const int ro = (rs + p - r + 7) * 31;
#pragma unroll
            for (int f = 0; f < 2; ++f)
#pragma unroll
                for (int j = 0; j < 4; ++j) { const int kc = ws + 8 * g + 4 * f + j; const bool valid = (kc >= cs) && (kc < cs + 16);
                    int rel = kc - c + 15; rel = rel < 0 ? 0 : (rel > 30 ? 30 : rel);
                    const float bias = rp[ro + rel];
                    s[p * 2 + f][j] = valid ? s[p * 2 + f][j] + bias : -INFINITY; } }
    }
    float mx = -INFINITY;
#pragma unroll
    for (int i = 0; i < 2 * NP; ++i) mx = fmaxf(mx, fmaxf(fmaxf(s[i][0], s[i][1]), fmaxf(s[i][2], s[i][3])));
    mx = fmaxf(mx, __shfl_xor(mx, 16)); mx = fmaxf(mx, __shfl_xor(mx, 32));
    float sum = 0.f; const float mxl = mx * 1.4426950408889634f;
    bf16x8 pb[NP];
#pragma unroll
    for (int p = 0; p < NP; ++p) { float e[8];
#pragma unroll
        for (int f = 0; f < 2; ++f)
#pragma unroll
            for (int j = 0; j < 4; ++j) { e[4 * f + j] = fast_exp2(fmaf(s[2 * p + f][j], 1.4426950408889634f, -mxl)); sum += e[4 * f + j]; }
        u32x4 pw; pw.x = cvt_pk_bf16(e[0], e[1]); pw.y = cvt_pk_bf16(e[2], e[3]); pw.z = cvt_pk_bf16(e[4], e[5]); pw.w = cvt_pk_bf16(e[6], e[7]);
        pb[p] = __builtin_bit_cast(bf16x8, pw); }
    sum += __shfl_xor(sum, 16); sum += __shfl_xor(sum, 32);
    f32x4 o[8];
#pragma unroll
    for (int df = 0; df < 8; ++df) o[df] = (f32x4){0.f, 0.f, 0.f, 0.f};
    if (LOCAL) {
        const bf16_t* vloc = VT + ((size_t)(((rgl >> 3) + g) * NH + h)) * 1024 + q * 8;
        bf16x8 va[2][8];
#define ATT_VLOAD(buf, p) do { const bf16_t* vp_ = vloc + (size_t)((p) * 8 * NH) * 1024; \
        _Pragma("unroll") for (int df = 0; df < 8; ++df) va[buf][df] = *(const bf16x8*)(vp_ + df * 128); } while (0)
        ATT_VLOAD(0, 0);
#pragma unroll
        for (int p = 0; p < 8; ++p) {
            __builtin_amdgcn_s_barrier();
            if (p + 1 < 8) ATT_VLOAD((p + 1) & 1, p + 1);
            __builtin_amdgcn_sched_barrier(0);
#pragma unroll
            for (int df = 0; df < 8; ++df) o[df] = __builtin_amdgcn_mfma_f32_16x16x32_bf16(va[p & 1][df], pb[p], o[df], 0, 0, 0);
            __builtin_amdgcn_sched_barrier(0);
        }
#undef ATT_VLOAD
    }
    {
        const LAS unsigned char* vl = lds + 65536 + g * 2048 + q * 16;
#pragma unroll
        for (int p = 0; p < 8; ++p)
#pragma unroll
            for (int df = 0; df < 8; ++df) o[df] = __builtin_amdgcn_mfma_f32_16x16x32_bf16(*(const LAS bf16x8*)(vl + p * 8192 + df * 256), pb[CP + p], o[df], 0, 0, 0);
    }
    const float inv = 1.f / sum;
    bf16_t* op = O + (size_t)qrow * D + h * HD + 4 * g;
#pragma unroll
    for (int df = 0; df < 8; ++df) { u32x2 wv; wv.x = cvt_pk_bf16(o[df][0] * inv, o[df][1] * inv); wv.y = cvt_pk_bf16(o[df][2] * inv, o[df][3] * inv); *(u32x2*)(op + 16 * df) = wv; }
}

#define LRU_STEP(h, l, x) do { const float a_ = fast_exp2(l); h = fmaf(a_, h, __builtin_amdgcn_sqrtf(fmaxf(fmaf(-a_, a_, 1.f), 0.f)) * (x)); } while (0)
__global__ void __launch_bounds__(NTHREADS, 2) mega(Args args) {
    extern __shared__ __attribute__((aligned(16))) unsigned char lds_raw[];
    LAS unsigned char* lds = (LAS unsigned char*)lds_raw;
    const int G = gridDim.x; const int bx = blockIdx.x; const int vcu = ((G & 7) == 0) ? (bx & 7) * (G >> 3) + (bx >> 3) : bx;
    const int NGW = G * NWAVES;
    const int lo = args.ph_lo, hi = args.ph_hi;
    volatile LAS unsigned* ptab = (volatile LAS unsigned*)(lds + LDS_MISC + 64);
    { const int tid = threadIdx.x;
    for (int u = tid; u < (LDS_BYTES - LDS_MISC) / 4; u += NTHREADS) ((LAS unsigned*)(lds + LDS_MISC))[u] = 0u;
    __syncthreads();
    if (tid < 25) { const unsigned long long pv = tid < 23 ? (unsigned long long)args.in[tid] : (tid == 23 ? (unsigned long long)args.out : (unsigned long long)args.ws);
        ptab[2 * tid] = (unsigned)pv; ptab[2 * tid + 1] = (unsigned)(pv >> 32); }
    if (tid == 32) { volatile LAS int* cct = (volatile LAS int*)(lds + pg8::CC_TAB_OFF); static_assert(pg8::CC_TAB_OFF == LDS_MISC + 512, "cc table");
        cct[1] = pg8::gemm_cc(36 * (2 * LW / 256), G); cct[2] = pg8::gemm_cc(36 * (2 * D / 256) + (D / 256) * 36, G); cct[3] = pg8::gemm_cc(36 * NLB * 4, G); cct[4] = pg8::gemm_cc(36 * (FF / 256), G); }
    __syncthreads(); }
    unsigned char* const ws0 = args.ws;
    XcdBarrier bar; bar.bar = (unsigned*)(ws0 + WS_CTL) + CW_BAR; bar.x = 0; bar.st = nullptr;
    const bool multi = (hi - lo) > 1;
    if (multi) bar = xcd_barrier_post((unsigned*)(ws0 + WS_CTL) + CW_BAR, (volatile LAS unsigned*)(lds + LDS_MISC + 32));
    bool need_bar = false;
#define IN(k) (lo <= (k) && (k) < hi)
#define TABP(i) tabp(ptab, (i))
#define INP(i) ((const float*)TABP(i))
#define WSF(off) ((float*)(wsl + (off)))
#define WSB(off) ((bf16_t*)(wsl + (off)))
#define PHASE_BEGIN() if (need_bar) xcd_barrier(bar); need_bar = true; int tid = threadIdx.x; asm volatile("" : "+v"(tid)); const int lane = tid & 63, wave = __builtin_amdgcn_readfirstlane(tid >> 6), gw = vcu * NWAVES + wave; (void)lane; (void)gw; unsigned char* const wsl = TABP(24); (void)wsl; int bxp = bx; asm volatile("" : "+s"(bxp)); (void)bxp

    if (IN(PH_PROLOGUE)) {
        PHASE_BEGIN();
        for (int rep = 0; rep < REP_PRO; ++rep) {
        __syncthreads();
        ada_fill_ssil(ptab, lds, tid);
        constexpr int ADA0 = 64;
        { const float* lam = INP(13); float* CAw = WSF(WS_CA);
          for (int i = gw * 64 + lane; i < 2 * 2 * LW; i += NGW * 64) CAw[i] = -8.f * log1pf(expf(-lam[i])) * 1.4426950408889634f; }
        constexpr int NITEMS = C_IN;
#define SEGS_P CSEG(2, 0, C_IN)
        if (G > 2 * ADA0) { if (bx < ADA0) ada_wg_item_t<64>(ptab, lds, 0, bx * 64, tid); else CONV_RUN((bx - ADA0) * NWAVES + wave, (G - ADA0) * NWAVES, NITEMS, SEGS_P); }
        else { for (int it_ = vcu; it_ < ADA0; it_ += G) ada_wg_item_t<64>(ptab, lds, 0, it_ * 64, tid); CONV_RUN(vcu * NWAVES + wave, G * NWAVES, NITEMS, SEGS_P); }
#undef SEGS_P
        }
    }
    if (IN(PH_NORM0)) {
        PHASE_BEGIN();
        const float* x = INP(0); const float* ctx = INP(2); const float* norm1_g = INP(6); const float* mods = WSF(WS_MODS); bf16_t* X = WSB(WS_X); bf16_t* XN = WSB(WS_XN);
#define VECS0(m) norm_vecs<0>(norm1_g, mods + (size_t)(m) * MODW, mods + (size_t)(m) * MODW + D, GG, SS, lane)
#define SRC0(r) (x + (size_t)(r) * D)
#define APP0(v, r) norm_apply<0>(v, nullptr, GG, SS, XN + (size_t)(r) * D, nullptr, lane)
        for (int rep = 0; rep < REP_NORM; ++rep) {
            NORM_LATENT(VECS0, SRC0, APP0);
            { f32x4 GG[8], SS[8]; VECS0(4);
              for (int row = ML + gw; row < M; row += NGW) { f32x4 v[8]; norm_load(ctx + (size_t)(row - ML) * D, v, lane); norm_apply<0>(v, X + (size_t)row * D, GG, SS, XN + (size_t)row * D, nullptr, lane); } } }
#undef VECS0
#undef SRC0
#undef APP0
    }
    for (int L = 0; L < DEPTH; ++L) {
        const int base = PH_LAYER0 + PH_PER_LAYER * L; const bool lru = !(L & 1); const int j = L >> 1; const bool lastL = (L == DEPTH - 1);
        const int nMrows = lastL ? 32 : 36;
        if (IN(base + 0)) {
            if (threadIdx.x == 0 && lru) { const int U_ = 36 * (2 * LW / 256), R_ = (U_ + G - 1) / G + (L == 0 ? 1 : 0); int c_ = ((U_ + R_ - 1) / R_ + 7) & ~7; if ((G & 7) || c_ > G) c_ = G;
                ((volatile LAS int*)(lds + pg8::CC_TAB_OFF))[1] = c_; }
            PHASE_BEGIN();
            if (lru) {
                pg8::Gemm g{WSB(WS_XN), WSB(WS_WIN) + (size_t)j * (2 * LW) * D, D, D, D, -1, nullptr, nullptr, 0}; pg8::StaticOrder S; S.init(36, 2 * LW / 256, G, bxp);
                pg8::EpiAct<0> E{WSB(WS_BIG), 2 * LW};
                pg8::gemm_phase<pg8::EpiAct<0>, true, true, 1>(lds, g, S, E);
#define SEGS_A CSEG(6, 0, C_G); CSEG(3, 0, C_OUT); CSEG(0, 0, C_W); CSEG(1, 0, C_W); CSEG(4, 0, C_QKV); CSEG(5, 0, C_O); CSEG(0, 1, C_W)
#define SEGS_E CSEG(1, 2, C_W); CSEG(4, 1, C_QKV); CSEG(5, 1, C_O)
                if (L == 0) FILLER2N(1, 32, 160, C_G + C_OUT + 3 * C_W + C_QKV + C_O, SEGS_A);
                if (L == 2) FILLER2(1, -1, C_W + C_QKV + C_O, SEGS_E);
#undef SEGS_A
#undef SEGS_E
            } else {
                const bf16_t* wq = WSB(WS_WQKV) + (size_t)j * (3 * D) * D; const bf16_t* XN = WSB(WS_XN);
                pg8::Gemm g{XN, wq, D, D, D, -1, wq + (size_t)(2 * D) * D, XN, 0}; pg8::StaticOrder S; S.init(36, 2 * D / 256, G, bxp, D / 256, 36);
                pg8::EpiQKV E{WSB(WS_BIG), WSB(WS_BIG + 36 * MiB), WSB(WS_BIG + 72 * MiB), 0.08838834764831845f};
                pg8::gemm_phase<pg8::EpiQKV, true, true, 2>(lds, g, S, E);
#define SEGS_C CSEG(3, 1, C_OUT); CSEG(6, 1, C_G); CSEGO(1, 1, 0, C_W / 2)
#define SEGS_F CSEG(1, 3, C_W)
                if (L == 1) FILLER2(2, 3 * ADA_IT, C_OUT + C_G + C_W / 2, SEGS_C);
                if (L == 3) FILLER2(2, -1, C_W, SEGS_F);
#undef SEGS_C
#undef SEGS_F
            }
        }
        if (IN(base + 1)) {
            PHASE_BEGIN();
            if (lru) {
                const float* cw = INP(11) + (size_t)j * 4 * LW; const float* cb = INP(12) + (size_t)j * LW; const bf16_t* GU = WSB(WS_BIG); bf16_t* UC = WSB(WS_UC);
                for (int rep = 0; rep < REP_CONV; ++rep)
                for (int it = gw; it < 288 * NLB; it += NGW) {
                    const int strip = it / NLB, cg = it % NLB, ch = cg * 256 + 4 * lane;
                    int seg0, seglen, t0; if (strip < 256) { seg0 = (strip >> 6) * SEQ; seglen = SEQ; t0 = (strip & 63) * 32; } else { const int s2 = strip - 256; seg0 = ML + (s2 >> 3) * CTX; seglen = CTX; t0 = (s2 & 7) * 32; }
                    const f32x4 w0 = *(const f32x4*)(cw + ch), w1 = *(const f32x4*)(cw + LW + ch), w2 = *(const f32x4*)(cw + 2 * LW + ch), w3 = *(const f32x4*)(cw + 3 * LW + ch), bv = *(const f32x4*)(cb + ch);
                    u32x2 uw[35];
#pragma unroll
                    for (int i = 0; i < 35; ++i) { const int t = t0 - 2 + i; const int tc = t < 0 ? 0 : (t >= seglen ? seglen - 1 : t); uw[i] = *(const u32x2*)(GU + (size_t)(seg0 + tc) * (2 * LW) + LW + ch); }
                    __builtin_amdgcn_sched_barrier(0);
                    auto cvu = [&](int i) -> f32x4 { const int t = t0 - 2 + i; const float z = (t < 0 || t >= seglen) ? 0.f : 1.f; return (f32x4){bf_lo(uw[i].x) * z, bf_hi(uw[i].x) * z, bf_lo(uw[i].y) * z, bf_hi(uw[i].y) * z}; };
                    f32x4 um2 = cvu(0), um1 = cvu(1), u0 = cvu(2);
#pragma unroll
                    for (int t = 0; t < 32; ++t) { const f32x4 up1 = cvu(t + 3);
                        const f32x4 y = w0 * um2 + w1 * um1 + w2 * u0 + w3 * up1 + bv;
                        u32x2 wv; wv.x = pk2(y.x, y.y); wv.y = pk2(y.z, y.w); *(u32x2*)(UC + (size_t)(seg0 + t0 + t) * LW + ch) = wv;
                        um2 = um1; um1 = u0; u0 = up1; }
                }
            } else {
                const bf16_t* Qb = WSB(WS_BIG); const bf16_t* KTp = WSB(WS_BIG + 36 * MiB); const bf16_t* VTp = WSB(WS_BIG + 72 * MiB); bf16_t* Ob = WSB(WS_O);
                const float* rpg = INP(20) + (size_t)j * NH * 465;
                for (int rep = 0; rep < REP_ATTN; ++rep)
                for (int it = vcu; it < BATCH * NH * 4; it += G) { const int qr = it & 3, h = (it >> 2) & 15, b = it >> 6;
                    __syncthreads();
                    { const int oc0 = (ML + b * CTX) >> 3;
                      for (int ci = tid; ci < 4096; ci += NTHREADS) { const int o = ci >> 7, wq = ci & 127;
                          const u32x4 kv = *(const u32x4*)(KTp + ((size_t)((oc0 + o) * NH + h)) * 1024 + wq * 8);
                          *(LAS u32x4*)(lds + o * 2048 + (wq & ~15) * 16 + ((wq & 15) ^ (o & 2)) * 16) = kv;
                          const u32x4 vv = *(const u32x4*)(VTp + ((size_t)((oc0 + o) * NH + h)) * 1024 + wq * 8);
                          *(LAS u32x4*)(lds + 65536 + o * 2048 + wq * 16) = vv; }
                      LAS float* rp = (LAS float*)(lds + LDS_MISC + 1024);
                      for (int i = tid; i < 465; i += NTHREADS) rp[i] = rpg[h * 465 + i]; }
                    __syncthreads();
#pragma unroll 1
                    for (int rd = 0; rd < 4; ++rd) attn_unit<true>(Qb, KTp, VTp, Ob, lds, b, h, 8 * qr + 2 * rd + (wave >> 2), wave & 3, 0, lane);
                    if (!lastL && wave < 4) attn_unit<false>(Qb, KTp, VTp, Ob, lds, b, h, 0, 0, 4 * qr + wave, lane);
                }
                __syncthreads();
            }
        }
        if (lru) {
            if (IN(base + 2)) {
                PHASE_BEGIN();
                const bf16_t* UC = WSB(WS_UC);
                pg8::Gemm g{UC, WSB(WS_WG) + (size_t)j * (NLB * 1024) * LB, LW, LB, LB, 2, nullptr, nullptr, 0}; pg8::StaticOrder S; S.init(36, NLB * 4, G, bxp);
                pg8::EpiGates E{UC, (unsigned*)(wsl + WS_LA), INP(15) + (size_t)j * 2 * LW, INP(17) + (size_t)j * 2 * LW, WSF(WS_CA) + (size_t)j * 2 * LW};
                for (int rep = 0; rep < REP_GATES; ++rep) pg8::gemm_phase<pg8::EpiGates, false, true>(lds, g, S, E);
#define SEGS_H0 CSEG(5, 0, C_O)
#define SEGS_H1 CSEG(5, 1, C_O)
#undef SEGS_H0
#undef SEGS_H1
            }
            if (IN(base + 3)) {
                PHASE_BEGIN();
                const unsigned* LB = (const unsigned*)(wsl + WS_LA); float* AGGA = WSF(WS_AGGA); float* AGGH = WSF(WS_AGGH);
                for (int rep = 0; rep < REP_S1; ++rep)
                for (int it = gw; it < 2 * BATCH * 72 * 22; it += NGW) {
                    const int cg = it % 22, r1 = it / 22, q = r1 % 72, r2 = r1 / 72, b = r2 & 3, dir = r2 >> 2;
                    const int ch = cg * 128 + 2 * lane;
                    const int rbase = q < 8 ? ML + b * CTX + 32 * q : b * SEQ + 32 * (q - 8);
                    const unsigned* lp = LB + ((size_t)dir * M + rbase) * LW + ch;
                    float sl0 = 0.f, sl1 = 0.f, h0 = 0.f, h1 = 0.f;
                    u32x2 lb[32];
#pragma unroll
                    for (int t = 0; t < 32; ++t) lb[t] = *(const u32x2*)(lp + (size_t)t * LW);
                    __builtin_amdgcn_sched_barrier(0);
                    if (dir == 0) {
#pragma unroll
                        for (int t = 0; t < 32; ++t) { const float l0 = bf_lo(lb[t].x), l1 = bf_lo(lb[t].y); LRU_STEP(h0, l0, bf_hi(lb[t].x)); LRU_STEP(h1, l1, bf_hi(lb[t].y)); sl0 += l0; sl1 += l1; }
                    } else {
#pragma unroll
                        for (int t = 31; t >= 0; --t) { const float l0 = bf_lo(lb[t].x), l1 = bf_lo(lb[t].y); LRU_STEP(h0, l0, bf_hi(lb[t].x)); LRU_STEP(h1, l1, bf_hi(lb[t].y)); sl0 += l0; sl1 += l1; }
                    }
                    const size_t o = ((size_t)(dir * BATCH + b) * 72 + q) * LW + ch;
                    *(f32x2*)(AGGA + o) = (f32x2){fast_exp2(sl0), fast_exp2(sl1)}; *(f32x2*)(AGGH + o) = (f32x2){h0, h1};
                }
            }
            if (IN(base + 4)) {
                PHASE_BEGIN();
                const float* AGGA = WSF(WS_AGGA); const float* AGGH = WSF(WS_AGGH); float* CARRY = WSF(WS_CARRY);
                for (int rep = 0; rep < REP_S2; ++rep)
                for (int i = (wave * G + vcu) * 64 + lane; i < 2 * BATCH * LW; i += NGW * 64) {
                    const int ch = i % LW, db = i / LW, dir = db >> 2;
                    const size_t o = (size_t)db * 72 * LW + ch; float h = 0.f;
                    for (int bt = 0; bt < 2; ++bt) { float av[36], hv[36];
#pragma unroll
                        for (int k = 0; k < 36; ++k) { const int st = bt * 36 + k, q = dir ? (st < 8 ? 7 - st : 79 - st) : st; av[k] = AGGA[o + (size_t)q * LW]; hv[k] = AGGH[o + (size_t)q * LW]; }
#pragma unroll
                        for (int k = 0; k < 36; ++k) { const int st = bt * 36 + k, q = dir ? (st < 8 ? 7 - st : 79 - st) : st; CARRY[o + (size_t)q * LW] = h; h = av[k] * h + hv[k]; } }
                }
            }
            if (IN(base + 5)) {
                PHASE_BEGIN();
                const unsigned* LB = (const unsigned*)(wsl + WS_LA); const float* CARRY = WSF(WS_CARRY); const bf16_t* GU = WSB(WS_BIG); bf16_t* Zb = WSB(WS_Z);
                for (int rep = 0; rep < REP_S3; ++rep)
                for (int it = gw; it < BATCH * 72 * 22; it += NGW) {
                    const int cg = it % 22, r1 = it / 22, q = r1 % 72, b = r1 / 72;
                    const int ch = cg * 128 + 2 * lane;
                    const int rbase = q < 8 ? ML + b * CTX + 32 * q : b * SEQ + 32 * (q - 8);
                    const size_t ro = (size_t)rbase * LW + ch;
                    const size_t c0 = ((size_t)(0 * BATCH + b) * 72 + q) * LW + ch, c1 = ((size_t)(1 * BATCH + b) * 72 + q) * LW + ch;
                    float hf0[32], hf1[32];
                    { u32x2 lb[32]; const f32x2 hc = *(const f32x2*)(CARRY + c0);
#pragma unroll
                      for (int t = 0; t < 32; ++t) lb[t] = *(const u32x2*)(LB + ro + (size_t)t * LW);
                      __builtin_amdgcn_sched_barrier(0);
                      float h0 = hc.x, h1 = hc.y;
#pragma unroll
                      for (int t = 0; t < 32; ++t) { LRU_STEP(h0, bf_lo(lb[t].x), bf_hi(lb[t].x)); LRU_STEP(h1, bf_lo(lb[t].y), bf_hi(lb[t].y)); hf0[t] = h0; hf1[t] = h1; } }
                    { u32x2 lb[32]; unsigned gwv[32]; const f32x2 hc = *(const f32x2*)(CARRY + c1);
                      const unsigned* l1p = LB + (size_t)M * LW + ro;
#pragma unroll
                      for (int t = 0; t < 32; ++t) { lb[t] = *(const u32x2*)(l1p + (size_t)t * LW); gwv[t] = *(const unsigned*)(GU + (size_t)(rbase + t) * (2 * LW) + ch); }
                      __builtin_amdgcn_sched_barrier(0);
                      float h0 = hc.x, h1 = hc.y;
#pragma unroll
                      for (int t = 31; t >= 0; --t) { LRU_STEP(h0, bf_lo(lb[t].x), bf_hi(lb[t].x)); LRU_STEP(h1, bf_lo(lb[t].y), bf_hi(lb[t].y));
                          const float g0 = bf_lo(gwv[t]), g1 = bf_hi(gwv[t]);
                          const float z0 = g0 * fast_sigmoid(1.5957691216057308f * (g0 + 0.044715f * g0 * g0 * g0)) * (hf0[t] + h0);
                          const float z1 = g1 * fast_sigmoid(1.5957691216057308f * (g1 + 0.044715f * g1 * g1 * g1)) * (hf1[t] + h1);
                          *(unsigned*)(Zb + ro + (size_t)t * LW) = pk2(z0, z1); } }
                }
            }
        }
        if (IN(base + 6)) {
            PHASE_BEGIN();
            const bf16_t* Ao = lru ? WSB(WS_Z) : WSB(WS_O); const bf16_t* Bo = lru ? WSB(WS_WOUT) + (size_t)j * D * LW : WSB(WS_WO) + (size_t)j * D * D; const int Ko = lru ? LW : D;
            pg8::Gemm g{Ao, Bo, Ko, Ko, Ko, -1, Ao, Bo, 1};
            pg8::StaticOrder S; if (lastL) S.init(32, D / 256, G, bxp); else if (G == 256) S.init(32, D / 256, -G, bxp + 256, 4, D / 256, 1);
            else S.init(32, D / 256, G, bxp, 4, D / 256, 1);
            if (L == 0) { pg8::EpiResidT<true, 1> E{WSB(WS_X), WSF(WS_MODS) + (size_t)L * 5 * MODW, 2, WSF(WS_SLAB), INP(0), INP(7) + (size_t)L * D, 3 * D, 64u * (2 * L + 1), lds};
                pg8::gemm_phase<pg8::EpiResidT<true, 1>, true, true>(lds, g, S, E); }
            else { pg8::EpiResidT<false, 1> E{WSB(WS_X), WSF(WS_MODS) + (size_t)L * 5 * MODW, 2, WSF(WS_SLAB), nullptr, INP(7) + (size_t)L * D, 3 * D, 64u * (2 * L + 1), lds};
                pg8::gemm_phase<pg8::EpiResidT<false, 1>, true, true>(lds, g, S, E); }
        }
        if (IN(base + 7) && !lastL) {
            PHASE_BEGIN();
            const float* ml = WSF(WS_MODS) + (size_t)L * 5 * MODW; bf16_t* X = WSB(WS_X); bf16_t* XN = WSB(WS_XN); const float* g2 = INP(7) + (size_t)L * D;
            const float* slab = WSF(WS_SLAB);
#define VECS7(m) norm_vecs<0>(g2, ml + (size_t)(m) * MODW + 3 * D, ml + (size_t)(m) * MODW + 4 * D, GG, SS, lane)
#define SRC7(r) (X + (size_t)(r) * D)
#define APP7(v, r) norm_apply<0>(v, nullptr, GG, SS, XN + (size_t)(r) * D, nullptr, lane)
            if (!lastL) { f32x4 GG[8], SS[8]; VECS7(4); const float* mm = ml + (size_t)4 * MODW;
                for (int row = ML + gw; row < M; row += NGW) { f32x4 v[8]; norm_load(X + (size_t)row * D, v, lane);
                    norm_apply<0>(v, X + (size_t)row * D, GG, SS, XN + (size_t)row * D, nullptr, lane,
                                  (const float*)((const bf16_t*)slab + (size_t)((row - ML) >> 8) * 64 * 65536 + (size_t)(row & 255) * 256), mm + 2 * D); } }
#undef VECS7
#undef SRC7
#undef APP7
        }
        if (IN(base + 8)) {
            if (threadIdx.x == 0) ((volatile LAS int*)(lds + pg8::CC_TAB_OFF))[4] = lastL ? G : pg8::gemm_cc(36 * (FF / 256), G);
            PHASE_BEGIN();
            pg8::Gemm g{WSB(WS_XN), WSB(WS_W1) + (size_t)L * FF * D, D, D, D, -1, nullptr, nullptr, 0}; pg8::StaticOrder S; S.init(nMrows, FF / 256, G, bxp);
            pg8::EpiAct<1> E{WSB(WS_BIG), FF};
            pg8::gemm_phase<pg8::EpiAct<1>, true, true, 4>(lds, g, S, E);
#define SEGS_B CSEG(2, 1, C_IN)
#define SEGS_D CSEG(0, 2, C_W); CSEGO(1, 1, C_W / 2, C_W / 2)
#define SEGS_G CSEG(0, 3, C_W)
            if (L == 0) FILLER2(4, 2 * ADA_IT, C_IN, SEGS_B);
            if (L == 1) FILLER2(4, -1, C_W + C_W / 2, SEGS_D);
            if (L == 2) FILLER2(4, -1, C_W, SEGS_G);
#undef SEGS_B
#undef SEGS_D
#undef SEGS_G
        }
        if (IN(base + 9)) {
            PHASE_BEGIN();
            const bf16_t* Ao = WSB(WS_BIG); const bf16_t* Bo = WSB(WS_W2) + (size_t)L * D * FF;
            pg8::Gemm g{Ao, Bo, FF, FF, FF, -1, Ao, Bo, 1};
            pg8::StaticOrder S; if (lastL) S.init(32, D / 256, G, bxp); else if (G == 256) S.init(32, D / 256, -G, bxp + 256, 4, D / 256, 1);
            else S.init(32, D / 256, G, bxp, 4, D / 256, 1);
            if (lastL) { pg8::EpiResidT<false, 2> E{WSB(WS_X), WSF(WS_MODS) + (size_t)L * 5 * MODW, 5, (float*)TABP(23), nullptr, INP(22), 0, 64u * (2 * L + 2), lds};
                pg8::gemm_phase<pg8::EpiResidT<false, 2>, true, true>(lds, g, S, E); }
            else { pg8::EpiResidT<false, 1> E{WSB(WS_X), WSF(WS_MODS) + (size_t)L * 5 * MODW, 5, WSF(WS_SLAB), nullptr, INP(6) + (size_t)(L + 1) * D, 5 * MODW, 64u * (2 * L + 2), lds};
                pg8::gemm_phase<pg8::EpiResidT<false, 1>, true, true>(lds, g, S, E); }
        }
        if (IN(base + 10) && !lastL) {
            PHASE_BEGIN();
            bf16_t* X = WSB(WS_X);
#define SRC10(r) (X + (size_t)(r) * D)
            { const float* mn = WSF(WS_MODS) + (size_t)(L + 1) * 5 * MODW; bf16_t* XN = WSB(WS_XN); const float* g1n = INP(6) + (size_t)(L + 1) * D;
                const float* slab = WSF(WS_SLAB); const float* gate5 = WSF(WS_MODS) + ((size_t)L * 5 + 4) * MODW + 5 * D;
#define VECS10B(m) norm_vecs<0>(g1n, mn + (size_t)(m) * MODW, mn + (size_t)(m) * MODW + D, GG, SS, lane)
#define APP10B(v, r) norm_apply<0>(v, nullptr, GG, SS, XN + (size_t)(r) * D, nullptr, lane)
                { f32x4 GG[8], SS[8]; VECS10B(4);
                  for (int row = ML + gw; row < M; row += NGW) { f32x4 v[8]; norm_load(X + (size_t)row * D, v, lane);
                      norm_apply<0>(v, X + (size_t)row * D, GG, SS, XN + (size_t)row * D, nullptr, lane,
                                    (const float*)((const bf16_t*)slab + (size_t)((row - ML) >> 8) * 64 * 65536 + (size_t)(row & 255) * 256), gate5); } }
#undef VECS10B
#undef APP10B
            }
#undef SRC10
        }
    }
#undef IN
#undef PHASE_BEGIN
}

static inline dim3 g1(size_t n) { return dim3((unsigned)((n + 255) / 256)); }

extern "C" void kernel_launch(void* const* d_in, const int* in_sizes, int n_in, void* d_out, int out_size, void* d_ws, size_t ws_size, hipStream_t stream) {
    static int grid = 0;
    if (grid == 0) {
        int dev = 0, cus = 0;
        if (hipGetDevice(&dev) != hipSuccess || hipDeviceGetAttribute(&cus, hipDeviceAttributeMultiprocessorCount, dev) != hipSuccess) { grid = -1; return; }
        if (hipFuncSetAttribute((const void*)mega, hipFuncAttributeMaxDynamicSharedMemorySize, LDS_BYTES) != hipSuccess) { fprintf(stderr, "hipFuncSetAttribute failed\n"); grid = -1; return; }
        int per_cu = 0; (void)hipOccupancyMaxActiveBlocksPerMultiprocessor(&per_cu, (const void*)mega, NTHREADS, LDS_BYTES); (void)hipGetLastError();
        grid = cus;
    }
    if (grid < 0) return;
    const float* norm1_g = (const float*)d_in[6]; const float* norm2_g = (const float*)d_in[7];
    const float* lru_w_in = (const float*)d_in[10]; const float* lru_conv_w = (const float*)d_in[11];
    const float* lru_conv_b = (const float*)d_in[12]; const float* lru_lambda = (const float*)d_in[13]; const float* lru_wa = (const float*)d_in[14]; const float* lru_ba = (const float*)d_in[15];
    const float* lru_wx = (const float*)d_in[16]; const float* lru_bx = (const float*)d_in[17]; const float* lru_w_out = (const float*)d_in[18]; const float* na_w_qkv = (const float*)d_in[19];
    const float* na_rpb = (const float*)d_in[20]; const float* na_w_o = (const float*)d_in[21];
    (void)norm2_g;
    char* ws = (char*)d_ws;
    (void)hipMemsetAsync(ws + WS_CTL, 0, CTL_ZERO_BYTES, stream);
    Args a{};
    for (int i = 0; i < 23; ++i) a.in[i] = (const float*)d_in[i];
    a.out = (float*)d_out; a.ws = (unsigned char*)d_ws;
    auto run = [&](int lo, int hi) { a.ph_lo = lo; a.ph_hi = hi; hipLaunchKernelGGL(mega, dim3(grid), dim3(NTHREADS), LDS_BYTES, stream, a); };
#if ONE_LAUNCH
    if (WS_FAST_END > ws_size) { fprintf(stderr, "ws too small\n"); return; }
    run(0, PH_END);
#else
    size_t off = (FAST_LRU ? WS_FAST_END : WS_NV);
    auto alloc = [&](size_t bytes) { float* p = (float*)(ws + off); off += (bytes + 255) & ~(size_t)255; return p; };
    float* H = alloc((size_t)M * D * 4); float* T1 = alloc((size_t)M * D * 4);
    float* BIGF = alloc((size_t)M * 3 * D * 4);
    float* UCf = alloc((size_t)M * LW * 4); float* RA = alloc((size_t)M * LW * 4); float* RX = alloc((size_t)M * LW * 4); float* Y = alloc((size_t)M * LW * 4);
    if (!(FAST_LRU && FAST_NA)) { if (off > ws_size) { fprintf(stderr, "ws too small: need %zu have %zu\n", off, ws_size); return; } }
    else if (WS_FAST_END > ws_size) return;
    float* mods = (float*)(ws + WS_MODS); float* X = (float*)(ws + WS_X);
    run(PH_PROLOGUE, PH_PROLOGUE + 1);
    run(PH_NORM0, PH_NORM0 + 1);
    for (int L = 0; L < DEPTH; ++L) {
        const int base = PH_LAYER0 + PH_PER_LAYER * L; const bool lru = !(L & 1); const int j = L / 2;
        const float* ml = mods + (size_t)L * 5 * MODW;
        if (lru) {
            if (FAST_LRU) { for (int p = 0; p <= 6; ++p) run(base + p, base + p + 1); }
            else {
                nv::k_norm_mod<<<M, 256, 0, stream>>>(X, norm1_g + (size_t)L * D, ml, 0, H, D);
                float* GUf = BIGF;
                nv::k_sgemm<<<dim3(2 * LW / 128, M / 128, 1), 256, 0, stream>>>(H, D, 0, lru_w_in + (size_t)j * D * 2 * LW, 2 * LW, 0, GUf, 2 * LW, 0, D);
                nv::k_conv<<<g1((size_t)M * LW), 256, 0, stream>>>(GUf, lru_conv_w + (size_t)j * 4 * LW, lru_conv_b + (size_t)j * LW, UCf);
                for (int d = 0; d < 2; ++d) {
                    const size_t wo = ((size_t)j * 2 + d) * NLB * LB * LB, bo = ((size_t)j * 2 + d) * LW;
                    nv::k_sgemm<<<dim3(LB / 128, M / 128, NLB), 256, 0, stream>>>(UCf, LW, LB, lru_wa + wo, LB, (size_t)LB * LB, RA, LW, LB, LB);
                    nv::k_sgemm<<<dim3(LB / 128, M / 128, NLB), 256, 0, stream>>>(UCf, LW, LB, lru_wx + wo, LB, (size_t)LB * LB, RX, LW, LB, LB);
                    nv::k_lru_coef<<<g1((size_t)M * LW), 256, 0, stream>>>(RA, RX, UCf, lru_ba + bo, lru_bx + bo, lru_lambda + bo);
                    nv::k_scan_dir<<<g1(BATCH * LW), 256, 0, stream>>>(RA, RX, Y, d);
                }
                nv::k_gate_mul<<<g1((size_t)M * LW), 256, 0, stream>>>(GUf, Y, UCf);
                nv::k_sgemm<<<dim3(D / 128, M / 128, 1), 256, 0, stream>>>(UCf, LW, 0, lru_w_out + (size_t)j * LW * D, D, 0, T1, D, 0, LW);
                nv::k_resid<<<g1((size_t)M * D), 256, 0, stream>>>(X, T1, ml, 2, M);
            }
        } else {
            if (FAST_NA) { run(base + 0, base + 1); run(base + 1, base + 2); run(base + 6, base + 7); }
            else {
                nv::k_norm_mod<<<M, 256, 0, stream>>>(X, norm1_g + (size_t)L * D, ml, 0, H, D);
                float* QKV = BIGF;
                nv::k_sgemm<<<dim3(3 * D / 128, M / 128, 1), 256, 0, stream>>>(H, D, 0, na_w_qkv + (size_t)j * D * 3 * D, 3 * D, 0, QKV, 3 * D, 0, D);
                nv::k_attn<<<M * NH / 4, 256, 0, stream>>>(QKV, na_rpb + (size_t)j * NH * 15 * 31, H);
                nv::k_sgemm<<<dim3(D / 128, M / 128, 1), 256, 0, stream>>>(H, D, 0, na_w_o + (size_t)j * D * D, D, 0, T1, D, 0, D);
                nv::k_resid<<<g1((size_t)M * D), 256, 0, stream>>>(X, T1, ml, 2, M);
            }
        }
        run(base + 7, base + 8); run(base + 8, base + 9); run(base + 9, base + 10); run(base + 10, base + 11);
    }
#endif
}
```
